# Optimizing an MI355X kernel written in HIP

```python
import math
import jax, jax.numpy as jnp
from jax import lax
import numpy as np

D_MODEL = 1024
BATCH = 8
SEQ = 4096
DEPTH = 2
DEC_BATCH = 32
DEC_SEQ = 1
PAST_LEN = 16384
PAGE_SIZE = 128

N_MIXERS = 2
N_GMLP = (DEPTH + 1) // 2
N_ATT = DEPTH // 2

CHUNK = 128
GMLP_WIDTH = 2 * D_MODEL
GMLP_GROUPS = 8
GMLP_GROUP_DIM = GMLP_WIDTH // GMLP_GROUPS

N_HEADS = 16
HEAD_DIM = D_MODEL // N_HEADS
N_KV_HEADS = 4
GROUP = N_HEADS // N_KV_HEADS
IDX_HEADS = 8
IDX_DIM = 64
TOPK_MAX = 256
Q_BLOCK = 128
ROPE_THETA = 10000.0
IDX_SCALE = (IDX_DIM ** -0.5) * (IDX_HEADS ** -0.5)
ATT_SIZES = (N_HEADS * HEAD_DIM, N_KV_HEADS * HEAD_DIM, N_KV_HEADS * HEAD_DIM,
             IDX_HEADS * IDX_DIM, IDX_DIM, IDX_HEADS)
ATT_PROJ = sum(ATT_SIZES)

PEER_HEADS = 8
N_KEYS = 128
N_EXPERTS = N_KEYS * N_KEYS
PEER_TOPK = 16
PEER_KEY_DIM = 256
PEER_HALF = PEER_KEY_DIM // 2
PEER_BLOCK = 128

EPS = 1e-6

kernel_name = "gmlp_dsa_peer_hybrid_step"


def _rms(x, g):
    xf = x.astype(jnp.float32)
    y = xf * lax.rsqrt(jnp.mean(xf * xf, axis=-1, keepdims=True) + EPS)
    return (y * g.astype(jnp.float32)).astype(x.dtype)


def _rope(x, pos):
    half = x.shape[-1] // 2
    inv = jnp.exp(-math.log(ROPE_THETA) * jnp.arange(half, dtype=jnp.float32) / half)
    ang = pos.astype(jnp.float32)[:, None] * inv[None, :]
    cos = jnp.cos(ang)[:, None, :]
    sin = jnp.sin(ang)[:, None, :]
    xf = x.astype(jnp.float32)
    x1, x2 = xf[..., :half], xf[..., half:]
    return jnp.concatenate([x1 * cos - x2 * sin, x2 * cos + x1 * sin], axis=-1).astype(x.dtype)


def _gmlp_mix(h, w_in, v_g, w_s, b_s, w_out):
    B, T, _ = h.shape
    uv = h @ w_in
    u, v = uv[..., :GMLP_WIDTH], uv[..., GMLP_WIDTH:]
    v = _rms(v, v_g)
    n_chunks = -(-T // CHUNK)
    pad = n_chunks * CHUNK - T
    vp = jnp.pad(v, ((0, 0), (0, pad), (0, 0))).reshape(B, n_chunks, CHUNK, GMLP_GROUPS, GMLP_GROUP_DIM)
    causal = jnp.tril(jnp.ones((CHUNK, CHUNK), dtype=bool))
    ws = jnp.where(causal, w_s, 0)
    mixed = jnp.einsum('gts,bcsgd->bctgd', ws, vp) + b_s.T[None, None, :, :, None]
    mixed = mixed.reshape(B, n_chunks * CHUNK, GMLP_WIDTH)[:, :T]
    return (u * mixed) @ w_out, v


def _att_project(h, w_in, qn_g, kn_g, ikn_g, pos):
    B, T, _ = h.shape
    p = h @ w_in
    splits = [int(s) for s in np.cumsum(ATT_SIZES)[:-1]]
    q, k, v, qi, ki, wi = jnp.split(p, splits, axis=-1)
    q = _rope(_rms(q.reshape(B, T, N_HEADS, HEAD_DIM), qn_g), pos)
    k = _rope(_rms(k.reshape(B, T, N_KV_HEADS, HEAD_DIM), kn_g), pos)
    v = v.reshape(B, T, N_KV_HEADS, HEAD_DIM)
    qi = _rope(qi.reshape(B, T, IDX_HEADS, IDX_DIM), pos)
    ki = _rope(_rms(ki, ikn_g)[:, :, None, :], pos)[:, :, 0]
    return q, k, v, qi, ki, wi


def _sparse_attend(q, qi, wi, ki_all, q_pos, n_keep, gather_kv):
    B, Tq = q.shape[0], q.shape[1]
    s = jax.nn.relu(jnp.einsum('bthd,bsd->bths', qi, ki_all))
    score = jnp.einsum('bths,bth->bts', s, wi).astype(jnp.float32) * IDX_SCALE
    key_pos = jnp.arange(ki_all.shape[1])
    admissible = key_pos[None, :] <= q_pos[:, None]
    score = jnp.where(admissible[None], score, -jnp.inf)
    _, idx = lax.top_k(score, n_keep)
    sel_ok = idx <= q_pos[None, :, None]
    k_sel, v_sel = gather_kv(idx)
    qg = q.reshape(B, Tq, N_KV_HEADS, GROUP, HEAD_DIM)
    logits = jnp.einsum('bthgd,btnhd->bthgn', qg, k_sel).astype(jnp.float32) * (HEAD_DIM ** -0.5)
    logits = jnp.where(sel_ok[:, :, None, None, :], logits, -jnp.inf)
    prob = jax.nn.softmax(logits, axis=-1).astype(v_sel.dtype)
    o = jnp.einsum('bthgn,btnhd->bthgd', prob, v_sel)
    return o.reshape(B, Tq, N_HEADS * HEAD_DIM)


def _take_rows(a, idx):
    return jax.vmap(lambda ab, ib: ab[ib])(a, idx)


def _att_prompt(h, w_in, qn_g, kn_g, ikn_g, w_out):
    B, S, _ = h.shape
    pos = jnp.arange(S)
    q, k, v, qi, ki, wi = _att_project(h, w_in, qn_g, kn_g, ikn_g, pos)
    n_keep = min(TOPK_MAX, S // 4)
    nb = S // Q_BLOCK

    def gather(idx):
        return _take_rows(k, idx), _take_rows(v, idx)

    def blocks(a):
        return a.reshape((B, nb, Q_BLOCK) + a.shape[2:]).swapaxes(0, 1)

    def one_block(args):
        qb, qib, wib, posb = args
        return _sparse_attend(qb, qib, wib, ki, posb, n_keep, gather)

    o = lax.map(one_block, (blocks(q), blocks(qi), blocks(wi), pos.reshape(nb, Q_BLOCK)))
    o = o.swapaxes(0, 1).reshape(B, S, N_HEADS * HEAD_DIM)
    return o @ w_out, k, v, ki


def _att_sample(h, ck, cv, cik, page_table, w_in, qn_g, kn_g, ikn_g, w_out):
    B, T, _ = h.shape
    pos = PAST_LEN + jnp.arange(T)
    q, k, v, qi, ki, wi = _att_project(h, w_in, qn_g, kn_g, ikn_g, pos)
    n_pages = PAST_LEN // PAGE_SIZE
    ki_past = cik[page_table].reshape(B, n_pages * PAGE_SIZE, IDX_DIM)
    ki_all = jnp.concatenate([ki_past, ki], axis=1)
    n_keep = min(TOPK_MAX, (PAST_LEN + T) // 4)

    def gather(idx):
        is_new = (idx >= PAST_LEN)[..., None, None]
        past = jnp.minimum(idx, PAST_LEN - 1)
        phys = jnp.take_along_axis(page_table, (past // PAGE_SIZE).reshape(B, -1), axis=1).reshape(idx.shape)
        off = past % PAGE_SIZE
        new = jnp.clip(idx - PAST_LEN, 0, T - 1)
        k_sel = jnp.where(is_new, _take_rows(k, new), ck[phys, off])
        v_sel = jnp.where(is_new, _take_rows(v, new), cv[phys, off])
        return k_sel, v_sel

    o = _sparse_attend(q, qi, wi, ki_all, pos, n_keep, gather)
    return o @ w_out, k, v, ki


def _peer(h, w_q, sub_k1, sub_k2, expert_u, expert_v):
    shape = h.shape
    x = h.reshape(-1, D_MODEL)
    n = x.shape[0]
    nb = -(-n // PEER_BLOCK)
    xp = jnp.pad(x, ((0, nb * PEER_BLOCK - n), (0, 0))).reshape(nb, PEER_BLOCK, D_MODEL)

    def one_block(xb):
        q = (xb @ w_q).reshape(PEER_BLOCK, PEER_HEADS, 2, PEER_HALF)
        s1 = jnp.einsum('thd,kd->thk', q[:, :, 0], sub_k1).astype(jnp.float32)
        s2 = jnp.einsum('thd,kd->thk', q[:, :, 1], sub_k2).astype(jnp.float32)
        v1, i1 = lax.top_k(s1, PEER_TOPK)
        v2, i2 = lax.top_k(s2, PEER_TOPK)
        cand = (v1[..., :, None] + v2[..., None, :]).reshape(PEER_BLOCK, PEER_HEADS, PEER_TOPK * PEER_TOPK)
        cand_idx = (i1[..., :, None] * N_KEYS + i2[..., None, :]).reshape(PEER_BLOCK, PEER_HEADS, PEER_TOPK * PEER_TOPK)
        top_s, top_pos = lax.top_k(cand, PEER_TOPK)
        eidx = jnp.take_along_axis(cand_idx, top_pos, axis=-1)
        gate = jax.nn.softmax(top_s, axis=-1)
        u = expert_u[eidx]
        act = jax.nn.gelu(jnp.einsum('thkd,td->thk', u, xb))
        vv = expert_v[eidx]
        return jnp.einsum('thk,thkd->td', (gate * act).astype(vv.dtype), vv)

    y = lax.map(one_block, xp).reshape(-1, D_MODEL)[:n]
    return y.reshape(shape)


def setup_inputs(seed: int = 0) -> dict:
    key = jax.random.key(seed)
    ks = jax.random.split(key, 24)
    n_pages = PAST_LEN // PAGE_SIZE
    n_used = DEC_BATCH * n_pages
    n_pool = (5 * n_used + 3) // 4
    f32 = jnp.float32

    def nrm(k, shape, scale):
        return jax.random.normal(k, shape, f32) * scale

    def gain(k, shape):
        return 1.0 + 0.02 * jax.random.normal(k, shape, f32)

    page_table = jax.random.permutation(ks[0], n_pool)[:n_used].reshape(DEC_BATCH, n_pages).astype(jnp.int32)
    return {
        "x_prompt": nrm(ks[1], (BATCH, SEQ, D_MODEL), 1.0),
        "x_sample": nrm(ks[2], (DEC_BATCH, DEC_SEQ, D_MODEL), 1.0),
        "cache_k": nrm(ks[3], (N_ATT, n_pool, PAGE_SIZE, N_KV_HEADS, HEAD_DIM), 1.0),
        "cache_v": nrm(ks[4], (N_ATT, n_pool, PAGE_SIZE, N_KV_HEADS, HEAD_DIM), 1.0),
        "cache_idx_k": nrm(ks[5], (N_ATT, n_pool, PAGE_SIZE, IDX_DIM), 1.0),
        "page_table": page_table,
        "norm_mix_g": gain(ks[6], (DEPTH, D_MODEL)),
        "norm_ffn_g": gain(ks[7], (DEPTH, D_MODEL)),
        "gmlp_w_in": nrm(ks[8], (N_GMLP, D_MODEL, 2 * GMLP_WIDTH), D_MODEL ** -0.5),
        "gmlp_v_g": gain(ks[9], (N_GMLP, GMLP_WIDTH)),
        "gmlp_w_s": nrm(ks[10], (N_GMLP, GMLP_GROUPS, CHUNK, CHUNK), CHUNK ** -0.5),
        "gmlp_b_s": gain(ks[11], (N_GMLP, GMLP_GROUPS, CHUNK)),
        "gmlp_w_out": nrm(ks[12], (N_GMLP, GMLP_WIDTH, D_MODEL), 0.5 * GMLP_WIDTH ** -0.5),
        "att_w_in": nrm(ks[13], (N_ATT, D_MODEL, ATT_PROJ), D_MODEL ** -0.5),
        "att_q_norm_g": gain(ks[14], (N_ATT, HEAD_DIM)),
        "att_k_norm_g": gain(ks[15], (N_ATT, HEAD_DIM)),
        "att_idx_k_norm_g": gain(ks[16], (N_ATT, IDX_DIM)),
        "att_w_out": nrm(ks[17], (N_ATT, N_HEADS * HEAD_DIM, D_MODEL), (N_HEADS * HEAD_DIM) ** -0.5),
        "peer_w_q": nrm(ks[18], (DEPTH, D_MODEL, PEER_HEADS * PEER_KEY_DIM), D_MODEL ** -0.5),
        "peer_sub_k1": nrm(ks[19], (DEPTH, N_KEYS, PEER_HALF), PEER_HALF ** -0.5),
        "peer_sub_k2": nrm(ks[20], (DEPTH, N_KEYS, PEER_HALF), PEER_HALF ** -0.5),
        "peer_u": nrm(ks[21], (DEPTH, N_EXPERTS, D_MODEL), D_MODEL ** -0.5),
        "peer_v": nrm(ks[22], (DEPTH, N_EXPERTS, D_MODEL), 0.1),
    }


def reference(x_prompt, x_sample, cache_k, cache_v, cache_idx_k, page_table,
              norm_mix_g, norm_ffn_g,
              gmlp_w_in, gmlp_v_g, gmlp_w_s, gmlp_b_s, gmlp_w_out,
              att_w_in, att_q_norm_g, att_k_norm_g, att_idx_k_norm_g, att_w_out,
              peer_w_q, peer_sub_k1, peer_sub_k2, peer_u, peer_v):
    xp, xs = x_prompt, x_sample
    kp_l, vp_l, ip_l, ks_l, vs_l, is_l, cv_l = [], [], [], [], [], [], []
    for layer in range(DEPTH):
        a = layer // N_MIXERS
        hp = _rms(xp, norm_mix_g[layer])
        hs = _rms(xs, norm_mix_g[layer])
        if layer % N_MIXERS == 0:
            op, _ = _gmlp_mix(hp, gmlp_w_in[a], gmlp_v_g[a], gmlp_w_s[a], gmlp_b_s[a], gmlp_w_out[a])
            os_, v_rows = _gmlp_mix(hs, gmlp_w_in[a], gmlp_v_g[a], gmlp_w_s[a], gmlp_b_s[a], gmlp_w_out[a])
            cv_l.append(v_rows)
        else:
            op, kp, vp, ip = _att_prompt(hp, att_w_in[a], att_q_norm_g[a], att_k_norm_g[a],
                                         att_idx_k_norm_g[a], att_w_out[a])
            os_, ksm, vsm, ism = _att_sample(hs, cache_k[a], cache_v[a], cache_idx_k[a], page_table,
                                             att_w_in[a], att_q_norm_g[a], att_k_norm_g[a],
                                             att_idx_k_norm_g[a], att_w_out[a])
            kp_l.append(kp); vp_l.append(vp); ip_l.append(ip)
            ks_l.append(ksm); vs_l.append(vsm); is_l.append(ism)
        xp = xp + op
        xs = xs + os_
        xp = xp + _peer(_rms(xp, norm_ffn_g[layer]), peer_w_q[layer], peer_sub_k1[layer],
                        peer_sub_k2[layer], peer_u[layer], peer_v[layer])
        xs = xs + _peer(_rms(xs, norm_ffn_g[layer]), peer_w_q[layer], peer_sub_k1[layer],
                        peer_sub_k2[layer], peer_u[layer], peer_v[layer])
    new_k_prompt = jnp.stack(kp_l)
    new_v_prompt = jnp.stack(vp_l)
    new_idx_k_prompt = jnp.stack(ip_l)
    new_k_sample = jnp.stack(ks_l)
    new_v_sample = jnp.stack(vs_l)
    new_idx_k_sample = jnp.stack(is_l)
    new_chunk_v_sample = jnp.stack(cv_l)
    return (xp, xs, new_k_prompt, new_v_prompt, new_idx_k_prompt,
            new_k_sample, new_v_sample, new_idx_k_sample, new_chunk_v_sample)
```

```cpp
#include <hip/hip_runtime.h>
#include <math.h>
#include <stdint.h>

namespace {
constexpr int D = 1024, NP = 32768, NS = 32, NT = NP + NS, SEQ = 4096;
constexpr int GW = 2048, ATT_PROJ = 2120, PAST = 16384, NPAGE = 128;
constexpr float EPS = 1e-6f;
constexpr float IDX_SCALE = 0.04419417382415922f;
constexpr size_t O_Y = 0, O_KP = 33587200, O_VP = 41975808, O_IP = 50364416, O_KS = 52461568, O_VS = 52469760, O_IS = 52477952, O_CV = 52480000;

struct RopeInv { float inv[32]; };

__device__ __forceinline__ float wave_sum(float v) {
#pragma unroll
    for (int o = 32; o > 0; o >>= 1) v += __shfl_xor(v, o);
    return v;
}
__device__ __forceinline__ float wave_max(float v) {
#pragma unroll
    for (int o = 32; o > 0; o >>= 1) v = fmaxf(v, __shfl_xor(v, o));
    return v;
}
__device__ __forceinline__ float block_sum256(float v, float* red) {
    v = wave_sum(v);
    __syncthreads();
    if ((threadIdx.x & 63) == 0) red[threadIdx.x >> 6] = v;
    __syncthreads();
    return red[0] + red[1] + red[2] + red[3];
}
__device__ __forceinline__ unsigned f2key(float f) { f = f + 0.0f; unsigned u = __float_as_uint(f); return (u & 0x80000000u) ? ~u : (u | 0x80000000u); }
__device__ __forceinline__ float gelu_tanh(float x) { const float t = tanhf(0.7978845608028654f * (x + 0.044715f * x * x * x)); return 0.5f * x * (1.0f + t); }

__global__ __launch_bounds__(256) void k_rms(const float* x, int ld_in, const float* g, float* out, int ld_out, int dim, float* extra, int extra_row0, int extra_ld) {
    __shared__ float red[4];
    const int row = blockIdx.x; const float* xr = x + (size_t)row * ld_in;
    float s = 0.f;
    for (int i = threadIdx.x; i < dim; i += 256) { const float v = xr[i]; s += v * v; }
    s = block_sum256(s, red);
    const float r = rsqrtf(s / (float)dim + EPS);
    for (int i = threadIdx.x; i < dim; i += 256) { const float y = xr[i] * r * g[i]; out[(size_t)row * ld_out + i] = y; if (extra && row >= extra_row0) extra[(size_t)(row - extra_row0) * extra_ld + i] = y; }
}

__global__ __launch_bounds__(256) void k_gemm(const float* A, int lda, const float* B, int ldb, float* C, int ldc, int M, int N, int K, const float* R, int ldr) {
    __shared__ float As[16][68]; __shared__ float Bs[16][68];
    const int bm = blockIdx.y * 64, bn = blockIdx.x * 64, tid = threadIdx.x, tx = tid & 15, ty = tid >> 4;
    float acc[4][4];
#pragma unroll
    for (int i = 0; i < 4; ++i)
#pragma unroll
        for (int j = 0; j < 4; ++j) acc[i][j] = 0.f;
    for (int k0 = 0; k0 < K; k0 += 16) {
        { const int r = tid >> 2, c = (tid & 3) * 4, gr = bm + r; float4 v = make_float4(0.f, 0.f, 0.f, 0.f); if (gr < M) v = *(const float4*)(A + (size_t)gr * lda + k0 + c);
          As[c][r] = v.x; As[c + 1][r] = v.y; As[c + 2][r] = v.z; As[c + 3][r] = v.w; }
        { const int r = tid >> 4, c = (tid & 15) * 4, gc = bn + c; const float* p = B + (size_t)(k0 + r) * ldb + gc; float4 v = make_float4(0.f, 0.f, 0.f, 0.f);
          if (gc + 3 < N) v = *(const float4*)p; else { if (gc < N) v.x = p[0]; if (gc + 1 < N) v.y = p[1]; if (gc + 2 < N) v.z = p[2]; }
          Bs[r][c] = v.x; Bs[r][c + 1] = v.y; Bs[r][c + 2] = v.z; Bs[r][c + 3] = v.w; }
        __syncthreads();
#pragma unroll
        for (int kk = 0; kk < 16; ++kk) {
            float a[4], b[4];
#pragma unroll
            for (int i = 0; i < 4; ++i) a[i] = As[kk][ty * 4 + i];
#pragma unroll
            for (int j = 0; j < 4; ++j) b[j] = Bs[kk][tx * 4 + j];
#pragma unroll
            for (int i = 0; i < 4; ++i)
#pragma unroll
                for (int j = 0; j < 4; ++j) acc[i][j] += a[i] * b[j];
        }
        __syncthreads();
    }
#pragma unroll
    for (int i = 0; i < 4; ++i) { const int gr = bm + ty * 4 + i; if (gr >= M) continue;
#pragma unroll
        for (int j = 0; j < 4; ++j) { const int gc = bn + tx * 4 + j; if (gc >= N) continue; float v = acc[i][j]; if (R) v += R[(size_t)gr * ldr + gc]; C[(size_t)gr * ldc + gc] = v; } }
}

__global__ __launch_bounds__(256) void k_sgu(const float* UV, const float* w_s, const float* b_s, float* G) {
    const int r = blockIdx.x; int tl, base;
    if (r < NP) { tl = r & 127; base = r - tl; } else { tl = 0; base = r; }
    float acc[8];
#pragma unroll
    for (int j = 0; j < 8; ++j) acc[j] = 0.f;
    for (int s = 0; s <= tl; ++s) {
        const float* vr = UV + (size_t)(base + s) * 4096 + 2048;
#pragma unroll
        for (int j = 0; j < 8; ++j) acc[j] += w_s[(size_t)j * 16384 + tl * 128 + s] * vr[j * 256 + threadIdx.x];
    }
#pragma unroll
    for (int j = 0; j < 8; ++j) { const int c = j * 256 + threadIdx.x; G[(size_t)r * 2048 + c] = UV[(size_t)r * 4096 + c] * (acc[j] + b_s[j * 128 + tl]); }
}

__global__ __launch_bounds__(128) void k_peer_route(const float* Q, const float* k1, const float* k2, int* eidx, float* gate) {
    __shared__ float q[256], s1[128], s2[128], v1[16], v2[16], cand[256], ts[16];
    __shared__ int i1[16], i2[16], te[16];
    const int tok = blockIdx.x >> 3, h = blockIdx.x & 7, k = threadIdx.x;
    q[k] = Q[(size_t)tok * 2048 + h * 256 + k]; q[k + 128] = Q[(size_t)tok * 2048 + h * 256 + 128 + k];
    __syncthreads();
    { float a = 0.f, b = 0.f; const float* r1 = k1 + k * 128; const float* r2 = k2 + k * 128;
      for (int d = 0; d < 128; ++d) { a += q[d] * r1[d]; b += q[128 + d] * r2[d]; }
      s1[k] = a; s2[k] = b; }
    __syncthreads();
    { const float a = s1[k], b = s2[k]; int ra = 0, rb = 0;
      for (int j = 0; j < 128; ++j) { const float x = s1[j], y = s2[j]; ra += (x > a || (x == a && j < k)) ? 1 : 0; rb += (y > b || (y == b && j < k)) ? 1 : 0; }
      if (ra < 16) { v1[ra] = a; i1[ra] = k; } if (rb < 16) { v2[rb] = b; i2[rb] = k; } }
    __syncthreads();
    cand[k] = v1[k >> 4] + v2[k & 15]; cand[k + 128] = v1[(k + 128) >> 4] + v2[k & 15];
    __syncthreads();
#pragma unroll
    for (int rep = 0; rep < 2; ++rep) { const int c = k + rep * 128; const float a = cand[c]; int ra = 0;
        for (int j = 0; j < 256; ++j) { const float x = cand[j]; ra += (x > a || (x == a && j < c)) ? 1 : 0; }
        if (ra < 16) { ts[ra] = a; te[ra] = i1[c >> 4] * 128 + i2[c & 15]; } }
    __syncthreads();
    if (k < 16) { float m = ts[0]; float sum = 0.f; for (int j = 0; j < 16; ++j) sum += expf(ts[j] - m);
        gate[(size_t)tok * 128 + h * 16 + k] = expf(ts[k] - m) / sum; eidx[(size_t)tok * 128 + h * 16 + k] = te[k]; }
}

__global__ __launch_bounds__(256) void k_peer_expert(const float* H, const float* X, const int* eidx, const float* gate, const float* U, const float* V, float* out) {
    __shared__ float hs[1024]; __shared__ float act[128]; __shared__ int es[128];
    const int tok = blockIdx.x, tid = threadIdx.x, lane = tid & 63, w = tid >> 6;
    for (int i = tid; i < 1024; i += 256) hs[i] = H[(size_t)tok * 1024 + i];
    if (tid < 128) es[tid] = eidx[(size_t)tok * 128 + tid];
    __syncthreads();
    for (int j = w; j < 128; j += 4) { const float* ur = U + (size_t)es[j] * 1024; float d = 0.f;
#pragma unroll
        for (int i = 0; i < 4; ++i) { const float4 u4 = *(const float4*)(ur + (i * 64 + lane) * 4); const float4 h4 = *(const float4*)(hs + (i * 64 + lane) * 4); d += u4.x * h4.x + u4.y * h4.y + u4.z * h4.z + u4.w * h4.w; }
        d = wave_sum(d);
        if (lane == 0) act[j] = gate[(size_t)tok * 128 + j] * gelu_tanh(d); }
    __syncthreads();
    float4 y = make_float4(0.f, 0.f, 0.f, 0.f);
    for (int j = 0; j < 128; ++j) { const float4 v4 = *(const float4*)(V + (size_t)es[j] * 1024 + tid * 4); const float a = act[j]; y.x += a * v4.x; y.y += a * v4.y; y.z += a * v4.z; y.w += a * v4.w; }
    const float4 x4 = *(const float4*)(X + (size_t)tok * 1024 + tid * 4);
    *(float4*)(out + (size_t)tok * 1024 + tid * 4) = make_float4(x4.x + y.x, x4.y + y.y, x4.z + y.z, x4.w + y.w);
}

__global__ void k_rope_table(RopeInv ri, float* tab) {
    const int i = blockIdx.x * blockDim.x + threadIdx.x; if (i >= 4097 * 32) return;
    const int p = i >> 5, d = i & 31; const float pos = (p < 4096) ? (float)p : 16384.0f;
    const float ang = pos * ri.inv[d];
    const double rev = (double)ang * 0.15915494309189535; const float fr = (float)(rev - floor(rev));
    tab[p * 64 + d] = __builtin_amdgcn_cosf(fr); tab[p * 64 + 32 + d] = __builtin_amdgcn_sinf(fr);
}

__global__ __launch_bounds__(256) void k_att_post(const float* P, const float* qg, const float* kg, const float* ikg, const float* tab,
                                                  float* Qn, float* Kn, float* Vn, float* QI, float* KI, float* WI, float* out) {
    const int row = blockIdx.x, tid = threadIdx.x, lane = tid & 63, w = tid >> 6;
    const float* p = P + (size_t)row * ATT_PROJ;
    const float* tb = tab + (size_t)(row < NP ? (row & 4095) : 4096) * 64;
    const float cs = tb[lane & 31], sn = tb[32 + (lane & 31)];
    for (int task = w; task < 29; task += 4) {
        int src; const float* g = nullptr; float* dst; float* dst2 = nullptr;
        if (task < 16) { src = task * 64; g = qg; dst = Qn + (size_t)row * 1024 + task * 64; }
        else if (task < 20) { const int hh = task - 16; src = 1024 + hh * 64; g = kg; dst = Kn + (size_t)row * 256 + hh * 64;
            dst2 = (row < NP) ? out + O_KP + (size_t)row * 256 + hh * 64 : out + O_KS + (size_t)(row - NP) * 256 + hh * 64; }
        else if (task < 28) { const int hh = task - 20; src = 1536 + hh * 64; dst = QI + (size_t)row * 512 + hh * 64; }
        else { src = 2048; g = ikg; dst = KI + (size_t)row * 64; dst2 = (row < NP) ? out + O_IP + (size_t)row * 64 : out + O_IS + (size_t)(row - NP) * 64; }
        float x = p[src + lane];
        if (g) { const float ss = wave_sum(x * x); x = x * rsqrtf(ss * (1.0f / 64.0f) + EPS) * g[lane]; }
        const float other = __shfl_xor(x, 32);
        const float y = (lane < 32) ? (x * cs - other * sn) : (x * cs + other * sn);
        dst[lane] = y; if (dst2) dst2[lane] = y;
    }
    { const float v = p[1280 + tid]; Vn[(size_t)row * 256 + tid] = v; if (row < NP) out[O_VP + (size_t)row * 256 + tid] = v; else out[O_VS + (size_t)(row - NP) * 256 + tid] = v; }
    if (tid < 8) WI[(size_t)row * 8 + tid] = p[2112 + tid];
}

__global__ __launch_bounds__(128) void k_samp_scores(const float* QI, const float* WI, const float* KI, const float* cik, const int* page_table, unsigned* keys) {
    __shared__ float qi[512], wi[8];
    const int b = blockIdx.y, pg = blockIdx.x, tid = threadIdx.x, row = NP + b;
    for (int i = tid; i < 512; i += 128) qi[i] = QI[(size_t)row * 512 + i];
    if (tid < 8) wi[tid] = WI[(size_t)row * 8 + tid];
    __syncthreads();
    const float* kr; int s;
    if (pg < NPAGE) { const int phys = page_table[b * NPAGE + pg]; kr = cik + ((size_t)phys * 128 + tid) * 64; s = pg * 128 + tid; }
    else { if (tid != 0) return; kr = KI + (size_t)row * 64; s = PAST; }
    float sc = 0.f;
    for (int h = 0; h < 8; ++h) { float d = 0.f; for (int i = 0; i < 64; ++i) d += qi[h * 64 + i] * kr[i]; sc += fmaxf(d, 0.f) * wi[h]; }
    keys[(size_t)b * 16640 + s] = f2key(sc * IDX_SCALE);
}

template <bool SAMPLE>
__global__ __launch_bounds__(256) void k_attend(const float* Qn, const float* Kn, const float* Vn, const float* QI, const float* KI, const float* WI,
                                                const unsigned* gkeys, const float* ck, const float* cv, const int* page_table, float* O) {
    extern __shared__ unsigned char smem[];
    unsigned* keys = (unsigned*)smem;
    float* qs = (float*)(smem + 16384);
    float* lg = (float*)(smem + 16384 + 4096);
    int* sel = (int*)(smem + 16384 + 4096 + 16384);
    float* qi = (float*)(smem + 16384 + 4096 + 16384 + 1024);
    float* wi = qi + 512;
    int* cnt = (int*)(wi + 8);
    const int tid = threadIdx.x, lane = tid & 63, w = tid >> 6;
    int row, n, b; const float* kbase; const float* vbase;
    if (SAMPLE) { b = blockIdx.x; row = NP + b; n = PAST + 1; kbase = nullptr; vbase = nullptr; }
    else { row = blockIdx.x; b = row >> 12; n = (row & 4095) + 1; kbase = Kn + (size_t)b * SEQ * 256; vbase = Vn + (size_t)b * SEQ * 256; }
    for (int i = tid; i < 1024; i += 256) qs[i] = Qn[(size_t)row * 1024 + i];
    if (!SAMPLE) { for (int i = tid; i < 512; i += 256) qi[i] = QI[(size_t)row * 512 + i]; if (tid < 8) wi[tid] = WI[(size_t)row * 8 + tid]; }
    if (tid < 4) cnt[tid] = 0;
    __syncthreads();
    const unsigned* kk;
    if (SAMPLE) kk = gkeys + (size_t)b * 16640;
    else {
        const float* kib = KI + (size_t)b * SEQ * 64;
        for (int s = tid; s < n; s += 256) { const float* kr = kib + (size_t)s * 64; float sc = 0.f;
            for (int h = 0; h < 8; ++h) { float d = 0.f; for (int i = 0; i < 64; ++i) d += qi[h * 64 + i] * kr[i]; sc += fmaxf(d, 0.f) * wi[h]; }
            keys[s] = f2key(sc * IDX_SCALE); }
        kk = keys;
        __syncthreads();
    }
    int nsel;
    if (n <= 256) { nsel = n; if (tid < n) sel[tid] = tid; __syncthreads(); }
    else {
        unsigned T = 0u;
        for (int bit = 31; bit >= 0; --bit) {
            const unsigned c = T | (1u << bit); int my = 0;
            for (int s = tid; s < n; s += 256) my += (kk[s] >= c) ? 1 : 0;
            my = (int)wave_sum((float)my);
            if (lane == 0) atomicAdd(&cnt[bit & 1], my);
            __syncthreads();
            const int tot = cnt[bit & 1];
            if (tot >= 256) T = c;
            if (tid == 0) cnt[(bit + 1) & 1] = 0;
            __syncthreads();
        }
        { int my = 0; for (int s = tid; s < n; s += 256) my += (kk[s] > T) ? 1 : 0; my = (int)wave_sum((float)my); if (lane == 0) atomicAdd(&cnt[2], my); }
        __syncthreads();
        const int ngt = cnt[2];
        for (int s = tid; s < n; s += 256) if (kk[s] > T) { const int p = atomicAdd(&cnt[3], 1); sel[p] = s; }
        __syncthreads();
        if (tid == 0) { int p = ngt; for (int s = 0; s < n && p < 256; ++s) if (kk[s] == T) sel[p++] = s; }
        __syncthreads();
        nsel = 256;
    }
    {
        const float* kr = nullptr;
        if (tid < nsel) { const int s = sel[tid];
            if (SAMPLE) { if (s >= PAST) kr = Kn + (size_t)row * 256; else { const int phys = page_table[b * NPAGE + (s >> 7)]; kr = ck + ((size_t)phys * 128 + (s & 127)) * 256; } }
            else kr = kbase + (size_t)s * 256; }
        for (int h = 0; h < 16; ++h) { float d = -INFINITY;
            if (kr) { d = 0.f; const float* kh = kr + (h >> 2) * 64; for (int i = 0; i < 64; ++i) d += qs[h * 64 + i] * kh[i]; d *= 0.125f; }
            lg[h * 256 + tid] = d; }
    }
    __syncthreads();
    for (int h = w; h < 16; h += 4) { float v[4]; float m = -INFINITY;
#pragma unroll
        for (int i = 0; i < 4; ++i) { v[i] = lg[h * 256 + i * 64 + lane]; m = fmaxf(m, v[i]); }
        m = wave_max(m); float sum = 0.f;
#pragma unroll
        for (int i = 0; i < 4; ++i) { v[i] = expf(v[i] - m); sum += v[i]; }
        sum = wave_sum(sum); const float inv = 1.0f / sum;
#pragma unroll
        for (int i = 0; i < 4; ++i) lg[h * 256 + i * 64 + lane] = v[i] * inv; }
    __syncthreads();
    { const int c = tid * 4, h = c >> 6, kvh = h >> 2, off = kvh * 64 + (c & 63); float4 o = make_float4(0.f, 0.f, 0.f, 0.f);
        for (int j = 0; j < nsel; ++j) { const int s = sel[j]; const float* vr;
            if (SAMPLE) { if (s >= PAST) vr = Vn + (size_t)row * 256; else { const int phys = page_table[b * NPAGE + (s >> 7)]; vr = cv + ((size_t)phys * 128 + (s & 127)) * 256; } }
            else vr = vbase + (size_t)s * 256;
            const float4 v4 = *(const float4*)(vr + off); const float pj = lg[h * 256 + j]; o.x += pj * v4.x; o.y += pj * v4.y; o.z += pj * v4.z; o.w += pj * v4.w; }
        *(float4*)(O + (size_t)row * 1024 + c) = o; }
}
constexpr int ATT_SMEM = 16384 + 4096 + 16384 + 1024 + 2048 + 32 + 16;
}

extern "C" void kernel_launch(void* const* d_in, const int* in_sizes, int n_in, void* d_out, int out_size, void* d_ws, size_t ws_size, hipStream_t stream) {
    const float* x_prompt = (const float*)d_in[0]; const float* x_sample = (const float*)d_in[1];
    const float* cache_k = (const float*)d_in[2]; const float* cache_v = (const float*)d_in[3]; const float* cache_ik = (const float*)d_in[4];
    const int* page_table = (const int*)d_in[5];
    const float* norm_mix_g = (const float*)d_in[6]; const float* norm_ffn_g = (const float*)d_in[7];
    const float* gmlp_w_in = (const float*)d_in[8]; const float* gmlp_v_g = (const float*)d_in[9]; const float* gmlp_w_s = (const float*)d_in[10];
    const float* gmlp_b_s = (const float*)d_in[11]; const float* gmlp_w_out = (const float*)d_in[12];
    const float* att_w_in = (const float*)d_in[13]; const float* att_qg = (const float*)d_in[14]; const float* att_kg = (const float*)d_in[15];
    const float* att_ikg = (const float*)d_in[16]; const float* att_w_out = (const float*)d_in[17];
    const float* peer_wq = (const float*)d_in[18]; const float* peer_k1 = (const float*)d_in[19]; const float* peer_k2 = (const float*)d_in[20];
    const float* peer_u = (const float*)d_in[21]; const float* peer_v = (const float*)d_in[22];
    float* out = (float*)d_out;
    float* ws = (float*)d_ws; size_t o = 0;
    auto take = [&](size_t n) { float* p = ws + o; o += (n + 63) & ~(size_t)63; return p; };
    float* X = take((size_t)NT * D); float* H = take((size_t)NT * D); float* BIG = take((size_t)NT * 4096); float* G = take((size_t)NT * 2048);
    float* X1 = take((size_t)NT * D); float* X2 = take((size_t)NT * D); float* X3 = take((size_t)NT * D);
    int* EIDX = (int*)take((size_t)NT * 128); float* GATE = take((size_t)NT * 128);
    float* Qn = take((size_t)NT * 1024); float* Kn = take((size_t)NT * 256); float* Vn = take((size_t)NT * 256); float* QI = take((size_t)NT * 512);
    float* KI = take((size_t)NT * 64); float* WI = take((size_t)NT * 8); float* TAB = take(4097 * 64); unsigned* SKEYS = (unsigned*)take(32 * 16640);
    float* O = take((size_t)NT * 1024);

    (void)hipMemcpyAsync(X, x_prompt, (size_t)NP * D * 4, hipMemcpyDeviceToDevice, stream);
    (void)hipMemcpyAsync(X + (size_t)NP * D, x_sample, (size_t)NS * D * 4, hipMemcpyDeviceToDevice, stream);
    RopeInv ri; for (int i = 0; i < 32; ++i) ri.inv[i] = (float)exp(-log(10000.0) * (double)i / 32.0);
    k_rope_table<<<(4097 * 32 + 255) / 256, 256, 0, stream>>>(ri, TAB);

    auto gemm = [&](const float* A, int lda, const float* B, int ldb, float* C, int ldc, int M, int N, int K, const float* R, int ldr) {
        dim3 grid((N + 63) / 64, (M + 63) / 64); k_gemm<<<grid, 256, 0, stream>>>(A, lda, B, ldb, C, ldc, M, N, K, R, ldr); };
    auto peer = [&](const float* Xin, int layer, float* Xout) {
        k_rms<<<NT, 256, 0, stream>>>(Xin, D, norm_ffn_g + layer * D, H, D, D, nullptr, 0, 0);
        gemm(H, D, peer_wq + (size_t)layer * D * 2048, 2048, BIG, 2048, NT, 2048, D, nullptr, 0);
        k_peer_route<<<NT * 8, 128, 0, stream>>>(BIG, peer_k1 + (size_t)layer * 16384, peer_k2 + (size_t)layer * 16384, EIDX, GATE);
        k_peer_expert<<<NT, 256, 0, stream>>>(H, Xin, EIDX, GATE, peer_u + (size_t)layer * 16384 * 1024, peer_v + (size_t)layer * 16384 * 1024, Xout); };

    k_rms<<<NT, 256, 0, stream>>>(X, D, norm_mix_g, H, D, D, nullptr, 0, 0);
    gemm(H, D, gmlp_w_in, 4096, BIG, 4096, NT, 4096, D, nullptr, 0);
    k_rms<<<NT, 256, 0, stream>>>(BIG + 2048, 4096, gmlp_v_g, BIG + 2048, 4096, 2048, out + O_CV, NP, 2048);
    k_sgu<<<NT, 256, 0, stream>>>(BIG, gmlp_w_s, gmlp_b_s, G);
    gemm(G, 2048, gmlp_w_out, D, X1, D, NT, D, 2048, X, D);
    peer(X1, 0, X2);
    k_rms<<<NT, 256, 0, stream>>>(X2, D, norm_mix_g + D, H, D, D, nullptr, 0, 0);
    gemm(H, D, att_w_in, ATT_PROJ, BIG, ATT_PROJ, NT, ATT_PROJ, D, nullptr, 0);
    k_att_post<<<NT, 256, 0, stream>>>(BIG, att_qg, att_kg, att_ikg, TAB, Qn, Kn, Vn, QI, KI, WI, out);
    k_attend<false><<<NP, 256, ATT_SMEM, stream>>>(Qn, Kn, Vn, QI, KI, WI, nullptr, nullptr, nullptr, nullptr, O);
    k_samp_scores<<<dim3(129, 32), 128, 0, stream>>>(QI, WI, KI, cache_ik, page_table, SKEYS);
    k_attend<true><<<NS, 256, ATT_SMEM, stream>>>(Qn, Kn, Vn, QI, KI, WI, SKEYS, cache_k, cache_v, page_table, O);
    gemm(O, D, att_w_out, D, X3, D, NT, D, D, X2, D);
    peer(X3, 1, out + O_Y);
}
```

```cpp
#include <hip/hip_runtime.h>
#include <cstdio>
#include <cstdint>
#include <math.h>
namespace pg8 {
#define PG8_LAS __attribute__((address_space(3)))
typedef unsigned short bf16_t;
typedef short bf16x8 __attribute__((ext_vector_type(8)));
typedef float f32x4 __attribute__((ext_vector_type(4)));
typedef unsigned u32x4 __attribute__((ext_vector_type(4)));
constexpr int BM = 256, BK = 64, HALF = 128, HTB = HALF * BK * 2  , STAGE_BYTES = 8 * HTB, NXCD = 8, WGM = 8;

__host__ __device__ __forceinline__ int lds_byte(int r, int c) { const int st = (r >> 4) * 2 + (c >> 5), rr = r & 15, cc = c & 31, ob = rr * 64 + cc * 2; return st * 1024 + (ob ^ (((ob >> 9) & 1) << 5)); }
__host__ __device__ __forceinline__ void stage_rc(int b, int& R, int& C) { const int st = b / 1024, sb = b % 1024, swz = sb ^ (((sb >> 9) & 1) << 5); R = (st >> 1) * 16 + swz / 64; C = (st & 1) * 32 + (swz % 64) / 2; }
__host__ __device__ __forceinline__ int perm32(int rho) { const int n = rho >> 4, i = rho & 15; return 8 * (i >> 2) + 4 * n + (i & 3); }

struct Unit { int pm, pn; };
struct Gemm { const bf16_t* A; const bf16_t* Bt; int M, N, K; };

struct StaticOrder {
    int nM, nN, nwg, G, c;
    __host__ __device__ void init(int M, int N, int G_, int c_) { nM = M / BM; nN = N / BM; nwg = nM * nN; G = G_; c = c_; }
    __host__ __device__ bool next(int i, Unit& u) const {
        const long L = (long)i * G + c; if (L >= nwg) return false;
        int wgid = (int)L; { const int q = nwg / NXCD, r = nwg % NXCD, xcd = wgid % NXCD, off = wgid / NXCD; wgid = (xcd < r ? xcd * (q + 1) : r * (q + 1) + (xcd - r) * q) + off; }
        const int nig = WGM * nN, gid = wgid / nig, fm = gid * WGM, gsz = (nM - fm) < WGM ? (nM - fm) : WGM;
        u.pm = fm + ((wgid % nig) % gsz); u.pn = (wgid % nig) / gsz; return true;
    }
    __device__ __forceinline__ void a_ready(const Unit&) const {}
    __device__ __forceinline__ void done(const Unit&) const {}
};

__device__ __forceinline__ unsigned cvt_pk_bf16(float lo, float hi) { unsigned r; asm volatile("v_cvt_pk_bf16_f32 %0, %1, %2" : "=v"(r) : "v"(lo), "v"(hi)); return r; }
typedef float f32x2 __attribute__((ext_vector_type(2)));

__device__ __forceinline__ void ss_add(unsigned long long* p, float sq) { (void)__hip_atomic_fetch_add(p, (unsigned long long)(sq * 16777216.0f), __ATOMIC_RELAXED, __HIP_MEMORY_SCOPE_AGENT); }
__device__ __forceinline__ float ss_get(const unsigned long long* p) { return (float)*p * (1.0f / 16777216.0f); }
struct EpiUV { static constexpr bool PERM = true, AFTER_DRAIN = false;
    bf16_t* U; bf16_t* V; const float* ss0; unsigned long long* ssv; int do_at;
    __device__ __forceinline__ void operator()(const f32x4 (&acc)[2][2][4][2], const Unit& u, int wr, int wc, int fr, int fq) const {
        const int row0 = u.pm * BM + wr * 64 + fr; const bool isv = u.pn >= 8; bf16_t* base = isv ? V : U;
        const int col0 = (u.pn & 7) * BM + wc * 32 + 8 * fq;
#pragma unroll
        for (int ai = 0; ai < 2; ++ai)
#pragma unroll
            for (int m = 0; m < 4; ++m) { const int row = row0 + ai * HALF + m * 16; const float rs = rsqrtf(ss0[row] * (1.0f / 1024.0f) + 1e-6f); float sq = 0.f;
                bf16_t* rowp = base + (size_t)row * 2048 + col0;
#pragma unroll
                for (int bj = 0; bj < 2; ++bj) { const f32x4 v0 = acc[ai][bj][m][0] * rs, v1 = acc[ai][bj][m][1] * rs;
                    sq += (v0[0] * v0[0] + v0[1] * v0[1]) + (v0[2] * v0[2] + v0[3] * v0[3]) + (v1[0] * v1[0] + v1[1] * v1[1]) + (v1[2] * v1[2] + v1[3] * v1[3]);
                    u32x4 w; w.x = cvt_pk_bf16(v0[0], v0[1]); w.y = cvt_pk_bf16(v0[2], v0[3]); w.z = cvt_pk_bf16(v1[0], v1[1]); w.w = cvt_pk_bf16(v1[2], v1[3]);
                    *(u32x4*)(rowp + bj * HALF) = w; }
                if (isv) { sq += __shfl_xor(sq, 16); sq += __shfl_xor(sq, 32); if (fq == 0 && do_at) ss_add(ssv + row, sq); } }
    }
};
template <bool RB16> struct EpiResid { static constexpr bool PERM = true, AFTER_DRAIN = false;
    const void* R0; const void* R1; bf16_t* Xb; unsigned long long* ssout; int np, nt, do_at;
    __device__ __forceinline__ void operator()(const f32x4 (&acc)[2][2][4][2], const Unit& u, int wr, int wc, int fr, int fq) const {
        const int row0 = u.pm * BM + wr * 64 + fr, col0 = u.pn * BM + wc * 32 + 8 * fq;
#pragma unroll
        for (int ai = 0; ai < 2; ++ai)
#pragma unroll
            for (int m = 0; m < 4; ++m) { const int row = row0 + ai * HALF + m * 16; float sq = 0.f;
#pragma unroll
                for (int bj = 0; bj < 2; ++bj) { f32x4 r0 = (f32x4){0.f, 0.f, 0.f, 0.f}, r1 = r0;
                    if constexpr (RB16) { if (row < nt) { const u32x4 rw = *(const u32x4*)((const bf16_t*)R0 + (size_t)row * 1024 + col0 + bj * HALF);
                            r0 = (f32x4){__uint_as_float(rw.x << 16), __uint_as_float(rw.x & 0xffff0000u), __uint_as_float(rw.y << 16), __uint_as_float(rw.y & 0xffff0000u)};
                            r1 = (f32x4){__uint_as_float(rw.z << 16), __uint_as_float(rw.z & 0xffff0000u), __uint_as_float(rw.w << 16), __uint_as_float(rw.w & 0xffff0000u)}; } }
                    else { const float* rp = row < np ? (const float*)R0 + (size_t)row * 1024 : (row < nt ? (const float*)R1 + (size_t)(row - np) * 1024 : nullptr);
                        if (rp) { r0 = *(const f32x4*)(rp + col0 + bj * HALF); r1 = *(const f32x4*)(rp + col0 + bj * HALF + 4); } }
                    const f32x4 v0 = acc[ai][bj][m][0] + r0, v1 = acc[ai][bj][m][1] + r1;
                    sq += (v0[0] * v0[0] + v0[1] * v0[1]) + (v0[2] * v0[2] + v0[3] * v0[3]) + (v1[0] * v1[0] + v1[1] * v1[1]) + (v1[2] * v1[2] + v1[3] * v1[3]);
                    u32x4 w; w.x = cvt_pk_bf16(v0[0], v0[1]); w.y = cvt_pk_bf16(v0[2], v0[3]); w.z = cvt_pk_bf16(v1[0], v1[1]); w.w = cvt_pk_bf16(v1[2], v1[3]);
                    *(u32x4*)(Xb + (size_t)row * 1024 + col0 + bj * HALF) = w; }
                sq += __shfl_xor(sq, 16); sq += __shfl_xor(sq, 32); if (fq == 0 && do_at) ss_add(ssout + row, sq); }
    }
};
struct EpiScaleF32 { static constexpr bool PERM = false, AFTER_DRAIN = false;
    float* C; int ldc; const float* ss; int nparts; int pstride;
    __device__ __forceinline__ void operator()(const f32x4 (&acc)[2][2][4][2], const Unit& u, int wr, int wc, int fr, int fq) const {
        const int row0 = u.pm * BM + wr * 64 + fr, col0 = u.pn * BM + wc * 32 + 4 * fq;
#pragma unroll
        for (int ai = 0; ai < 2; ++ai)
#pragma unroll
            for (int m = 0; m < 4; ++m) { const int row = row0 + ai * HALF + m * 16; float sa = ss[row]; for (int pp = 1; pp < nparts; ++pp) sa += ss[(size_t)pp * pstride + row];
                const float rs = rsqrtf(sa * (1.0f / 1024.0f) + 1e-6f);
                float* rowp = C + (size_t)row * ldc + col0;
#pragma unroll
                for (int bj = 0; bj < 2; ++bj)
#pragma unroll
                    for (int n = 0; n < 2; ++n) *(f32x4*)(rowp + bj * HALF + n * 16) = acc[ai][bj][m][n] * rs; }
    }
};
struct EpiScaleBf16 { static constexpr bool PERM = true, AFTER_DRAIN = false;
    bf16_t* O; int ldc; const float* ss; int nparts; int pstride;
    __device__ __forceinline__ void operator()(const f32x4 (&acc)[2][2][4][2], const Unit& u, int wr, int wc, int fr, int fq) const {
        const int row0 = u.pm * BM + wr * 64 + fr, col0 = u.pn * BM + wc * 32 + 8 * fq;
#pragma unroll
        for (int ai = 0; ai < 2; ++ai)
#pragma unroll
            for (int m = 0; m < 4; ++m) { const int row = row0 + ai * HALF + m * 16; float sa = ss[row]; for (int pp = 1; pp < nparts; ++pp) sa += ss[(size_t)pp * pstride + row];
                const float rs = rsqrtf(sa * (1.0f / 1024.0f) + 1e-6f);
                bf16_t* rowp = O + (size_t)row * ldc + col0;
#pragma unroll
                for (int bj = 0; bj < 2; ++bj) { const f32x4 v0 = acc[ai][bj][m][0] * rs, v1 = acc[ai][bj][m][1] * rs;
                    u32x4 w; w.x = cvt_pk_bf16(v0[0], v0[1]); w.y = cvt_pk_bf16(v0[2], v0[3]); w.z = cvt_pk_bf16(v1[0], v1[1]); w.w = cvt_pk_bf16(v1[2], v1[3]);
                    *(u32x4*)(rowp + bj * HALF) = w; } }
    }
};
struct EpiScaleF16 { static constexpr bool PERM = true, AFTER_DRAIN = false;
    unsigned short* O; int ldc; const unsigned long long* ss;
    __device__ __forceinline__ static unsigned pkh(float a, float b) { typedef _Float16 h2 __attribute__((ext_vector_type(2))); h2 h; h[0] = (_Float16)a; h[1] = (_Float16)b; return __builtin_bit_cast(unsigned, h); }
    __device__ __forceinline__ void operator()(const f32x4 (&acc)[2][2][4][2], const Unit& u, int wr, int wc, int fr, int fq) const {
        const int row0 = u.pm * BM + wr * 64 + fr, col0 = u.pn * BM + wc * 32 + 8 * fq;
#pragma unroll
        for (int ai = 0; ai < 2; ++ai)
#pragma unroll
            for (int m = 0; m < 4; ++m) { const int row = row0 + ai * HALF + m * 16; const float rs = rsqrtf(ss_get(ss + row) * (1.0f / 1024.0f) + 1e-6f);
                unsigned short* rowp = O + (size_t)row * ldc + col0;
#pragma unroll
                for (int bj = 0; bj < 2; ++bj) { const f32x4 v0 = acc[ai][bj][m][0] * rs, v1 = acc[ai][bj][m][1] * rs;
                    u32x4 w; w.x = pkh(v0[0], v0[1]); w.y = pkh(v0[2], v0[3]); w.z = pkh(v1[0], v1[1]); w.w = pkh(v1[2], v1[3]);
                    *(u32x4*)(rowp + bj * HALF) = w; } }
    }
};
template <class Epi, class Sched, bool ALIGN_EPI = false, bool SP2 = false>
__device__ __forceinline__ void gemm_phase(PG8_LAS unsigned char* lds, const Gemm g, const Sched& S, const Epi& E) {
    const int tid = threadIdx.x, wid = __builtin_amdgcn_readfirstlane(tid >> 6), lane = tid & 63, wr = wid >> 2, wc = wid & 3, fr = lane & 15, fq = lane >> 4;
    const int K = g.K, nt = K / BK;
    unsigned voffA[2], voffB[2];
#pragma unroll
    for (int i = 0; i < 2; ++i) { int R, C; stage_rc(tid * 16 + i * 8192, R, C); const int Rb = Epi::PERM ? ((R & ~31) + perm32(R & 31)) : R;
        voffA[i] = (unsigned)(R * K + C) * 2u; voffB[i] = (unsigned)(Rb * K + C) * 2u; }
    const size_t kstep = (size_t)(BK * 2);
    const size_t hstep = (size_t)HALF * K * 2;
    const size_t tstep = 2 * hstep;
    const unsigned ldsw = (unsigned)wid * 1024u;
    const int aoff = lds_byte(wr * 64 + fr, fq * 8), boff = lds_byte(wc * 32 + fr, fq * 8);
#define PG8_SA(b, h) (((b) * 2 + (h)) * HTB)
#define PG8_SB(b, h) ((4 + (b) * 2 + (h)) * HTB)
#define PG8_STAGE(bufoff, gbase, voff) do { _Pragma("unroll") for (int _i = 0; _i < 2; ++_i) \
        __builtin_amdgcn_global_load_lds((const unsigned*)((const char*)(gbase) + (voff)[_i]), (PG8_LAS unsigned*)(lds + (bufoff) + ldsw + _i * 8192), 16, 0, 0); } while (0)
#define PG8_LDA(dst, b, h) do { _Pragma("unroll") for (int m = 0; m < 4; ++m) _Pragma("unroll") for (int k = 0; k < 2; ++k) dst[m][k] = *(const PG8_LAS bf16x8*)(lds + PG8_SA(b, h) + aoff + m * 2048 + k * 1024); } while (0)
#define PG8_LDB(dst, b, h) do { _Pragma("unroll") for (int n = 0; n < 2; ++n) _Pragma("unroll") for (int k = 0; k < 2; ++k) dst[n][k] = *(const PG8_LAS bf16x8*)(lds + PG8_SB(b, h) + boff + n * 2048 + k * 1024); } while (0)
#define PG8_MMA(ai, bj, At, Bt) do { __builtin_amdgcn_s_setprio(1); _Pragma("unroll") for (int m = 0; m < 4; ++m) _Pragma("unroll") for (int n = 0; n < 2; ++n) _Pragma("unroll") for (int k = 0; k < 2; ++k) \
        acc[ai][bj][m][n] = __builtin_amdgcn_mfma_f32_16x16x32_bf16(Bt[n][k], At[m][k], acc[ai][bj][m][n], 0, 0, 0); __builtin_amdgcn_s_setprio(0); } while (0)
#define PG8_WAIT_V(n) asm volatile("s_waitcnt vmcnt(" #n ")" ::: "memory")
#define PG8_WAIT_L(n) asm volatile("s_waitcnt lgkmcnt(" #n ")" ::: "memory")
#define PG8_BAR __builtin_amdgcn_s_barrier()
#define PG8_SCHED __builtin_amdgcn_sched_barrier(0)
    Unit cur, nxt; int ui = 0;
    if (!S.next(0, cur)) return;
    f32x4 acc[2][2][4][2];
#pragma unroll
    for (int a = 0; a < 2; ++a)
#pragma unroll
        for (int b = 0; b < 2; ++b)
#pragma unroll
            for (int m = 0; m < 4; ++m)
#pragma unroll
                for (int n = 0; n < 2; ++n) acc[a][b][m][n] = (f32x4){0.f, 0.f, 0.f, 0.f};
    bf16x8 At[4][2], B0[2][2], B1[2][2];
    const char* cA = (const char*)g.A + (size_t)cur.pm * tstep; const char* cB = (const char*)g.Bt + (size_t)cur.pn * tstep;
    S.a_ready(cur);
    if constexpr (SP2) {
        PG8_STAGE(PG8_SB(0, 0), cB, voffB); PG8_STAGE(PG8_SB(0, 1), cB + hstep, voffB); PG8_STAGE(PG8_SA(0, 0), cA, voffA); PG8_STAGE(PG8_SA(0, 1), cA + hstep, voffA);
        if (wr == 1) PG8_BAR;
        PG8_WAIT_V(2); PG8_BAR;
        PG8_STAGE(PG8_SB(1, 0), cB + kstep, voffB); PG8_STAGE(PG8_SA(1, 0), cA + kstep, voffA); PG8_STAGE(PG8_SB(1, 1), cB + hstep + kstep, voffB);
        PG8_WAIT_V(6); PG8_BAR;
    } else {
        PG8_STAGE(PG8_SB(0, 0), cB, voffB); PG8_STAGE(PG8_SA(0, 0), cA, voffA); PG8_STAGE(PG8_SB(0, 1), cB + hstep, voffB); PG8_STAGE(PG8_SA(0, 1), cA + hstep, voffA);
        if (wr == 1) PG8_BAR;
        PG8_WAIT_V(4); PG8_BAR;
        PG8_STAGE(PG8_SB(1, 0), cB + kstep, voffB); PG8_STAGE(PG8_SA(1, 0), cA + kstep, voffA); PG8_STAGE(PG8_SB(1, 1), cB + hstep + kstep, voffB);
        PG8_WAIT_V(6); PG8_BAR;
    }
    for (;;) {
        const bool has_next = S.next(ui + 1, nxt);
        const char* nA = has_next ? (const char*)g.A + (size_t)nxt.pm * tstep : cA; const char* nB = has_next ? (const char*)g.Bt + (size_t)nxt.pn * tstep : cB;
        for (int t = 0; t < nt; t += 2) {
            const bool last = (t == nt - 2);
            const char* a1 = cA + (size_t)(t + 1) * kstep;
            const char* a2 = last ? nA : cA + (size_t)(t + 2) * kstep; const char* b2 = last ? nB : cB + (size_t)(t + 2) * kstep;
            const char* a3 = a2 + kstep; const char* b3 = b2 + kstep;
            if (last && has_next) S.a_ready(nxt);
            if constexpr (SP2) {
            PG8_LDB(B0, 0, 0); PG8_LDB(B1, 0, 1); PG8_SCHED; PG8_LDA(At, 0, 0); PG8_STAGE(PG8_SA(1, 1), a1 + hstep, voffA);
            PG8_WAIT_V(8); PG8_WAIT_L(0); PG8_BAR; PG8_MMA(0, 0, At, B0); PG8_MMA(0, 1, At, B1); PG8_BAR; PG8_SCHED;
            PG8_LDA(At, 0, 1); PG8_STAGE(PG8_SB(0, 0), b2, voffB); PG8_STAGE(PG8_SB(0, 1), b2 + hstep, voffB); PG8_STAGE(PG8_SA(0, 0), a2, voffA);
            PG8_WAIT_V(8); PG8_WAIT_L(0); PG8_BAR; PG8_MMA(1, 0, At, B0); PG8_MMA(1, 1, At, B1); PG8_BAR; PG8_SCHED;
            PG8_LDB(B0, 1, 0); PG8_LDB(B1, 1, 1); PG8_SCHED; PG8_LDA(At, 1, 0); PG8_STAGE(PG8_SA(0, 1), a2 + hstep, voffA);
            PG8_WAIT_V(8); PG8_WAIT_L(0); PG8_BAR; PG8_MMA(0, 0, At, B0); PG8_MMA(0, 1, At, B1); PG8_BAR; PG8_SCHED;
            PG8_LDA(At, 1, 1); PG8_STAGE(PG8_SB(1, 0), b3, voffB); PG8_STAGE(PG8_SB(1, 1), b3 + hstep, voffB); PG8_STAGE(PG8_SA(1, 0), a3, voffA);
            PG8_WAIT_V(8); PG8_WAIT_L(0); PG8_BAR; PG8_MMA(1, 0, At, B0); PG8_MMA(1, 1, At, B1); PG8_BAR; PG8_SCHED;
            } else {
            PG8_LDB(B0, 0, 0); PG8_SCHED; PG8_LDA(At, 0, 0); PG8_STAGE(PG8_SA(1, 1), a1 + hstep, voffA);
            PG8_WAIT_L(8); PG8_BAR; PG8_WAIT_L(0); PG8_MMA(0, 0, At, B0); PG8_BAR; PG8_SCHED;
            PG8_LDB(B1, 0, 1); PG8_STAGE(PG8_SB(0, 0), b2, voffB);
            PG8_BAR; PG8_WAIT_L(0); PG8_MMA(0, 1, At, B1); PG8_BAR;
            PG8_LDA(At, 0, 1); PG8_STAGE(PG8_SA(0, 0), a2, voffA);
            PG8_BAR; PG8_WAIT_L(0); PG8_MMA(1, 0, At, B0); PG8_BAR; PG8_SCHED;
            PG8_STAGE(PG8_SB(0, 1), b2 + hstep, voffB);
            PG8_WAIT_V(6); PG8_BAR; PG8_MMA(1, 1, At, B1); PG8_BAR;
            PG8_LDB(B0, 1, 0); PG8_SCHED; PG8_LDA(At, 1, 0); PG8_STAGE(PG8_SA(0, 1), a2 + hstep, voffA);
            PG8_WAIT_L(8); PG8_BAR; PG8_WAIT_L(0); PG8_MMA(0, 0, At, B0); PG8_BAR; PG8_SCHED;
            PG8_LDB(B1, 1, 1); PG8_STAGE(PG8_SB(1, 0), b3, voffB);
            PG8_BAR; PG8_WAIT_L(0); PG8_MMA(0, 1, At, B1); PG8_BAR;
            PG8_LDA(At, 1, 1); PG8_STAGE(PG8_SA(1, 0), a3, voffA);
            PG8_BAR; PG8_WAIT_L(0); PG8_MMA(1, 0, At, B0); PG8_BAR; PG8_SCHED;
            PG8_STAGE(PG8_SB(1, 1), b3 + hstep, voffB);
            PG8_WAIT_V(6); PG8_BAR; PG8_MMA(1, 1, At, B1); PG8_BAR;
            }
        }
        if constexpr (ALIGN_EPI) { if (wr == 0) PG8_BAR; }
        if constexpr (!Epi::AFTER_DRAIN) { E(acc, cur, wr, wc, fr, fq); S.done(cur); }
        if (!has_next) break;
#pragma unroll
        for (int a = 0; a < 2; ++a)
#pragma unroll
            for (int b = 0; b < 2; ++b)
#pragma unroll
                for (int m = 0; m < 4; ++m)
#pragma unroll
                    for (int n = 0; n < 2; ++n) acc[a][b][m][n] = (f32x4){0.f, 0.f, 0.f, 0.f};
        cur = nxt; cA = nA; cB = nB; ++ui;
        if constexpr (ALIGN_EPI) { if (wr == 1) PG8_BAR; }
    }
    PG8_WAIT_V(0);
    if constexpr (!ALIGN_EPI) { if (wr == 0) PG8_BAR; }
    PG8_BAR;
    if constexpr (Epi::AFTER_DRAIN) { E.fused(acc, cur, wr, wc, fr, fq, lds, wid, lane); S.done(cur); }
#undef PG8_SA
#undef PG8_SB
#undef PG8_STAGE
#undef PG8_LDA
#undef PG8_LDB
#undef PG8_MMA
#undef PG8_WAIT_V
#undef PG8_WAIT_L
#undef PG8_BAR
#undef PG8_SCHED
}

}

#define GAS __attribute__((address_space(1)))
#define LAS __attribute__((address_space(3)))
typedef unsigned short bf16;
typedef unsigned v4u __attribute__((ext_vector_type(4)));
typedef unsigned v2u __attribute__((ext_vector_type(2)));
typedef float f32x4 __attribute__((ext_vector_type(4)));
typedef float f32x2 __attribute__((ext_vector_type(2)));
typedef float f32x16 __attribute__((ext_vector_type(16)));
typedef short bf16x8 __attribute__((ext_vector_type(8)));
typedef __bf16 bf16x2_t __attribute__((ext_vector_type(2)));
typedef GAS unsigned gu32;
typedef GAS unsigned long long gu64;
#define RLX_AGENT __ATOMIC_RELAXED, __HIP_MEMORY_SCOPE_AGENT
#define LDS_WAIT() asm volatile("s_waitcnt lgkmcnt(0)" ::: "memory")
#define VM_WAIT() asm volatile("s_waitcnt vmcnt(0)" ::: "memory")
__device__ __forceinline__ unsigned long long rt() { return __builtin_amdgcn_s_memrealtime(); }
__device__ __forceinline__ unsigned f2bf(float f) { unsigned u = __builtin_bit_cast(unsigned, f); return (u + 0x7fffu + ((u >> 16) & 1u)) >> 16; }
__device__ __forceinline__ unsigned pk2(float lo, float hi) { return f2bf(lo) | (f2bf(hi) << 16); }

#define XB_TMO      128
#define XB_XCNT(j)  (256  + 64 * (j))
#define XB_XSUB(j)  (1280 + 64 * (j))
#define XB_XGEN(j)  (2304 + 64 * (j))
#define XB_TOP      3328
#define XB_TOPGEN   3392
#define XCD_BAR_WORDS 3456
#define XB_SPIN_CAP (1u << 18)

__device__ __forceinline__ unsigned xb_ld(unsigned* p)              { return __hip_atomic_load(p, __ATOMIC_RELAXED, __HIP_MEMORY_SCOPE_AGENT); }
__device__ __forceinline__ unsigned xb_add(unsigned* p, unsigned v) { return __hip_atomic_fetch_add(p, v, __ATOMIC_RELAXED, __HIP_MEMORY_SCOPE_AGENT); }
__device__ __forceinline__ unsigned xb_xcc_id() { return (unsigned)__builtin_amdgcn_s_getreg((3 << 11) | 20) & 0xFu; }
#define XB_SPIN(cond, bar) do { unsigned _sp = 0; while (cond) { __builtin_amdgcn_s_sleep(1); \
    if ((++_sp & 255u) == 0u) { if (xb_ld(&(bar)[XB_TMO])) break; if (_sp > XB_SPIN_CAP) { atomicAdd(&(bar)[XB_TMO], 1u); break; } } } } while (0)

struct XcdBarrier {
    unsigned* bar; unsigned x;
    volatile LAS unsigned* st;
};

__device__ __forceinline__ XcdBarrier xcd_barrier_post(unsigned* bar, volatile LAS unsigned* st) {
    XcdBarrier b; b.bar = bar; b.x = xb_xcc_id(); b.st = st;
    if (threadIdx.x == 0) (void)xb_add(&bar[XB_XCNT(b.x)], 1u);
    return b;
}
__device__ __forceinline__ void xcd_barrier_complete(unsigned* bar, unsigned x, unsigned& nloc, unsigned& nx) {
    const unsigned G = gridDim.x * gridDim.y * gridDim.z;
    unsigned sum, cnt, mine, sp = 0u;
    for (;;) {
        sum = 0u; cnt = 0u; mine = 0u;
#pragma unroll
        for (unsigned j = 0; j < 16; ++j) { const unsigned c = xb_ld(&bar[XB_XCNT(j)]); sum += c; cnt += (c > 0u) ? 1u : 0u; mine = (j == x) ? c : mine; }
        if (sum == G) break;
        __builtin_amdgcn_s_sleep(1);
        if ((++sp & 255u) == 0u) { if (xb_ld(&bar[XB_TMO])) break; if (sp > XB_SPIN_CAP) { atomicAdd(&bar[XB_TMO], 1u); break; } }
    }
    nloc = mine > 0u ? mine : 1u; nx = cnt > 0u ? cnt : 1u;
}

__device__ __forceinline__ void xcd_barrier(const XcdBarrier& b) {
    asm volatile("s_waitcnt vmcnt(0)" ::: "memory");
    __syncthreads();
    if (threadIdx.x == 0) {
        unsigned* bar = b.bar;
        __builtin_amdgcn_s_waitcnt(0);
        unsigned nloc = b.st[0], nx = b.st[1];
        if (nloc == 0u) { xcd_barrier_complete(bar, b.x, nloc, nx); b.st[0] = nloc; b.st[1] = nx; }
        const unsigned old = xb_add(&bar[XB_XSUB(b.x)], 1u);
        const unsigned gen = old / nloc;
        if (old + 1u == (gen + 1u) * nloc) {
            __builtin_amdgcn_fence(__ATOMIC_RELEASE, "agent");
            asm volatile("s_waitcnt vmcnt(0)" ::: "memory");
            const unsigned og = xb_add(&bar[XB_TOP], 1u);
            const unsigned tg = og / nx;
            if (og + 1u == (tg + 1u) * nx) xb_add(&bar[XB_TOPGEN], 1u);
            else XB_SPIN(xb_ld(&bar[XB_TOPGEN]) == tg, bar);
            __builtin_amdgcn_fence(__ATOMIC_ACQUIRE, "agent");
            xb_add(&bar[XB_XGEN(b.x)], 1u);
            asm volatile("s_waitcnt vmcnt(0)" ::: "memory");
        } else {
            XB_SPIN(xb_ld(&bar[XB_XGEN(b.x)]) == gen, bar);
            __builtin_amdgcn_fence(__ATOMIC_ACQUIRE, "agent");
            asm volatile("s_waitcnt vmcnt(0)" ::: "memory");
        }
    }

    __syncthreads();
}

namespace mk {
constexpr int D = 1024, NP = 32768, NS = 32, NT = NP + NS, MP = 33024, SEQ = 4096;
constexpr int PAST = 16384, NPAGE = 128, APROJ = 2120, APAD = 2304;
constexpr int NWAVES = 8, NTHR = 512;
constexpr float EPS = 1e-6f;
constexpr float IDX_SCALE = 0.04419417382415922f;
constexpr float QSCALE = 0.125f * 1.4426950408889634f;
constexpr size_t O_Y = 0, O_KP = 33587200, O_VP = 41975808, O_IP = 50364416, O_KS = 52461568, O_VS = 52469760, O_IS = 52477952, O_CV = 52480000;
constexpr size_t A256(size_t x) { return (x + 255) & ~(size_t)255; }
constexpr size_t CTL_BYTES = 2u << 20;
constexpr int CW_BAR = 4096;
constexpr size_t W_SSV = 256u << 10, W_SS1 = 576u << 10, W_SS3 = 896u << 10, W_QC = 64u << 10;
constexpr size_t W_SS0 = CTL_BYTES;
constexpr size_t W_SS2 = W_SS0 + A256((size_t)MP * 4);
constexpr size_t W_X0B = W_SS2 + A256((size_t)8 * MP * 4);
constexpr size_t W_WIN0T = W_X0B + A256((size_t)MP * 1024 * 2);
constexpr size_t W_WOUT0T = W_WIN0T + A256((size_t)4096 * 1024 * 2);
constexpr size_t W_WP0T = W_WOUT0T + A256((size_t)1024 * 2048 * 2);
constexpr size_t W_WP1T = W_WP0T + A256((size_t)2048 * 1024 * 2);
constexpr size_t W_WIN1T = W_WP1T + A256((size_t)2048 * 1024 * 2);
constexpr size_t W_WOUT1T = W_WIN1T + A256((size_t)APAD * 1024 * 2);
constexpr size_t W_WSMT = W_WOUT1T + A256((size_t)1024 * 1024 * 2);
constexpr size_t W_ROPE = W_WSMT + A256((size_t)8 * 128 * 128 * 4);
constexpr size_t W_UB = W_ROPE + A256((size_t)4097 * 64 * 4);
constexpr size_t W_VB = W_UB + A256((size_t)2 * 16384 * 1024 * 2);
constexpr size_t W_SU = W_VB + A256((size_t)2 * 16384 * 1024 * 2);
constexpr size_t W_SV = W_SU + A256((size_t)2 * 16384 * 4);
constexpr size_t W_X1B = W_SV + A256((size_t)2 * 16384 * 4);
constexpr size_t W_X2B = W_X1B + A256((size_t)MP * 1024 * 2);
constexpr size_t W_X3B = W_X2B + A256((size_t)MP * 1024 * 2);
constexpr size_t W_X1 = W_X3B + A256((size_t)MP * 1024 * 2);
constexpr size_t W_X2 = W_X1 + A256((size_t)MP * 1024 * 4);
constexpr size_t W_X3 = W_X2 + A256((size_t)MP * 1024 * 4);
constexpr size_t W_BIG = W_X3 + A256((size_t)MP * 1024 * 4);
constexpr size_t BIG_BYTES = (size_t)NP * 4096 * 4;
constexpr size_t W_U0 = W_BIG, W_V0 = W_U0 + A256((size_t)MP * 2048 * 2), W_G0 = W_V0 + A256((size_t)MP * 2048 * 2);
static_assert(W_G0 + (size_t)MP * 2048 * 2 <= W_BIG + BIG_BYTES, "union");
static_assert((size_t)MP * APAD * 4 <= BIG_BYTES, "union");
constexpr size_t W_EIDX = W_BIG + A256(BIG_BYTES);
constexpr size_t W_GATE = W_EIDX + A256((size_t)MP * 128 * 4);
constexpr size_t W_QB = W_GATE + A256((size_t)MP * 128 * 4);
constexpr size_t W_KB = W_QB + A256((size_t)MP * 1024 * 2);
constexpr size_t W_V2B = W_KB + A256((size_t)MP * 256 * 2);
constexpr size_t W_QIB = W_V2B + A256((size_t)MP * 256 * 2);
constexpr size_t W_KIB = W_QIB + A256((size_t)MP * 512 * 2);
constexpr size_t W_WI = W_KIB + A256((size_t)MP * 64 * 2);
constexpr size_t W_SEL = W_WI + A256((size_t)MP * 8 * 4);
constexpr size_t W_SKEYS = W_SEL + A256((size_t)NP * 64 * 8);
constexpr size_t W_OB = W_SKEYS + A256((size_t)32 * 16640 * 4);
constexpr size_t W_VT = W_OB + A256((size_t)MP * 1024 * 2);
constexpr size_t W_XQ = W_VT + A256((size_t)NP * 256 * 2);
constexpr size_t W_RSX = W_XQ + A256((size_t)MP * 1024);
constexpr size_t W_ACT = W_RSX + A256((size_t)MP * 4);
constexpr size_t W_END = W_ACT + A256((size_t)MP * 128 * 4);
constexpr int RING_BYTES = 131072, MISC_OFF = RING_BYTES + 320, LDS_BYTES = 147456;

struct Params { const float* in[23]; float* out; unsigned char* ws; float inv[32]; int ph_lo, ph_hi; };

__device__ __forceinline__ float wave_sum(float v) {
#pragma unroll
    for (int o = 1; o < 64; o <<= 1) v += __shfl_xor(v, o);
    return v;
}
__device__ __forceinline__ float bflo(unsigned w) { return __uint_as_float(w << 16); }
__device__ __forceinline__ float bfhi(unsigned w) { return __uint_as_float(w & 0xffff0000u); }
__device__ __forceinline__ unsigned f2key(float f) { f = f + 0.0f; const unsigned u = __float_as_uint(f); return (u & 0x80000000u) ? ~u : (u | 0x80000000u); }
__device__ __forceinline__ float key2f(unsigned k) { const unsigned u = (k & 0x80000000u) ? (k & 0x7fffffffu) : ~k; return __uint_as_float(u); }
__device__ __forceinline__ float fast_exp2(float x) { return __builtin_amdgcn_exp2f(x); }
__device__ __forceinline__ float gelu_tanh(float x) {
    const float a = 0.7978845608028654f * (x + 0.044715f * x * x * x);
    const float e = fast_exp2(a * 2.8853900817779268f);
    const float t = 1.0f - 2.0f * __builtin_amdgcn_rcpf(1.0f + e);
    return 0.5f * x * (1.0f + t);
}
__device__ __forceinline__ unsigned long long lanemask_lt(int lane) { return (1ull << lane) - 1ull; }
__device__ __forceinline__ float dot2bf(unsigned a, unsigned b, float c) { return __builtin_amdgcn_fdot2_f32_bf16(__builtin_bit_cast(bf16x2_t, a), __builtin_bit_cast(bf16x2_t, b), c, false); }

__device__ __forceinline__ int xadd32i(int a, int b) { const auto r = __builtin_amdgcn_permlane32_swap((unsigned)a, (unsigned)b, false, false); return (int)r[0] + (int)r[1]; }
__device__ __forceinline__ int xadd16i(int a, int b) { const auto r = __builtin_amdgcn_permlane16_swap((unsigned)a, (unsigned)b, false, false); return (int)r[0] + (int)r[1]; }
__device__ __forceinline__ int ror8i(int v) { return __builtin_amdgcn_update_dpp(0, v, 0x128, 0xf, 0xf, false); }
__device__ __forceinline__ int sum8i(int t) { t += __builtin_amdgcn_update_dpp(0, t, 0xB1, 0xf, 0xf, false); t += __builtin_amdgcn_update_dpp(0, t, 0x4E, 0xf, 0xf, false); t += __builtin_amdgcn_update_dpp(0, t, 0x141, 0xf, 0xf, false); return t; }
__device__ __forceinline__ float wave_max_f(float m) {
    m = fmaxf(m, __int_as_float(__builtin_amdgcn_update_dpp(0, __float_as_int(m), 0x121, 0xf, 0xf, false))); m = fmaxf(m, __int_as_float(__builtin_amdgcn_update_dpp(0, __float_as_int(m), 0x122, 0xf, 0xf, false)));
    m = fmaxf(m, __int_as_float(__builtin_amdgcn_update_dpp(0, __float_as_int(m), 0x124, 0xf, 0xf, false))); m = fmaxf(m, __int_as_float(__builtin_amdgcn_update_dpp(0, __float_as_int(m), 0x128, 0xf, 0xf, false)));
    { const auto r = __builtin_amdgcn_permlane16_swap(__float_as_uint(m), __float_as_uint(m), false, false); m = fmaxf(__uint_as_float(r[0]), __uint_as_float(r[1])); }
    { const auto r = __builtin_amdgcn_permlane32_swap(__float_as_uint(m), __float_as_uint(m), false, false); m = fmaxf(__uint_as_float(r[0]), __uint_as_float(r[1])); }
    return m;
}
__device__ __forceinline__ unsigned cvtpk(float lo, float hi) { const f32x2 v = {lo, hi}; const bf16x2_t b = __builtin_convertvector(v, bf16x2_t); return __builtin_bit_cast(unsigned, b); }
__device__ __forceinline__ void p0_transpose_item(const float* W, int ldw, int K, int nblk, int Nvalid, const float* gain, bf16* WT, LAS float* scr, int item, int lane) {
    const int kb = item / nblk, nb = item % nblk, k0 = 64 * kb, n0 = 32 * nb;
    const int nn = n0 + (lane & 31); const bool ok = nn < Nvalid;
#pragma unroll 8
    for (int i = 0; i < 32; ++i) { const int kk = 2 * i + (lane >> 5); float v = ok ? W[(size_t)(k0 + kk) * ldw + nn] : 0.f; if (gain) v *= gain[k0 + kk]; scr[kk * 33 + (lane & 31)] = v; }
    LDS_WAIT(); asm volatile("" ::: "memory");
    const int c = lane & 7;
#pragma unroll
    for (int j = 0; j < 4; ++j) { const int n = (lane >> 3) + 8 * j; const LAS float* s = scr + (8 * c) * 33 + n;
        v4u o; o.x = pk2(s[0 * 33], s[1 * 33]); o.y = pk2(s[2 * 33], s[3 * 33]); o.z = pk2(s[4 * 33], s[5 * 33]); o.w = pk2(s[6 * 33], s[7 * 33]);
        *(GAS v4u*)(WT + (size_t)(n0 + n) * K + k0 + 8 * c) = o; }
    LDS_WAIT(); asm volatile("" ::: "memory");
}
__device__ __forceinline__ float p0_row(const float* src, const float* gain, bf16* dst, int lane) {
    f32x4 v[4]; float s = 0.f;
#pragma unroll
    for (int j = 0; j < 4; ++j) { v[j] = src ? *((const GAS f32x4*)src + lane + 64 * j) : (f32x4){0.f, 0.f, 0.f, 0.f}; s += (v[j].x * v[j].x + v[j].y * v[j].y) + (v[j].z * v[j].z + v[j].w * v[j].w); }
    if (gain) {
#pragma unroll
        for (int j = 0; j < 4; ++j) v[j] = v[j] * *((const GAS f32x4*)gain + lane + 64 * j); }
    GAS unsigned long long* o8 = (GAS unsigned long long*)dst + lane;
#pragma unroll
    for (int j = 0; j < 4; ++j) o8[64 * j] = (unsigned long long)pk2(v[j].x, v[j].y) | ((unsigned long long)pk2(v[j].z, v[j].w) << 32);
    return wave_sum(s);
}
__device__ __forceinline__ void p0_quant_row(const float* src, const float* gain, unsigned char* dst, float* scale_out, int bias, int lane, bool part = false, int erow = 0) {
    f32x4 v[4]; float am = 0.f;
#pragma unroll
    for (int j = 0; j < 4; ++j) { v[j] = *((const GAS f32x4*)src + lane * 4 + j); if (gain) v[j] = v[j] * *((const GAS f32x4*)gain + lane * 4 + j);
        am = fmaxf(am, fmaxf(fmaxf(fabsf(v[j].x), fabsf(v[j].y)), fmaxf(fabsf(v[j].z), fabsf(v[j].w)))); }
    am = wave_max_f(am);
    const float sc = am > 0.f ? am * (1.0f / 127.0f) : 1.0f, inv = 1.0f / sc;
    v4u w;
#pragma unroll
    for (int j = 0; j < 4; ++j) { unsigned pk = 0u;
#pragma unroll
        for (int e = 0; e < 4; ++e) { int q = (int)rintf(v[j][e] * inv); q = q > 127 ? 127 : (q < -127 ? -127 : q); pk |= ((unsigned)(q + bias) & 0xffu) << (8 * e); }
        w[j] = pk; }
    if (part) *(GAS v4u*)(dst + (size_t)(lane >> 3) * (16384 * 128) + (size_t)erow * 128 + (lane & 7) * 16) = w;
    else *((GAS v4u*)dst + lane) = w;
    if (lane == 0) *scale_out = sc;
}
struct RowIn { f32x4 v[4]; };
__device__ __forceinline__ void p0_rowq_load(RowIn& R, const float* src, int lane) {
#pragma unroll
    for (int j = 0; j < 4; ++j) R.v[j] = *((const GAS f32x4*)src + lane * 4 + j);
}
__device__ __forceinline__ void p0_rowq_store(const RowIn& R, const float* gain, unsigned char* dst, float* scale_out, int lane, bool part, int erow) {
    f32x4 v[4]; float am = 0.f;
#pragma unroll
    for (int j = 0; j < 4; ++j) { v[j] = R.v[j]; if (gain) v[j] = v[j] * *((const GAS f32x4*)gain + lane * 4 + j);
        am = fmaxf(am, fmaxf(fmaxf(fabsf(v[j].x), fabsf(v[j].y)), fmaxf(fabsf(v[j].z), fabsf(v[j].w)))); }
    am = wave_max_f(am);
    const float sc = am > 0.f ? am * (1.0f / 127.0f) : 1.0f, inv = 1.0f / sc;
    v4u w;
#pragma unroll
    for (int j = 0; j < 4; ++j) { unsigned pk = 0u;
#pragma unroll
        for (int e = 0; e < 4; ++e) { int q = (int)rintf(v[j][e] * inv); q = q > 127 ? 127 : (q < -127 ? -127 : q); pk |= ((unsigned)q & 0xffu) << (8 * e); }
        w[j] = pk; }
    if (part) *(GAS v4u*)(dst + (size_t)(lane >> 3) * (16384 * 128) + (size_t)erow * 128 + (lane & 7) * 16) = w;
    else *((GAS v4u*)dst + lane) = w;
    if (lane == 0) *scale_out = sc;
}
__device__ __forceinline__ void p0_rowx_load(RowIn& R, const float* src, int lane) {
#pragma unroll
    for (int j = 0; j < 4; ++j) R.v[j] = src ? *((const GAS f32x4*)src + lane + 64 * j) : (f32x4){0.f, 0.f, 0.f, 0.f};
}
__device__ __forceinline__ float p0_rowx_store(const RowIn& R, bf16* dst, int lane) {
    float s = 0.f;
#pragma unroll
    for (int j = 0; j < 4; ++j) s += (R.v[j].x * R.v[j].x + R.v[j].y * R.v[j].y) + (R.v[j].z * R.v[j].z + R.v[j].w * R.v[j].w);
    GAS unsigned long long* o8 = (GAS unsigned long long*)dst + lane;
#pragma unroll
    for (int j = 0; j < 4; ++j) o8[64 * j] = (unsigned long long)pk2(R.v[j].x, R.v[j].y) | ((unsigned long long)pk2(R.v[j].z, R.v[j].w) << 32);
    return wave_sum(s);
}
__device__ __forceinline__ void p0_wp_item(const float* wq, const float* subk, const float* gain, bf16* WT, int col0, int j0, LAS float* scr, int lane) {
#pragma unroll 4
    for (int i = 0; i < 32; ++i) { const int idx = i * 64 + lane, jj = idx >> 7, d = idx & 127; scr[d * 16 + jj] = wq[(size_t)(j0 + jj) * 2048 + col0 + d] * gain[j0 + jj]; }
    LDS_WAIT(); asm volatile("" ::: "memory");
    float a0[16], a1[16];
#pragma unroll
    for (int i = 0; i < 16; ++i) { a0[i] = 0.f; a1[i] = 0.f; }
    const float* r0 = subk + (size_t)lane * 128; const float* r1 = subk + (size_t)(lane + 64) * 128;
#pragma unroll 1
    for (int d8 = 0; d8 < 4; ++d8) {
      f32x4 xs[8], ys[8];
#pragma unroll
      for (int u = 0; u < 8; ++u) { xs[u] = *(const GAS f32x4*)(r0 + (d8 * 8 + u) * 4); ys[u] = *(const GAS f32x4*)(r1 + (d8 * 8 + u) * 4); }
#pragma unroll
      for (int u = 0; u < 8; ++u) { const int d4 = d8 * 8 + u;
        const f32x4 x = xs[u], y = ys[u];
#pragma unroll
        for (int dd = 0; dd < 4; ++dd) { const LAS f32x4* wv = (const LAS f32x4*)(scr + (d4 * 4 + dd) * 16);
#pragma unroll
            for (int q = 0; q < 4; ++q) { const f32x4 w = wv[q];
#pragma unroll
                for (int e = 0; e < 4; ++e) { a0[q * 4 + e] += x[dd] * w[e]; a1[q * 4 + e] += y[dd] * w[e]; } } }
      }
    }
    { v4u o0, o1; o0.x = pk2(a0[0], a0[1]); o0.y = pk2(a0[2], a0[3]); o0.z = pk2(a0[4], a0[5]); o0.w = pk2(a0[6], a0[7]); o1.x = pk2(a0[8], a0[9]); o1.y = pk2(a0[10], a0[11]); o1.z = pk2(a0[12], a0[13]); o1.w = pk2(a0[14], a0[15]);
      GAS v4u* p = (GAS v4u*)(WT + (size_t)(col0 + lane) * 1024 + j0); p[0] = o0; p[1] = o1; }
    { v4u o0, o1; o0.x = pk2(a1[0], a1[1]); o0.y = pk2(a1[2], a1[3]); o0.z = pk2(a1[4], a1[5]); o0.w = pk2(a1[6], a1[7]); o1.x = pk2(a1[8], a1[9]); o1.y = pk2(a1[10], a1[11]); o1.z = pk2(a1[12], a1[13]); o1.w = pk2(a1[14], a1[15]);
      GAS v4u* p = (GAS v4u*)(WT + (size_t)(col0 + lane + 64) * 1024 + j0); p[0] = o0; p[1] = o1; }
    LDS_WAIT(); asm volatile("" ::: "memory");
}

#define ROWMAX16(m) do { m = max(m, (unsigned)__builtin_amdgcn_update_dpp(0, (int)m, 0x121, 0xf, 0xf, false)); m = max(m, (unsigned)__builtin_amdgcn_update_dpp(0, (int)m, 0x122, 0xf, 0xf, false)); \
    m = max(m, (unsigned)__builtin_amdgcn_update_dpp(0, (int)m, 0x124, 0xf, 0xf, false)); m = max(m, (unsigned)__builtin_amdgcn_update_dpp(0, (int)m, 0x128, 0xf, 0xf, false)); } while (0)
#define ROWSUM16F(s) do { s += __int_as_float(__builtin_amdgcn_update_dpp(0, __float_as_int(s), 0x121, 0xf, 0xf, false)); s += __int_as_float(__builtin_amdgcn_update_dpp(0, __float_as_int(s), 0x122, 0xf, 0xf, false)); \
    s += __int_as_float(__builtin_amdgcn_update_dpp(0, __float_as_int(s), 0x124, 0xf, 0xf, false)); s += __int_as_float(__builtin_amdgcn_update_dpp(0, __float_as_int(s), 0x128, 0xf, 0xf, false)); } while (0)
__device__ __forceinline__ unsigned top16_of_128(unsigned (&x)[8], int sub) {
#define CE(i, j) do { const unsigned hi_ = max(x[i], x[j]), lo_ = min(x[i], x[j]); x[i] = hi_; x[j] = lo_; } while (0)
    CE(0, 1); CE(2, 3); CE(4, 5); CE(6, 7);
    CE(0, 2); CE(1, 3); CE(4, 6); CE(5, 7);
    CE(1, 2); CE(5, 6); CE(0, 4); CE(3, 7);
    CE(1, 5); CE(2, 6);
    CE(1, 4); CE(3, 6);
    CE(2, 4); CE(3, 5);
    CE(3, 4);
#undef CE
    unsigned res = 0u;
#pragma unroll
    for (int r = 0; r < 16; ++r) {
        unsigned m = x[0];
        ROWMAX16(m);
        res = (sub == r) ? m : res;
        const bool win = (x[0] == m);
#pragma unroll
        for (int i = 0; i < 7; ++i) x[i] = win ? x[i + 1] : x[i];
        x[7] = win ? 0u : x[7];
    }
    return res;
}
struct RouteIn { f32x4 a, b, c, d; };
__device__ __forceinline__ void peer_route_load(RouteIn& R, const unsigned short* S, int task, int lane) {
    const int sub = lane & 15, grp = lane >> 4, p = task * 4 + grp, tok = p >> 3, h = p & 7;
    const unsigned short* sp = S + (size_t)tok * 2048 + h * 256 + sub * 8;
    typedef _Float16 h8 __attribute__((ext_vector_type(8)));
    const h8 x = *(const GAS h8*)sp, y = *(const GAS h8*)(sp + 128);
    R.a = (f32x4){(float)x[0], (float)x[1], (float)x[2], (float)x[3]}; R.b = (f32x4){(float)x[4], (float)x[5], (float)x[6], (float)x[7]};
    R.c = (f32x4){(float)y[0], (float)y[1], (float)y[2], (float)y[3]}; R.d = (f32x4){(float)y[4], (float)y[5], (float)y[6], (float)y[7]};
}
__device__ __forceinline__ void peer_route_core(const RouteIn& R, unsigned* EIDX, float* GATE, int tok, int h, int lane) {
    const int sub = lane & 15;
    unsigned x1[8], x2[8];
    { const f32x4 a = R.a, b = R.b, c = R.c, d = R.d;
#pragma unroll
      for (int i = 0; i < 4; ++i) { x1[i] = (f2key(a[i]) & ~127u) | (unsigned)(127 - (sub * 8 + i)); x1[4 + i] = (f2key(b[i]) & ~127u) | (unsigned)(127 - (sub * 8 + 4 + i));
                                    x2[i] = (f2key(c[i]) & ~127u) | (unsigned)(127 - (sub * 8 + i)); x2[4 + i] = (f2key(d[i]) & ~127u) | (unsigned)(127 - (sub * 8 + 4 + i)); } }
    const unsigned r1 = top16_of_128(x1, sub), r2 = top16_of_128(x2, sub);
    const float v1 = key2f(r1 & ~127u), v2 = key2f(r2 & ~127u); const int i1 = 127 - (int)(r1 & 127u), i2 = 127 - (int)(r2 & 127u);
    unsigned c[8];
    const int La = (sub == 0 || sub == 1) ? 8 : (sub == 2 ? 5 : (sub == 3 ? 4 : (sub == 4 ? 3 : (sub < 8 ? 2 : 1))));
#pragma unroll
    for (int j = 0; j < 8; ++j) { const float vj = __shfl(v2, (lane & 48) | j); c[j] = (j < La) ? ((f2key(v1 + vj) & ~255u) | (unsigned)((15 - sub) << 4) | (unsigned)(15 - j)) : 0u; }
    { const float v10 = __shfl(v1, lane & 48); if (sub >= 8) { const unsigned extra = (f2key(v10 + v2) & ~255u) | (unsigned)(15 << 4) | (unsigned)(15 - sub);
          const unsigned hi_ = max(c[0], extra), lo_ = min(c[0], extra); c[0] = hi_; c[1] = lo_; } }
    unsigned res = 0u;
#pragma unroll
    for (int r = 0; r < 16; ++r) {
        unsigned m = c[0]; ROWMAX16(m);
        res = (sub == r) ? m : res;
        const bool win = (c[0] == m);
#pragma unroll
        for (int j = 0; j < 7; ++j) c[j] = win ? c[j + 1] : c[j];
        c[7] = win ? 0u : c[7];
    }
    const float ts = key2f(res & ~255u); const int a = 15 - (int)((res >> 4) & 15u), b = 15 - (int)(res & 15u);
    const int ia = __shfl(i1, (lane & 48) | a), ib = __shfl(i2, (lane & 48) | b);
    unsigned mk = f2key(ts); ROWMAX16(mk); const float mx = key2f(mk);
    const float e = fast_exp2((ts - mx) * 1.4426950408889634f); float sum = e; ROWSUM16F(sum);
    { const int j = h * 16 + sub, pos = (j & 64) + (j & 7) * 8 + ((j >> 3) & 7);
      if (tok < NT) { EIDX[(size_t)tok * 128 + pos] = (unsigned)(ia * 128 + ib); GATE[(size_t)tok * 128 + pos] = e / sum; } }
}

__device__ __forceinline__ void peer_route_task(const RouteIn& R, unsigned* EIDX, float* GATE, int task, int lane) { const int p = task * 4 + (lane >> 4); peer_route_core(R, EIDX, GATE, p >> 3, p & 7, lane); }
struct OneUnit : pg8::StaticOrder { int k;
    __device__ __forceinline__ bool next(int i, pg8::Unit& u) const { return i == 0 && pg8::StaticOrder::next(k, u); } };
struct EpiRoute { static constexpr bool PERM = true, AFTER_DRAIN = true;
    const unsigned long long* ss; unsigned* EIDX; float* GATE;
    __device__ __forceinline__ void fused(f32x4 (&acc)[2][2][4][2], const pg8::Unit& u, int wr, int wc, int fr, int fq, LAS unsigned char* tile, int wid, int lane) const {
#pragma unroll
        for (int ai = 0; ai < 2; ++ai)
#pragma unroll
            for (int m = 0; m < 4; ++m) { const int row = ai * 128 + wr * 64 + m * 16 + fr; const float rs = rsqrtf(pg8::ss_get(ss + u.pm * 256 + row) * (1.0f / 1024.0f) + EPS);
#pragma unroll
                for (int bj = 0; bj < 2; ++bj) { const f32x4 v0 = acc[ai][bj][m][0] * rs, v1 = acc[ai][bj][m][1] * rs; v4u w;
                    w.x = pg8::EpiScaleF16::pkh(v0[0], v0[1]); w.y = pg8::EpiScaleF16::pkh(v0[2], v0[3]); w.z = pg8::EpiScaleF16::pkh(v1[0], v1[1]); w.w = pg8::EpiScaleF16::pkh(v1[2], v1[3]);
                    const int ci = bj * 16 + wc * 4 + fq; *(LAS v4u*)(tile + row * 512 + ((ci ^ (row & 7)) * 16)) = w; } }
        asm volatile("s_waitcnt lgkmcnt(0)" ::: "memory"); __builtin_amdgcn_s_barrier(); asm volatile("" ::: "memory");
        const int sub = lane & 15, grp = lane >> 4;
#pragma unroll 1
        for (int tk = wid; tk < 64; tk += 8) { const int row = tk * 4 + grp; const LAS unsigned char* rp = tile + row * 512; const int sw = sub ^ (row & 7);
            typedef _Float16 h8 __attribute__((ext_vector_type(8)));
            const h8 x = *(const LAS h8*)(rp + sw * 16), y = *(const LAS h8*)(rp + 256 + sw * 16);
            RouteIn R; R.a = (f32x4){(float)x[0], (float)x[1], (float)x[2], (float)x[3]}; R.b = (f32x4){(float)x[4], (float)x[5], (float)x[6], (float)x[7]};
            R.c = (f32x4){(float)y[0], (float)y[1], (float)y[2], (float)y[3]}; R.d = (f32x4){(float)y[4], (float)y[5], (float)y[6], (float)y[7]};
            peer_route_core(R, EIDX, GATE, u.pm * 256 + row, u.pn, lane); }
        asm volatile("s_waitcnt lgkmcnt(0)" ::: "memory"); __builtin_amdgcn_s_barrier(); asm volatile("" ::: "memory");
    }
};
struct XqIn { f32x4 xv[4]; float ss; };
__device__ __forceinline__ void peer_xq_load(XqIn& R, const bf16* X, const unsigned long long* ss, int tok, int lane) {
    const v4u a = *(const GAS v4u*)(X + (size_t)tok * 1024 + lane * 16), b = *(const GAS v4u*)(X + (size_t)tok * 1024 + lane * 16 + 8);
    R.xv[0] = (f32x4){bflo(a.x), bfhi(a.x), bflo(a.y), bfhi(a.y)}; R.xv[1] = (f32x4){bflo(a.z), bfhi(a.z), bflo(a.w), bfhi(a.w)};
    R.xv[2] = (f32x4){bflo(b.x), bfhi(b.x), bflo(b.y), bfhi(b.y)}; R.xv[3] = (f32x4){bflo(b.z), bfhi(b.z), bflo(b.w), bfhi(b.w)};
    R.ss = pg8::ss_get(ss + tok);
}
__device__ __forceinline__ void peer_xq_token(const XqIn& R, unsigned char* XQ, float* RSX, int tok, int lane) {
    float am = 0.f;
#pragma unroll
    for (int j = 0; j < 4; ++j) am = fmaxf(am, fmaxf(fmaxf(fabsf(R.xv[j].x), fabsf(R.xv[j].y)), fmaxf(fabsf(R.xv[j].z), fabsf(R.xv[j].w))));
    am = wave_max_f(am);
    const float sx = am > 0.f ? am * (1.0f / 127.0f) : 1.0f, isx = 1.0f / sx;
    v4u w;
#pragma unroll
    for (int j = 0; j < 4; ++j) { unsigned pk = 0u;
#pragma unroll
        for (int e = 0; e < 4; ++e) { const int q = (int)rintf(R.xv[j][e] * isx); pk |= ((unsigned)q & 0xffu) << (8 * e); }
        w[j] = pk; }
    *((GAS v4u*)(XQ + (size_t)tok * 1024) + lane) = w;
    if (lane == 0) RSX[tok] = rsqrtf(R.ss * (1.0f / 1024.0f) + EPS) * sx;
}
struct E1Set { v4u uu[8]; v4u xw; float rs, su, sv, gt; int tokj; };
__device__ __forceinline__ void e1_load(E1Set& S, const LAS unsigned* wl, int b, int ts, const unsigned char* XQ, const float* RSX, const float* GATE, const unsigned char* U8, const float* SU, const float* SV, int lane) {
    const unsigned d = (unsigned)__builtin_amdgcn_readfirstlane((int)wl[2048 + b]); const int start = (int)(d & 0xffffu), n = (int)((d >> 16) & 0xffu), tok = ts + (int)(d >> 24), grp = (lane >> 3) & 7;
    const unsigned ev8 = wl[start + (lane & 7)];
#pragma unroll
    for (int i = 0; i < 8; ++i) { S.uu[i] = (v4u){0u, 0u, 0u, 0u}; if (i < n) { const unsigned e = (unsigned)__builtin_amdgcn_readlane((int)ev8, i); S.uu[i] = *((const GAS v4u*)(U8 + (size_t)e * 1024) + lane); } }
    S.xw = *((const GAS v4u*)(XQ + (size_t)tok * 1024) + lane); S.rs = RSX[tok];
    S.tokj = -1; S.su = 0.f; S.sv = 0.f; S.gt = 0.f;
    if (grp < n) { const unsigned ek = wl[start + grp], jk = wl[1024 + start + grp] & 0xffu; S.tokj = tok * 128 + (int)jk; S.su = SU[ek]; S.sv = SV[ek]; S.gt = GATE[(size_t)tok * 128 + jk]; }
}
__device__ __forceinline__ void e1_compute(const E1Set& S, float* ACT, int lane) {
    const int b5 = (lane >> 5) & 1, b4 = (lane >> 4) & 1, b3 = (lane >> 3) & 1; int p[8];
#pragma unroll
    for (int i = 0; i < 8; ++i) { int d = __builtin_amdgcn_sdot4((int)S.uu[i].x, (int)S.xw.x, 0, false); d = __builtin_amdgcn_sdot4((int)S.uu[i].y, (int)S.xw.y, d, false);
        d = __builtin_amdgcn_sdot4((int)S.uu[i].z, (int)S.xw.z, d, false); d = __builtin_amdgcn_sdot4((int)S.uu[i].w, (int)S.xw.w, d, false); p[i] = d; }
    const int r0 = xadd32i(p[0], p[4]), r1 = xadd32i(p[1], p[5]), r2 = xadd32i(p[2], p[6]), r3 = xadd32i(p[3], p[7]);
    const int q0 = xadd16i(r0, r2), q1 = xadd16i(r1, r3);
    int t = (b3 ? q1 : q0) + ror8i(b3 ? q0 : q1);
    t = sum8i(t); (void)b5; (void)b4;
    if (S.tokj >= 0 && (lane & 7) == 0) ACT[S.tokj] = S.gt * gelu_tanh(S.rs * S.su * (float)t) * S.sv;
}
__device__ __forceinline__ void peer_e1_chunk(const unsigned char* XQ, const float* RSX, const unsigned* EIDX, const float* GATE, const unsigned char* U8, const float* SU, const float* SV,
                                              float* ACT, LAS unsigned* wl, int t0, int t1, int pi, int lane) {
    const unsigned long long lt = lanemask_lt(lane);
#pragma unroll 1
    for (int ts = t0; ts < t1; ts += 8) {
        const int nt = (t1 - ts) < 8 ? (t1 - ts) : 8;
        unsigned ee[8][2];
#pragma unroll
        for (int tl = 0; tl < 8; ++tl) { ee[tl][0] = 0xffffffffu; ee[tl][1] = 0xffffffffu; if (tl < nt) { ee[tl][0] = EIDX[(size_t)(ts + tl) * 128 + lane]; ee[tl][1] = EIDX[(size_t)(ts + tl) * 128 + 64 + lane]; } }
        int nent = 0, nbat = 0;
#pragma unroll
        for (int tl = 0; tl < 8; ++tl) {
            const bool s0 = (int)(ee[tl][0] >> 11) == pi, s1 = (int)(ee[tl][1] >> 11) == pi;
            const unsigned long long m0 = __ballot(s0), m1 = __ballot(s1);
            const int c0 = __builtin_popcountll(m0), c = c0 + __builtin_popcountll(m1);
            if (s0) { const int p = nent + __builtin_popcountll(m0 & lt); wl[p] = ee[tl][0]; wl[1024 + p] = (unsigned)lane; }
            if (s1) { const int p = nent + c0 + __builtin_popcountll(m1 & lt); wl[p] = ee[tl][1]; wl[1024 + p] = (unsigned)(64 + lane); }
            const int nb = (c + 7) >> 3;
            if (lane < nb) { const int rem = c - 8 * lane; wl[2048 + nbat + lane] = (unsigned)(nent + 8 * lane) | ((unsigned)(rem < 8 ? rem : 8) << 16) | ((unsigned)tl << 24); }
            nent += c; nbat += nb;
        }
        LDS_WAIT(); asm volatile("" ::: "memory");
        if (nbat > 0) {
            E1Set A, B;
            e1_load(A, wl, 0, ts, XQ, RSX, GATE, U8, SU, SV, lane);
#pragma unroll 1
            for (int b = 0; b < nbat; b += 2) {
                if (b + 1 < nbat) e1_load(B, wl, b + 1, ts, XQ, RSX, GATE, U8, SU, SV, lane);
                e1_compute(A, ACT, lane);
                if (b + 1 >= nbat) break;
                if (b + 2 < nbat) e1_load(A, wl, b + 2, ts, XQ, RSX, GATE, U8, SU, SV, lane);
                e1_compute(B, ACT, lane);
            }
        }
        LDS_WAIT(); asm volatile("" ::: "memory");
    }
}
__device__ __forceinline__ void e2_accum4(const v4u& d0v, const v4u& d1v, const v4u& d2v, const v4u& d3v, int W4, int (&y)[16]) {
#pragma unroll
    for (int k = 0; k < 4; ++k) { const unsigned d0 = d0v[k], d1 = d1v[k], d2 = d2v[k], d3 = d3v[k];
        const unsigned p01l = __builtin_amdgcn_perm(d1, d0, 0x05010400u), p01h = __builtin_amdgcn_perm(d1, d0, 0x07030602u);
        const unsigned p23l = __builtin_amdgcn_perm(d3, d2, 0x05010400u), p23h = __builtin_amdgcn_perm(d3, d2, 0x07030602u);
        y[4 * k + 0] = __builtin_amdgcn_sdot4((int)__builtin_amdgcn_perm(p23l, p01l, 0x05040100u), W4, y[4 * k + 0], false);
        y[4 * k + 1] = __builtin_amdgcn_sdot4((int)__builtin_amdgcn_perm(p23l, p01l, 0x07060302u), W4, y[4 * k + 1], false);
        y[4 * k + 2] = __builtin_amdgcn_sdot4((int)__builtin_amdgcn_perm(p23h, p01h, 0x05040100u), W4, y[4 * k + 2], false);
        y[4 * k + 3] = __builtin_amdgcn_sdot4((int)__builtin_amdgcn_perm(p23h, p01h, 0x07060302u), W4, y[4 * k + 3], false); }
}
struct E2Meta { f32x4 a[4]; unsigned x; };
template <bool HAS_B> __device__ __forceinline__ void e2_finish(const v4u (&V)[16], const E2Meta& M, float* Xo, bf16* Xob, float* sso, int tok, int pi, int col, int lane) {
    const int b3 = (lane >> 3) & 1;
    int y[16];
#pragma unroll
    for (int i = 0; i < 16; ++i) y[i] = 0;
    float am = 0.f;
#pragma unroll
    for (int i = 0; i < 4; ++i) am = fmaxf(am, fmaxf(fmaxf(fabsf(M.a[i].x), fabsf(M.a[i].y)), fmaxf(fabsf(M.a[i].z), fabsf(M.a[i].w))));
    am = wave_max_f(am);
    const float sw = am > 0.f ? am * (1.0f / 127.0f) : 1.0f, isw = 1.0f / sw;
#pragma unroll
    for (int g4 = 0; g4 < 4; ++g4) { const f32x4 a = M.a[g4];
        const int W4 = (int)(((unsigned)(int)rintf(a.x * isw) & 0xffu) | (((unsigned)(int)rintf(a.y * isw) & 0xffu) << 8) | (((unsigned)(int)rintf(a.z * isw) & 0xffu) << 16) | ((unsigned)(int)rintf(a.w * isw) << 24));
        e2_accum4(V[4 * g4], V[4 * g4 + 1], V[4 * g4 + 2], V[4 * g4 + 3], W4, y); }
    int z8[8];
#pragma unroll
    for (int i = 0; i < 8; ++i) z8[i] = (b3 ? y[8 + i] : y[i]) + ror8i(b3 ? y[i] : y[8 + i]);
    int z4[4];
#pragma unroll
    for (int i = 0; i < 4; ++i) z4[i] = xadd16i(z8[i], z8[4 + i]);
    int z2[2];
#pragma unroll
    for (int i = 0; i < 2; ++i) z2[i] = xadd32i(z4[i], z4[2 + i]);
    const float o0 = bflo(M.x) + sw * (float)z2[0], o1 = bfhi(M.x) + sw * (float)z2[1];
    if constexpr (!HAS_B) *(GAS f32x2*)(Xo + (size_t)tok * 1024 + col) = (f32x2){o0, o1};
    if constexpr (HAS_B) { *(GAS unsigned*)(Xob + (size_t)tok * 1024 + col) = pk2(o0, o1);
        float sq = o0 * o0 + o1 * o1; ROWSUM16F(sq);
        const float tot = (__int_as_float(__builtin_amdgcn_readlane(__float_as_int(sq), 0)) + __int_as_float(__builtin_amdgcn_readlane(__float_as_int(sq), 16))) + (__int_as_float(__builtin_amdgcn_readlane(__float_as_int(sq), 32)) + __int_as_float(__builtin_amdgcn_readlane(__float_as_int(sq), 48)));
        if (lane == 0) sso[(size_t)pi * MP + tok] = tot; }
}
template <bool HAS_B> __device__ __forceinline__ void peer_e2_chunk(const bf16* X, const unsigned* EIDX, const float* ACT, const unsigned char* V8, float* Xo, bf16* Xob, float* sso, int t0, int t1, int pi, int lane) {
    const int grp = lane >> 3, l8 = lane & 7, b3 = (lane >> 3) & 1, b4 = (lane >> 4) & 1, b5 = (lane >> 5) & 1;
    const int col = pi * 128 + l8 * 16 + b3 * 8 + b4 * 4 + b5 * 2;
    const unsigned char* vb = V8 + (size_t)pi * (16384 * 128) + l8 * 16;
    v4u vA[16], vB[16]; E2Meta mA, mB; v4u eN[4];
#define E2_LOADE(T) do { const GAS v4u* ep = (const GAS v4u*)(EIDX + (size_t)(T) * 128 + grp * 8); eN[0] = ep[0]; eN[1] = ep[1]; eN[2] = ep[16]; eN[3] = ep[17]; } while (0)
#define E2_META(T, M) do { const GAS f32x4* apn = (const GAS f32x4*)(ACT + (size_t)(T) * 128 + grp * 8); M.a[0] = apn[0]; M.a[1] = apn[1]; M.a[2] = apn[16]; M.a[3] = apn[17]; \
        M.x = *(const GAS unsigned*)(X + (size_t)(T) * 1024 + col); } while (0)
#define E2_GATHER16(V) do { _Pragma("unroll") for (int g4 = 0; g4 < 4; ++g4) { _Pragma("unroll") for (int k = 0; k < 4; ++k) V[4 * g4 + k] = *(const GAS v4u*)(vb + (size_t)eN[g4][k] * 128); } } while (0)
    E2_LOADE(t0); E2_META(t0, mA);
    E2_GATHER16(vA);
    if (t0 + 1 < t1) E2_LOADE(t0 + 1);
#pragma unroll 1
    for (int tok = t0; tok < t1; tok += 2) {
        if (tok + 1 < t1) { E2_GATHER16(vB); E2_META(tok + 1, mB); if (tok + 2 < t1) E2_LOADE(tok + 2); }
        e2_finish<HAS_B>(vA, mA, Xo, Xob, sso, tok, pi, col, lane);
        if (tok + 1 >= t1) break;
        if (tok + 2 < t1) { E2_GATHER16(vA); E2_META(tok + 2, mA); if (tok + 3 < t1) E2_LOADE(tok + 3); }
        e2_finish<HAS_B>(vB, mB, Xo, Xob, sso, tok + 1, pi, col, lane);
    }
#undef E2_GATHER16
#undef E2_META
#undef E2_LOADE
}
#define PEER_QLOOP_CHUNK(QBASE, BODY) do { const int home_ = (int)(xb_xcc_id() & 7u); \
    for (int k_ = 0; k_ < 8; ++k_) { const int pi = (home_ + k_) & 7; unsigned* qh_ = (QBASE) + pi * 64; \
        for (;;) { unsigned c_ = 0u; if (lane == 0) c_ = __hip_atomic_fetch_add(qh_, 16u, __ATOMIC_RELAXED, __HIP_MEMORY_SCOPE_AGENT); c_ = (unsigned)__builtin_amdgcn_readfirstlane((int)c_); \
            if (c_ >= (unsigned)NT) break; const int t0 = (int)c_, t1 = (int)c_ + 16 < NT ? (int)c_ + 16 : NT; BODY; } } } while (0)
__device__ __forceinline__ float wave_sum_dpp(float v) {
    ROWSUM16F(v);
    return (__int_as_float(__builtin_amdgcn_readlane(__float_as_int(v), 0)) + __int_as_float(__builtin_amdgcn_readlane(__float_as_int(v), 16))) + (__int_as_float(__builtin_amdgcn_readlane(__float_as_int(v), 32)) + __int_as_float(__builtin_amdgcn_readlane(__float_as_int(v), 48)));
}
struct PostRow { float x[33]; float wi; };
__device__ __forceinline__ void att_post_load(PostRow& R, const bf16* P, int row, int lane) {
    const bf16* p = P + (size_t)row * APAD;
#pragma unroll
    for (int i = 0; i < 33; ++i) R.x[i] = bflo((unsigned)p[i * 64 + lane]);
    R.wi = (lane < 8) ? bflo((unsigned)p[2112 + lane]) : 0.f;
}
__device__ __forceinline__ void att_post_compute(const PostRow& R, float gq, float gk, float gik, const float* tab,
                                                 bf16* QB, bf16* KB, bf16* V2B, bf16* QIB, bf16* KIB, float* WI, float* out, int row, int lane) {
    const float* tb = tab + (size_t)(row < NP ? (row & 4095) : 4096) * 64;
    const float cs = tb[lane & 31], sn0 = tb[32 + (lane & 31)], sn = (lane < 32) ? -sn0 : sn0;
    float* okp = (row < NP) ? out + O_KP + (size_t)row * 256 : out + O_KS + (size_t)(row - NP) * 256;
    float* ovp = (row < NP) ? out + O_VP + (size_t)row * 256 : out + O_VS + (size_t)(row - NP) * 256;
    float* oip = (row < NP) ? out + O_IP + (size_t)row * 64 : out + O_IS + (size_t)(row - NP) * 64;
#pragma unroll
    for (int i = 0; i < 33; ++i) {
        float x = R.x[i];
        if (i >= 20 && i < 24) { V2B[(size_t)row * 256 + (i - 20) * 64 + lane] = (bf16)f2bf(x); ovp[(i - 20) * 64 + lane] = x; continue; }
        const float g = (i < 16) ? gq : ((i < 20) ? gk : gik);
        if (i < 20 || i == 32) { const float ss = wave_sum_dpp(x * x); x = x * rsqrtf(ss * (1.0f / 64.0f) + EPS) * g; }
        const auto sw_ = __builtin_amdgcn_permlane32_swap(__float_as_uint(x), __float_as_uint(x), false, false);
        const float other = __uint_as_float(lane < 32 ? sw_[1] : sw_[0]);
        const float y = x * cs + other * sn;
        if (i < 16) QB[(size_t)row * 1024 + i * 64 + lane] = (bf16)f2bf(y * QSCALE);
        else if (i < 20) { KB[(size_t)row * 256 + (i - 16) * 64 + lane] = (bf16)f2bf(y); okp[(i - 16) * 64 + lane] = y; }
        else if (i < 32) QIB[(size_t)row * 512 + (i - 24) * 64 + lane] = (bf16)f2bf(y);
        else { KIB[(size_t)row * 64 + lane] = (bf16)f2bf(y); oip[lane] = y; }
    }
    if (lane < 8) WI[(size_t)row * 8 + lane] = R.wi * IDX_SCALE;
}

__device__ __forceinline__ void idx_scores_task(const bf16* QIB, const bf16* KIB, const float* WI, unsigned short* SC, int b, int qb, int kb_lo, int kb_hi, int lane) {
    const int l16 = lane & 15, q4 = lane >> 4; const size_t qrow = (size_t)b * SEQ + qb * 16 + l16;
    bf16x8 qf[8][2]; float wi[8];
#pragma unroll
    for (int h = 0; h < 8; ++h) { wi[h] = WI[qrow * 8 + h];
#pragma unroll
        for (int kk = 0; kk < 2; ++kk) qf[h][kk] = *(const GAS bf16x8*)(QIB + qrow * 512 + h * 64 + kk * 32 + q4 * 8); }
    const bf16* kbase = KIB + ((size_t)b * SEQ + l16) * 64 + q4 * 8;
    bf16x8 kr0[4], kr1[4];
#pragma unroll
    for (int j = 0; j < 4; ++j) { const int kb = (kb_lo + j < kb_hi) ? kb_lo + j : kb_lo; kr0[j] = *(const GAS bf16x8*)(kbase + (size_t)kb * 1024); kr1[j] = *(const GAS bf16x8*)(kbase + (size_t)kb * 1024 + 32); }
#pragma unroll 1
    for (int kb0 = kb_lo; kb0 < kb_hi; kb0 += 4) {
#pragma unroll
        for (int j = 0; j < 4; ++j) { const int kb = kb0 + j;
            const bf16x8 k0 = kr0[j], k1 = kr1[j];
            { const int kn = (kb + 4 < kb_hi) ? kb + 4 : kb_lo; kr0[j] = *(const GAS bf16x8*)(kbase + (size_t)kn * 1024); kr1[j] = *(const GAS bf16x8*)(kbase + (size_t)kn * 1024 + 32); }
            {
                f32x4 sc = {0.f, 0.f, 0.f, 0.f};
#pragma unroll
                for (int h = 0; h < 8; ++h) { f32x4 a = {0.f, 0.f, 0.f, 0.f};
                    a = __builtin_amdgcn_mfma_f32_16x16x32_bf16(k0, qf[h][0], a, 0, 0, 0);
                    a = __builtin_amdgcn_mfma_f32_16x16x32_bf16(k1, qf[h][1], a, 0, 0, 0);
#pragma unroll
                    for (int i = 0; i < 4; ++i) sc[i] += wi[h] * fmaxf(a[i], 0.f); }
                if (kb < kb_hi) { v2u w; w.x = pg8::EpiScaleF16::pkh(sc[0], sc[1]); w.y = pg8::EpiScaleF16::pkh(sc[2], sc[3]); *(GAS v2u*)(SC + qrow * 4096 + kb * 16 + 4 * q4) = w; } }
        }
    }
}

__device__ __forceinline__ void select_load(unsigned (&raw)[64], const unsigned short* SC, int row, int lane) {
    const int t = row & 4095, n = t + 1; if (n <= 256) return;
    const unsigned short* sc = SC + (size_t)row * 4096; const int nj = (n + 63) >> 6;
#pragma unroll
    for (int j = 0; j < 64; ++j) if (j < nj) raw[j] = (unsigned)sc[j * 64 + lane];
}
__device__ __forceinline__ void select_keys(unsigned (&x)[64], const unsigned (&raw)[64], int row, int lane) {
    const int t = row & 4095, n = t + 1; if (n <= 256) return; const int nj = (n + 63) >> 6;
#pragma unroll
    for (int j = 0; j < 64; ++j) { x[j] = 0u; if (j < nj) { const int s = j * 64 + lane; const unsigned h = raw[j];
            if (s < n) x[j] = ((h & 0x8000u) ? (~h & 0xffffu) : (h | 0x8000u)) + ((h & 0x7fffu) == 0u && (h & 0x8000u) ? 1u : 0u); } }
}
__device__ __forceinline__ void select_run(const unsigned (&x)[64], unsigned long long* BM, int row, int lane) {
    const int t = row & 4095, n = t + 1; unsigned long long* bm = BM + (size_t)row * 64;
    if (n <= 256) { const int lo = lane * 64; unsigned long long w = 0ull; if (lo + 63 <= t) w = ~0ull; else if (lo <= t) w = (2ull << (t - lo)) - 1ull; bm[lane] = w; return; }
    const int nj = (n + 63) >> 6;
    unsigned T = 0u; const int ngrp = (nj + 15) >> 4;
#pragma unroll 1
    for (int bit = 15; bit >= 0; --bit) { const unsigned c = T | (1u << bit); unsigned cv = 0u;
#pragma unroll
        for (int g = 0; g < 4; ++g) if (g < ngrp) {
#pragma unroll
            for (int j = g * 16; j < g * 16 + 16; ++j) asm("v_cmp_ge_u32 vcc, %1, %2\n\tv_addc_co_u32 %0, vcc, 0, %0, vcc" : "+v"(cv) : "v"(x[j]), "v"(c) : "vcc"); }
        asm volatile("s_nop 1" : "+v"(cv));
        int ci = (int)cv;
        ci += __builtin_amdgcn_update_dpp(0, ci, 0x121, 0xf, 0xf, false); ci += __builtin_amdgcn_update_dpp(0, ci, 0x122, 0xf, 0xf, false);
        ci += __builtin_amdgcn_update_dpp(0, ci, 0x124, 0xf, 0xf, false); ci += __builtin_amdgcn_update_dpp(0, ci, 0x128, 0xf, 0xf, false);
        const int cnt = __builtin_amdgcn_readlane(ci, 0) + __builtin_amdgcn_readlane(ci, 16) + __builtin_amdgcn_readlane(ci, 32) + __builtin_amdgcn_readlane(ci, 48);
        if (cnt >= 256) T = c; }
    int cgt = 0;
#pragma unroll
    for (int j = 0; j < 64; ++j) if (j < nj) cgt += __builtin_popcountll(__ballot(x[j] > T));
    const int need = 256 - cgt; int eqb = 0; const unsigned long long lt = lanemask_lt(lane); unsigned long long myw = 0ull;
#pragma unroll
    for (int j = 0; j < 64; ++j) if (j < nj) {
        const bool eq = (x[j] == T); const unsigned long long meq = __ballot(eq);
        const bool sl = (x[j] > T) || (eq && (eqb + __builtin_popcountll(meq & lt)) < need);
        const unsigned long long m = __ballot(sl);
        if (lane == j) myw = m;
        eqb += __builtin_popcountll(meq); }
    bm[lane] = myw;
}

constexpr int ATT_KP = 144, ATT_VP = 136, ATT_STAGE = 64 * ATT_KP + 64 * ATT_VP;
__device__ __forceinline__ void attend_unit(const bf16* QB, const bf16* KB, const bf16* VT, const unsigned long long* BM, bf16* OB, LAS unsigned char* lds, int b, int kvh, int qt, float nbound, int tid, unsigned* qnext, int& nxt) {
    const int lane = tid & 63, wave = tid >> 6, r32 = lane & 31, hi = lane >> 5, qh = wave >> 2, head = kvh * 4 + (wave & 3);
    const size_t qrow = (size_t)b * SEQ + qt * 64 + qh * 32 + r32;
    bf16x8 qf[4];
#pragma unroll
    for (int d0 = 0; d0 < 4; ++d0) qf[d0] = *(const GAS bf16x8*)(QB + qrow * 1024 + head * 64 + d0 * 16 + hi * 8);
    const int srow = tid >> 3, sch = tid & 7;
    const bf16* kg = KB + ((size_t)b * SEQ + srow) * 256 + kvh * 64 + sch * 8;
    const bf16* vg = VT + ((size_t)(b * 4 + kvh) * 64 + srow) * SEQ + sch * 8;
    const unsigned long long* bmq = BM + qrow * 64; const LAS unsigned char* mtab = lds + 3 * ATT_STAGE + 64;
    f32x16 o0 = {}, o1 = {}; f32x16 nb16; float ls[4] = {0.f, 0.f, 0.f, 0.f};
#pragma unroll
    for (int i = 0; i < 16; ++i) nb16[i] = nbound;
    const bf16x8 ones8 = {0x3F80, 0x3F80, 0x3F80, 0x3F80, 0x3F80, 0x3F80, 0x3F80, 0x3F80};
    const int nt = qt + 1;
#define ATT_STORE(T, KR, VR) do { LAS unsigned char* st_ = lds + ((T) % 3) * ATT_STAGE; *(LAS v4u*)(st_ + srow * ATT_KP + sch * 16) = KR; \
        LAS v2u* vp_ = (LAS v2u*)(st_ + 64 * ATT_KP + srow * ATT_VP + sch * 16); vp_[0] = (v2u){VR.x, VR.y}; vp_[1] = (v2u){VR.z, VR.w}; } while (0)
#define ATT_QK(T, P0, P1) do { const LAS unsigned char* st_ = lds + ((T) % 3) * ATT_STAGE; _Pragma("unroll") for (int d0 = 0; d0 < 4; ++d0) { \
        const bf16x8 k0 = *(const LAS bf16x8*)(st_ + r32 * ATT_KP + d0 * 32 + hi * 16), k1 = *(const LAS bf16x8*)(st_ + (32 + r32) * ATT_KP + d0 * 32 + hi * 16); \
        P0 = __builtin_amdgcn_mfma_f32_32x32x16_bf16(k0, qf[d0], P0, 0, 0, 0); P1 = __builtin_amdgcn_mfma_f32_32x32x16_bf16(k1, qf[d0], P1, 0, 0, 0); } } while (0)
#define ATT_BAR() do { asm volatile("s_waitcnt lgkmcnt(0)" ::: "memory"); __builtin_amdgcn_s_barrier(); asm volatile("" ::: "memory"); } while (0)
    auto tcl = [&](int t) { return t < nt ? t : nt - 1; };
    v4u kA = *(const GAS v4u*)kg, vA = *(const GAS v4u*)vg; unsigned long long wA = bmq[0];
    v4u kB = *(const GAS v4u*)(kg + (size_t)tcl(1) * 64 * 256), vB = *(const GAS v4u*)(vg + tcl(1) * 64); unsigned long long wB = bmq[tcl(1)];
    ATT_STORE(0, kA, vA);
    kA = *(const GAS v4u*)(kg + (size_t)tcl(2) * 64 * 256); vA = *(const GAS v4u*)(vg + tcl(2) * 64);
    ATT_BAR();
    f32x16 p0 = nb16, p1 = nb16;
    ATT_QK(0, p0, p1);
    auto step = [&](const int t, v4u& kq, v4u& vq, unsigned long long& wp) __attribute__((always_inline)) {
        const unsigned long long wcur = wp;
        if (t + 1 < nt) ATT_STORE(t + 1, kq, vq);
        ATT_BAR();
        { const int t3 = tcl(t + 3); wp = bmq[tcl(t + 2)]; kq = *(const GAS v4u*)(kg + (size_t)t3 * 64 * 256); vq = *(const GAS v4u*)(vg + t3 * 64); }
        if (t == 0 && tid == 0) nxt = (int)__hip_atomic_fetch_add(qnext, 1u, __ATOMIC_RELAXED, __HIP_MEMORY_SCOPE_AGENT);
        f32x16 n0 = nb16, n1 = nb16;
        ATT_QK(t + 1, n0, n1);
#pragma unroll
        for (int r = 0; r < 16; ++r) { p0[r] = fast_exp2(p0[r]); p1[r] = fast_exp2(p1[r]); }
        const unsigned ml = (unsigned)wcur >> (4 * hi), mh = (unsigned)(wcur >> 32) >> (4 * hi);
        unsigned pw[4][4];
#pragma unroll
        for (int g = 0; g < 4; ++g) {
            const v2u ma = *(const LAS v2u*)(mtab + (((ml >> (8 * g)) & 15u) << 3)), mb = *(const LAS v2u*)(mtab + (((mh >> (8 * g)) & 15u) << 3));
            const int r = 4 * g;
            pw[g >> 1][2 * (g & 1)] = cvtpk(p0[r], p0[r + 1]) & ma.x; pw[g >> 1][2 * (g & 1) + 1] = cvtpk(p0[r + 2], p0[r + 3]) & ma.y;
            pw[2 + (g >> 1)][2 * (g & 1)] = cvtpk(p1[r], p1[r + 1]) & mb.x; pw[2 + (g >> 1)][2 * (g & 1) + 1] = cvtpk(p1[r + 2], p1[r + 3]) & mb.y;
        }
        const LAS unsigned char* vb = lds + (t % 3) * ATT_STAGE + 64 * ATT_KP;
#pragma unroll
        for (int kk = 0; kk < 4; ++kk) {
            const bf16x8 pf = __builtin_bit_cast(bf16x8, (v4u){pw[kk][0], pw[kk][1], pw[kk][2], pw[kk][3]});
            const v2u a0 = *(const LAS v2u*)(vb + r32 * ATT_VP + (16 * kk + 4 * hi) * 2), a1 = *(const LAS v2u*)(vb + r32 * ATT_VP + (16 * kk + 4 * hi) * 2 + 16);
            const v2u c0 = *(const LAS v2u*)(vb + (32 + r32) * ATT_VP + (16 * kk + 4 * hi) * 2), c1 = *(const LAS v2u*)(vb + (32 + r32) * ATT_VP + (16 * kk + 4 * hi) * 2 + 16);
            o0 = __builtin_amdgcn_mfma_f32_32x32x16_bf16(__builtin_bit_cast(bf16x8, (v4u){a0.x, a0.y, a1.x, a1.y}), pf, o0, 0, 0, 0);
            o1 = __builtin_amdgcn_mfma_f32_32x32x16_bf16(__builtin_bit_cast(bf16x8, (v4u){c0.x, c0.y, c1.x, c1.y}), pf, o1, 0, 0, 0);
#pragma unroll
            for (int j = 0; j < 4; ++j) ls[j] = __builtin_amdgcn_fdot2_f32_bf16(__builtin_bit_cast(bf16x2_t, pw[kk][j]), __builtin_bit_cast(bf16x2_t, 0x3F803F80u), ls[j], false); }
        p0 = n0; p1 = n1;
    };
#pragma unroll 1
    for (int t = 0; t < nt; t += 2) {
        step(t, kB, vB, wA);
        if (t + 1 >= nt) break;
        step(t + 1, kA, vA, wB);
    }
#undef ATT_BAR
#undef ATT_STORE
#undef ATT_QK
    float lsum = (ls[0] + ls[1]) + (ls[2] + ls[3]); lsum += __shfl_xor(lsum, 32); const float inv = 1.0f / lsum;
    bf16* op = OB + qrow * 1024 + head * 64 + 4 * hi;
#pragma unroll
    for (int r4 = 0; r4 < 4; ++r4) {
        v2u w0, w1; w0.x = pk2(o0[4 * r4] * inv, o0[4 * r4 + 1] * inv); w0.y = pk2(o0[4 * r4 + 2] * inv, o0[4 * r4 + 3] * inv);
        w1.x = pk2(o1[4 * r4] * inv, o1[4 * r4 + 1] * inv); w1.y = pk2(o1[4 * r4 + 2] * inv, o1[4 * r4 + 3] * inv);
        *(GAS v2u*)(op + 8 * r4) = w0; *(GAS v2u*)(op + 32 + 8 * r4) = w1; }
    __syncthreads();
}

__device__ __forceinline__ void samp_scores_task(const bf16* QIB, const float* WI, const bf16* KIB, const float* cik, const int* page_table, unsigned* SKEYS, LAS float* scr, int b, int pg, int lane) {
    const size_t row = (size_t)NP + b;
    for (int i = lane; i < 512; i += 64) scr[i] = bflo((unsigned)QIB[row * 512 + i]);
    LDS_WAIT(); asm volatile("" ::: "memory");
    float wi[8];
#pragma unroll
    for (int h = 0; h < 8; ++h) wi[h] = WI[row * 8 + h];
    if (pg < NPAGE) {
        const int phys = page_table[b * NPAGE + pg];
#pragma unroll 1
        for (int rep = 0; rep < 2; ++rep) { const int kk = lane + rep * 64; const float* kr = cik + ((size_t)phys * 128 + kk) * 64; float d[8];
#pragma unroll
            for (int h = 0; h < 8; ++h) d[h] = 0.f;
#pragma unroll 4
            for (int c = 0; c < 16; ++c) { const f32x4 k4 = *(const GAS f32x4*)(kr + c * 4);
#pragma unroll
                for (int h = 0; h < 8; ++h) { const f32x4 q4 = *(const LAS f32x4*)(scr + h * 64 + c * 4); d[h] += k4[0] * q4[0] + k4[1] * q4[1] + k4[2] * q4[2] + k4[3] * q4[3]; } }
            float sc = 0.f;
#pragma unroll
            for (int h = 0; h < 8; ++h) sc += fmaxf(d[h], 0.f) * wi[h];
            SKEYS[(size_t)b * 16640 + pg * 128 + kk] = f2key(sc); }
    } else {
        const float kv = bflo((unsigned)KIB[row * 64 + lane]); float sc = 0.f;
#pragma unroll
        for (int h = 0; h < 8; ++h) { const float d = wave_sum(kv * scr[h * 64 + lane]); sc += fmaxf(d, 0.f) * wi[h]; }
        if (lane == 0) SKEYS[(size_t)b * 16640 + PAST] = f2key(sc);
    }
    LDS_WAIT(); asm volatile("" ::: "memory");
}
__device__ __forceinline__ void samp_select_attend(const unsigned* SKEYS, const bf16* QB, const bf16* KB, const bf16* V2B, const float* ck, const float* cv, const int* page_table,
                                                   bf16* OB, LAS unsigned char* lds, int b, int tid) {
    LAS int* cnt = (LAS int*)lds;
    LAS int* sl = (LAS int*)(lds + 64);
    LAS float* qs = (LAS float*)(lds + 64 + 1024);
    LAS float* lg = (LAS float*)(lds + 64 + 1024 + 4096);
    const int lane = tid & 63, w = tid >> 6; const size_t row = (size_t)NP + b; const int n = PAST + 1;
    const unsigned* kk = SKEYS + (size_t)b * 16640;
    unsigned x[33];
#pragma unroll
    for (int j = 0; j < 33; ++j) { const int s = j * 512 + tid; x[j] = (s < n) ? kk[s] : 0u; }
    for (int i = tid; i < 1024; i += NTHR) qs[i] = bflo((unsigned)QB[row * 1024 + i]);
    if (tid < 4) cnt[tid] = 0;
    __syncthreads();
    unsigned T = 0u;
#pragma unroll 1
    for (int bit = 31; bit >= 0; --bit) { const unsigned c = T | (1u << bit); int my = 0;
#pragma unroll
        for (int j = 0; j < 33; ++j) my += __builtin_popcountll(__ballot(x[j] >= c));
        if (lane == 0) atomicAdd((int*)&cnt[bit & 1], my);
        __syncthreads();
        const int tot = cnt[bit & 1]; if (tot >= 256) T = c;
        if (tid == 0) cnt[(bit + 1) & 1] = 0;
        __syncthreads(); }
    { const unsigned long long lt = lanemask_lt(lane); int cg = 0, ce = 0;
#pragma unroll
      for (int j = 0; j < 33; ++j) { cg += __builtin_popcountll(__ballot(x[j] > T)); ce += __builtin_popcountll(__ballot(x[j] == T)); }
      LAS int* wc = (LAS int*)(lds + 22656);
      if (lane == 0) { wc[w * 2] = cg; wc[w * 2 + 1] = ce; }
      __syncthreads();
      int bg = 0, be = 0, tg = 0;
      for (int ww = 0; ww < NWAVES; ++ww) { const int a_ = wc[ww * 2], e_ = wc[ww * 2 + 1]; if (ww < w) { bg += a_; be += e_; } tg += a_; }
      const int need = 256 - tg;
#pragma unroll
      for (int j = 0; j < 33; ++j) { const bool sg = x[j] > T, se = x[j] == T; const unsigned long long mg = __ballot(sg), me = __ballot(se);
          if (sg) sl[bg + __builtin_popcountll(mg & lt)] = j * 512 + tid;
          if (se) { const int r = be + __builtin_popcountll(me & lt); if (r < need) sl[tg + r] = j * 512 + tid; }
          bg += __builtin_popcountll(mg); be += __builtin_popcountll(me); } }
    __syncthreads();
    LAS int* prow = (LAS int*)(lds + 64 + 1024 + 4096 + 16384);
    if (tid < 256) { const int s = sl[tid]; prow[tid] = (s >= PAST) ? -1 : page_table[b * NPAGE + (s >> 7)] * 128 + (s & 127); }
    __syncthreads();
    { const int n_ = tid & 255, hh = tid >> 8; const int pr = prow[n_];
      float kv[2][64];
      if (pr >= 0) { const float* krf = ck + (size_t)pr * 256 + hh * 128;
#pragma unroll
          for (int i = 0; i < 32; ++i) { const f32x4 k4 = *(const GAS f32x4*)(krf + i * 4); kv[i >> 4][(i & 15) * 4] = k4[0]; kv[i >> 4][(i & 15) * 4 + 1] = k4[1]; kv[i >> 4][(i & 15) * 4 + 2] = k4[2]; kv[i >> 4][(i & 15) * 4 + 3] = k4[3]; } }
      else { const bf16* krb = KB + row * 256 + hh * 128;
#pragma unroll
          for (int i = 0; i < 128; ++i) kv[i >> 6][i & 63] = bflo((unsigned)krb[i]); }
#pragma unroll
      for (int hq = 0; hq < 8; ++hq) { const int h = hh * 8 + hq; float d = 0.f;
#pragma unroll
          for (int i = 0; i < 64; i += 4) { const f32x4 q4 = *(const LAS f32x4*)(qs + h * 64 + i); d += q4[0] * kv[hq >> 2][i] + q4[1] * kv[hq >> 2][i + 1] + q4[2] * kv[hq >> 2][i + 2] + q4[3] * kv[hq >> 2][i + 3]; }
          lg[h * 256 + n_] = d; } }
    __syncthreads();
    for (int h = w; h < 16; h += NWAVES) { float v[4]; float m = -INFINITY;
#pragma unroll
        for (int i = 0; i < 4; ++i) { v[i] = lg[h * 256 + i * 64 + lane]; m = fmaxf(m, v[i]); }
#pragma unroll
        for (int o = 1; o < 64; o <<= 1) m = fmaxf(m, __shfl_xor(m, o));
        float sum = 0.f;
#pragma unroll
        for (int i = 0; i < 4; ++i) { v[i] = fast_exp2(v[i] - m); sum += v[i]; }
        sum = wave_sum(sum); const float inv = 1.0f / sum;
#pragma unroll
        for (int i = 0; i < 4; ++i) lg[h * 256 + i * 64 + lane] = v[i] * inv; }
    __syncthreads();
    {
        LAS float* red = (LAS float*)(lds + 24576);
        const int kvh = lane >> 4, d0 = (lane & 15) * 4;
        f32x4 vr[32];
#pragma unroll
        for (int jj = 0; jj < 32; ++jj) { const int pr = prow[w * 32 + jj];
            if (pr >= 0) vr[jj] = *(const GAS f32x4*)(cv + (size_t)pr * 256 + kvh * 64 + d0);
            else { const v2u vb = *(const GAS v2u*)(V2B + row * 256 + kvh * 64 + d0); vr[jj] = (f32x4){bflo(vb.x), bfhi(vb.x), bflo(vb.y), bfhi(vb.y)}; } }
        f32x4 acc[4];
#pragma unroll
        for (int g = 0; g < 4; ++g) acc[g] = (f32x4){0.f, 0.f, 0.f, 0.f};
#pragma unroll
        for (int jj = 0; jj < 32; ++jj) {
#pragma unroll
            for (int g = 0; g < 4; ++g) acc[g] += vr[jj] * lg[(kvh * 4 + g) * 256 + w * 32 + jj]; }
#pragma unroll
        for (int g = 0; g < 4; ++g) *(LAS f32x4*)(red + w * 1024 + (kvh * 4 + g) * 64 + d0) = acc[g];
        __syncthreads();
        { const int c = tid * 2; float o0 = 0.f, o1 = 0.f;
#pragma unroll
          for (int ww = 0; ww < 8; ++ww) { const f32x2 r2 = *(const LAS f32x2*)(red + ww * 1024 + c); o0 += r2[0]; o1 += r2[1]; }
          *(GAS unsigned*)(OB + row * 1024 + c) = pk2(o0, o1); }
    }
    __syncthreads();
}

template <int K> __device__ __forceinline__ void thin_gemm_tile(const bf16* A, const bf16* Bt, int col0, LAS float* red, int tid, float& v0, float& v1) {
    const int lane = tid & 63, w = tid >> 6, r32 = lane & 31, hi = lane >> 5;
    constexpr int KS = K / 8, NS = KS / 16;
    const bf16* ap = A + (size_t)r32 * K + w * KS + hi * 8;
    const bf16* bp = Bt + (size_t)(col0 + r32) * K + w * KS + hi * 8;
    f32x16 acc = {};
    bf16x8 af[NS], bf_[NS];
#pragma unroll
    for (int i = 0; i < NS; ++i) { af[i] = *(const GAS bf16x8*)(ap + i * 16); bf_[i] = *(const GAS bf16x8*)(bp + i * 16); }
#pragma unroll
    for (int i = 0; i < NS; ++i) acc = __builtin_amdgcn_mfma_f32_32x32x16_bf16(af[i], bf_[i], acc, 0, 0, 0);
    __syncthreads();
#pragma unroll
    for (int i = 0; i < 16; ++i) red[w * 1024 + ((i & 3) + 8 * (i >> 2) + 4 * hi) * 32 + r32] = acc[i];
    __syncthreads();
    v0 = 0.f; v1 = 0.f;
#pragma unroll
    for (int ww = 0; ww < 8; ++ww) { const f32x2 t = *(const LAS f32x2*)(red + ww * 1024 + tid * 2); v0 += t[0]; v1 += t[1]; }
}
__device__ __forceinline__ float row16_sum(float v) {
    v += __shfl_xor(v, 1); v += __shfl_xor(v, 2); v += __shfl_xor(v, 4); v += __shfl_xor(v, 8); return v;
}

__global__ void __launch_bounds__(NTHR, 2) fused_fwd(Params prm) {
    extern __shared__ __attribute__((aligned(16))) unsigned char lds_raw[];
    LAS unsigned char* lds = (LAS unsigned char*)lds_raw;
    volatile LAS unsigned* MISC = (volatile LAS unsigned*)(lds + MISC_OFF);
    const int tid = threadIdx.x, lane = tid & 63, wave = __builtin_amdgcn_readfirstlane(tid >> 6);
    const int G = gridDim.x, bid = blockIdx.x;
    const int gw = bid * NWAVES + wave, NGW = G * NWAVES;
    unsigned char* ws = prm.ws;
    for (int u = tid; u < (LDS_BYTES - RING_BYTES) / 4; u += NTHR) ((LAS unsigned*)(lds + RING_BYTES))[u] = 0u;
    __syncthreads();
    XcdBarrier bar = xcd_barrier_post((unsigned*)ws + CW_BAR, MISC + 8);
    const int lo = prm.ph_lo, hi = prm.ph_hi;
#ifndef REPMASK
#define REPMASK 0
#endif
#define REP(k) (((REPMASK >> (k)) & 1) ? 2 : 1)
#ifndef DISMASK
#define DISMASK 0
#endif
#define IN(k) (lo <= (k) && (k) < hi && !((DISMASK >> (k)) & 1))
#define SEAM(k) do { if (IN(k) && IN((k) + 1)) xcd_barrier(bar); } while (0)
    const float* x_prompt = prm.in[0]; const float* x_sample = prm.in[1]; const float* cache_k = prm.in[2]; const float* cache_v = prm.in[3]; const float* cache_ik = prm.in[4];
    const int* page_table = (const int*)prm.in[5]; const float* norm_mix_g = prm.in[6]; const float* norm_ffn_g = prm.in[7];
    const float* gmlp_w_in = prm.in[8]; const float* gmlp_v_g = prm.in[9]; const float* gmlp_w_s = prm.in[10]; const float* gmlp_b_s = prm.in[11]; const float* gmlp_w_out = prm.in[12];
    const float* att_w_in = prm.in[13]; const float* att_qg = prm.in[14]; const float* att_kg = prm.in[15]; const float* att_ikg = prm.in[16]; const float* att_w_out = prm.in[17];
    const float* peer_wq = prm.in[18]; const float* peer_k1 = prm.in[19]; const float* peer_k2 = prm.in[20]; const float* peer_u = prm.in[21]; const float* peer_v = prm.in[22];
    float* out = prm.out;
    unsigned long long* SSV = (unsigned long long*)(ws + W_SSV); unsigned long long* SS1 = (unsigned long long*)(ws + W_SS1); unsigned long long* SS3 = (unsigned long long*)(ws + W_SS3); float* SS0 = (float*)(ws + W_SS0); float* SS2 = (float*)(ws + W_SS2); unsigned* QC = (unsigned*)(ws + W_QC);
    unsigned char* XQ = ws + W_XQ; float* RSX = (float*)(ws + W_RSX); float* ACT = (float*)(ws + W_ACT);
    bf16* X0B = (bf16*)(ws + W_X0B); bf16* WIN0T = (bf16*)(ws + W_WIN0T); bf16* WOUT0T = (bf16*)(ws + W_WOUT0T); bf16* WP0T = (bf16*)(ws + W_WP0T); bf16* WP1T = (bf16*)(ws + W_WP1T);
    bf16* WIN1T = (bf16*)(ws + W_WIN1T); bf16* WOUT1T = (bf16*)(ws + W_WOUT1T); float* WSMT = (float*)(ws + W_WSMT); float* ROPE = (float*)(ws + W_ROPE);
    unsigned char* U8 = ws + W_UB; unsigned char* V8 = ws + W_VB; float* SU = (float*)(ws + W_SU); float* SV = (float*)(ws + W_SV); bf16* X1B = (bf16*)(ws + W_X1B); bf16* X2B = (bf16*)(ws + W_X2B); bf16* X3B = (bf16*)(ws + W_X3B);
    bf16* U0 = (bf16*)(ws + W_U0); bf16* V0 = (bf16*)(ws + W_V0); bf16* G0 = (bf16*)(ws + W_G0); unsigned short* SH = (unsigned short*)(ws + W_BIG); bf16* PBF = (bf16*)(ws + W_BIG); unsigned short* SC = (unsigned short*)(ws + W_BIG);
    unsigned* EIDX = (unsigned*)(ws + W_EIDX); float* GATE = (float*)(ws + W_GATE);
    bf16* QB = (bf16*)(ws + W_QB); bf16* KB = (bf16*)(ws + W_KB); bf16* V2B = (bf16*)(ws + W_V2B); bf16* QIB = (bf16*)(ws + W_QIB); bf16* KIB = (bf16*)(ws + W_KIB); float* WI = (float*)(ws + W_WI);
    unsigned long long* BM = (unsigned long long*)(ws + W_SEL); bf16* VT = (bf16*)(ws + W_VT); unsigned* SKEYS = (unsigned*)(ws + W_SKEYS); bf16* OB = (bf16*)(ws + W_OB);

    if (IN(0)) for (int rep = 0; rep < REP(0); ++rep) {
        LAS float* scr = (LAS float*)(lds + wave * 16384);
        constexpr int I_X = MP, I_WIN0 = 16 * 128, I_WOUT0 = 32 * 32, I_WIN1 = 16 * 72, I_WOUT1 = 16 * 32, I_WP = 2 * 16 * 64, I_U = 2 * 16384, I_V = 2 * 16384, I_ROPE = (4097 * 32 + 63) / 64, I_WSM = 8 * 128 * 128 / 64;
        constexpr int TOTAL = I_WIN0 + I_WOUT0 + I_WIN1 + I_WOUT1 + I_WP + I_ROPE + I_WSM;
        for (int it = gw; it < TOTAL; it += NGW) {
            int r = it;
            if (r < I_WP) { const int l = r >> 10, hh = (r >> 6) & 15, jb = r & 63, h = hh >> 1, half = hh & 1;
                p0_wp_item(peer_wq + (size_t)l * 1024 * 2048, (half ? peer_k2 : peer_k1) + (size_t)l * 16384, norm_ffn_g + l * 1024, l ? WP1T : WP0T, h * 256 + half * 128, jb * 16, scr, lane); continue; } r -= I_WP;
            if (r < I_WIN0) { p0_transpose_item(gmlp_w_in, 4096, 1024, 128, 4096, norm_mix_g, WIN0T, scr, r, lane); continue; } r -= I_WIN0;
            if (r < I_WOUT0) { p0_transpose_item(gmlp_w_out, 1024, 2048, 32, 1024, nullptr, WOUT0T, scr, r, lane); continue; } r -= I_WOUT0;
            if (r < I_WIN1) { p0_transpose_item(att_w_in, APROJ, 1024, 72, APROJ, norm_mix_g + 1024, WIN1T, scr, r, lane); continue; } r -= I_WIN1;
            if (r < I_WOUT1) { p0_transpose_item(att_w_out, 1024, 1024, 32, 1024, nullptr, WOUT1T, scr, r, lane); continue; } r -= I_WOUT1;
            if (r < I_ROPE) { const int i = r * 64 + lane; if (i < 4097 * 32) { const int p = i >> 5, d = i & 31; const float pos = (p < 4096) ? (float)p : 16384.0f;
                    const float ang = pos * prm.inv[d]; const double rev = (double)ang * 0.15915494309189535; const float fr = (float)(rev - floor(rev));
                    ROPE[p * 64 + d] = __builtin_amdgcn_cosf(fr); ROPE[p * 64 + 32 + d] = __builtin_amdgcn_sinf(fr); } continue; } r -= I_ROPE;
            { const int e = r * 64 + lane, t = (e >> 7) & 127, s = e & 127; ((unsigned short*)WSMT)[e] = (unsigned short)((s <= t) ? (cvtpk(gmlp_w_s[e], 0.f) & 0xffffu) : 0u); }
        }
        {
            auto xsrc = [&](int r) { return r < NP ? x_prompt + (size_t)r * 1024 : (r < NT ? x_sample + (size_t)(r - NP) * 1024 : (const float*)nullptr); };
            RowIn A, B; int r = gw; if (r < I_X) p0_rowx_load(A, xsrc(r), lane);
            for (; r < I_X; r += 2 * NGW) {
                if (r + NGW < I_X) p0_rowx_load(B, xsrc(r + NGW), lane);
                { const float sq = p0_rowx_store(A, X0B + (size_t)r * 1024, lane); if (lane == 0) SS0[r] = sq; }
                if (r + NGW >= I_X) break;
                if (r + 2 * NGW < I_X) p0_rowx_load(A, xsrc(r + 2 * NGW), lane);
                { const float sq = p0_rowx_store(B, X0B + (size_t)(r + NGW) * 1024, lane); if (lane == 0) SS0[r + NGW] = sq; } } }
        {
            RowIn A, B; int r = gw;
            auto qsrc = [&](int q) { return q < I_U ? peer_u + (size_t)q * 1024 : peer_v + (size_t)(q - I_U) * 1024; };
            auto qst = [&](const RowIn& R, int q) { if (q < I_U) p0_rowq_store(R, norm_ffn_g + (q >> 14) * 1024, U8 + (size_t)q * 1024, SU + q, lane, false, 0);
                                                    else { const int v = q - I_U; p0_rowq_store(R, nullptr, V8 + (size_t)(v >> 14) * 16384 * 1024, SV + v, lane, true, v & 16383); } };
            if (r < I_U + I_V) p0_rowq_load(A, qsrc(r), lane);
            for (; r < I_U + I_V; r += 2 * NGW) {
                if (r + NGW < I_U + I_V) p0_rowq_load(B, qsrc(r + NGW), lane);
                qst(A, r);
                if (r + NGW >= I_U + I_V) break;
                if (r + 2 * NGW < I_U + I_V) p0_rowq_load(A, qsrc(r + 2 * NGW), lane);
                qst(B, r + NGW); } }
    }
    SEAM(0);
    if (IN(1)) for (int rep = 0; rep < REP(1); ++rep) { pg8::Gemm g{X0B, WIN0T, NP, 4096, 1024}; pg8::StaticOrder S; S.init(NP, 4096, G, bid); pg8::EpiUV E{U0, V0, SS0, SSV, rep == 0};
        pg8::gemm_phase<pg8::EpiUV, pg8::StaticOrder, true, true>(lds, g, S, E);
        for (int tk = bid; tk < 4096 / 32; tk += G) { float v0, v1; thin_gemm_tile<1024>(X0B + (size_t)NP * 1024, WIN0T, tk * 32, (LAS float*)lds, tid, v0, v1);
            const int r = tid >> 4, row = NP + r, col = tk * 32 + 2 * (tid & 15); const float rs = rsqrtf(SS0[row] * (1.0f / 1024.0f) + EPS); v0 *= rs; v1 *= rs;
            if (col < 2048) *(GAS unsigned*)(U0 + (size_t)row * 2048 + col) = pk2(v0, v1);
            else { *(GAS unsigned*)(V0 + (size_t)row * 2048 + col - 2048) = pk2(v0, v1); const float sq = row16_sum(v0 * v0 + v1 * v1); if ((tid & 15) == 0 && rep == 0) pg8::ss_add(SSV + row, sq); } } }
    SEAM(1);
    if (IN(2)) for (int rep = 0; rep < REP(2); ++rep) {
        typedef short s16x4_t __attribute__((ext_vector_type(4)));
        LAS float* rvs = (LAS float*)(lds + 98304); LAS unsigned char* slab = lds + wave * 8192; LAS float* vgl = (LAS float*)(lds + 65536 + wave * 1024);
        const int c = tid * 4, g = wave, r32 = lane & 31, hi = lane >> 5;
        for (int unit = bid; unit < 256; unit += G) {
            const int row0 = unit * 128;
            __syncthreads();
            { int tl = tid; asm volatile("" : "+v"(tl));
              if (tl < 128) rvs[tl] = rsqrtf(pg8::ss_get(SSV + row0 + tl) * (1.0f / 2048.0f) + EPS);
              for (int i = tl & 63; i < 256; i += 64) vgl[i] = gmlp_v_g[g * 256 + i]; }
            __syncthreads();
            const __amdgpu_buffer_rsrc_t rV = __builtin_amdgcn_make_buffer_rsrc((void*)V0, 0, 0x7fffffff, 0x00020000), rU = __builtin_amdgcn_make_buffer_rsrc((void*)U0, 0, 0x7fffffff, 0x00020000), rG = __builtin_amdgcn_make_buffer_rsrc((void*)G0, 0, 0x7fffffff, 0x00020000);
            const unsigned voffv = (unsigned)(((lane >> 2) * 2048 + g * 256 + (lane & 3) * 8) * 2), voffu = (unsigned)((r32 * 2048 + g * 256 + 4 * hi) * 2);
            const __amdgpu_buffer_rsrc_t rW = __builtin_amdgcn_make_buffer_rsrc((void*)WSMT, 0, 0x7fffffff, 0x00020000); const unsigned voffw = (unsigned)((r32 * 128 + 8 * hi) * 2); const int gs = __builtin_amdgcn_readfirstlane(g);
            v4u pv[8]; v2u pu[16];
#pragma unroll
            for (int i = 0; i < 8; ++i) pv[i] = __builtin_amdgcn_raw_buffer_load_b128(rV, voffv, (row0 + 16 * i) * 4096, 0);
#pragma unroll
            for (int j = 0; j < 16; ++j) pu[j] = __builtin_amdgcn_raw_buffer_load_b64(rU, voffu, (row0 + 32 * (j >> 2)) * 4096 + 16 * (j & 3), 0);
            bf16x8 wf[20]; float bias[4], rv8[8];
#pragma unroll
            for (int i = 0; i < 8; ++i) rv8[i] = rvs[(lane >> 2) + 16 * i];
#pragma unroll
            for (int tb = 0; tb < 4; ++tb) { bias[tb] = gmlp_b_s[g * 128 + tb * 32 + r32];
#pragma unroll
                for (int kk = 0; kk < 2 * tb + 2; ++kk) wf[tb * (tb + 1) + kk] = __builtin_bit_cast(bf16x8, __builtin_amdgcn_raw_buffer_load_b128(rW, voffw, (gs * 128 + tb * 32) * 256 + kk * 32, 0)); }
            LAS unsigned char* trp = slab + (8 * hi + ((lane & 15) >> 2)) * 64 + (((lane >> 4) & 1) * 16 + (lane & 3) * 4) * 2;
#pragma unroll 1
            for (int cb = 0; cb < 8; ++cb) {
#pragma unroll
                for (int i = 0; i < 8; ++i) { const float rv = rv8[i]; v4u w; w.x = cvtpk(bflo(pv[i].x) * rv, bfhi(pv[i].x) * rv); w.y = cvtpk(bflo(pv[i].y) * rv, bfhi(pv[i].y) * rv); w.z = cvtpk(bflo(pv[i].z) * rv, bfhi(pv[i].z) * rv); w.w = cvtpk(bflo(pv[i].w) * rv, bfhi(pv[i].w) * rv);
                    *(LAS v4u*)(slab + ((lane >> 2) + 16 * i) * 64 + (lane & 3) * 16) = w; }
                const int cbn = cb + 1 < 8 ? cb + 1 : 7;
#pragma unroll
                for (int i = 0; i < 8; ++i) pv[i] = __builtin_amdgcn_raw_buffer_load_b128(rV, voffv, (row0 + 16 * i) * 4096 + cbn * 64, 0);
                LDS_WAIT(); asm volatile("" ::: "memory");
                bf16x8 af[8];
#pragma unroll
                for (int kk = 0; kk < 8; ++kk) { const s16x4_t lo = __builtin_amdgcn_ds_read_tr16_b64_v4i16((LAS s16x4_t*)(trp + kk * 1024)), h4 = __builtin_amdgcn_ds_read_tr16_b64_v4i16((LAS s16x4_t*)(trp + kk * 1024 + 256));
                    af[kk] = (bf16x8){lo[0], lo[1], lo[2], lo[3], h4[0], h4[1], h4[2], h4[3]}; }
#pragma unroll
                for (int tb = 0; tb < 4; ++tb) { f32x16 acc = {};
#pragma unroll
                    for (int kk = 0; kk < 2 * tb + 2; ++kk) acc = __builtin_amdgcn_mfma_f32_32x32x16_bf16(af[kk], wf[tb * (tb + 1) + kk], acc, 0, 0, 0);
#pragma unroll
                    for (int i4 = 0; i4 < 4; ++i4) { const f32x4 vg = *(const LAS f32x4*)(vgl + cb * 32 + 8 * i4 + 4 * hi); const v2u uu = pu[tb * 4 + i4];
                        const float o0 = bflo(uu.x) * (acc[4 * i4] * vg[0] + bias[tb]), o1 = bfhi(uu.x) * (acc[4 * i4 + 1] * vg[1] + bias[tb]), o2 = bflo(uu.y) * (acc[4 * i4 + 2] * vg[2] + bias[tb]), o3 = bfhi(uu.y) * (acc[4 * i4 + 3] * vg[3] + bias[tb]);
                        v2u w; w.x = pk2(o0, o1); w.y = pk2(o2, o3); __builtin_amdgcn_raw_buffer_store_b64(w, rG, voffu, (row0 + 32 * tb) * 4096 + cb * 64 + 16 * i4, 0); }
                    __builtin_amdgcn_sched_barrier(0); }
#pragma unroll
                for (int j = 0; j < 16; ++j) pu[j] = __builtin_amdgcn_raw_buffer_load_b64(rU, voffu, (row0 + 32 * (j >> 2)) * 4096 + cbn * 64 + 16 * (j & 3), 0);
                LDS_WAIT(); asm volatile("" ::: "memory");
            }
        }
        for (int r = bid; r < MP - NP; r += G) {
            const int row = NP + r; const float rv = rsqrtf(pg8::ss_get(SSV + row) * (1.0f / 2048.0f) + EPS); const f32x4 vg = *(const GAS f32x4*)(gmlp_v_g + c);
            const v2u vv = *(const GAS v2u*)(V0 + (size_t)row * 2048 + c); const v2u uu = *(const GAS v2u*)(U0 + (size_t)row * 2048 + c);
            const float w00 = gmlp_w_s[(size_t)g * 16384], bias = gmlp_b_s[g * 128];
            const float n0 = bflo(vv.x) * rv * vg[0], n1 = bfhi(vv.x) * rv * vg[1], n2 = bflo(vv.y) * rv * vg[2], n3 = bfhi(vv.y) * rv * vg[3];
            v2u w; w.x = pk2(bflo(uu.x) * (w00 * n0 + bias), bfhi(uu.x) * (w00 * n1 + bias)); w.y = pk2(bflo(uu.y) * (w00 * n2 + bias), bfhi(uu.y) * (w00 * n3 + bias));
            *(GAS v2u*)(G0 + (size_t)row * 2048 + c) = w;
            if (r < NS) *(GAS f32x4*)(out + O_CV + (size_t)r * 2048 + c) = (f32x4){n0, n1, n2, n3};
        }
    }
    SEAM(2);
    if (IN(3)) for (int rep = 0; rep < REP(3); ++rep) { pg8::Gemm g{G0, WOUT0T, NP, 1024, 2048}; pg8::StaticOrder S; S.init(NP, 1024, G, bid); pg8::EpiResid<false> E{x_prompt, x_sample, X1B, SS1, NP, NT, rep == 0};
        pg8::gemm_phase<pg8::EpiResid<false>, pg8::StaticOrder, true, true>(lds, g, S, E);
        for (int tk = bid; tk < 1024 / 32; tk += G) { float v0, v1; thin_gemm_tile<2048>(G0 + (size_t)NP * 2048, WOUT0T, tk * 32, (LAS float*)lds, tid, v0, v1);
            const int r = tid >> 4, row = NP + r, col = tk * 32 + 2 * (tid & 15); const f32x2 xr = *(const GAS f32x2*)(x_sample + (size_t)r * 1024 + col); v0 += xr[0]; v1 += xr[1];
            *(GAS unsigned*)(X1B + (size_t)row * 1024 + col) = pk2(v0, v1); const float sq = row16_sum(v0 * v0 + v1 * v1); if ((tid & 15) == 0 && rep == 0) pg8::ss_add(SS1 + row, sq); } }
    SEAM(3);
    if (IN(4)) for (int rep = 0; rep < REP(4); ++rep) { pg8::Gemm g{X1B, WP0T, NP, 2048, 1024};
        if (G == 256) {
            const EpiRoute ER{SS1, EIDX, GATE};
            { OneUnit S1; S1.init(NP, 2048, G, bid); S1.k = 0; pg8::gemm_phase<EpiRoute, OneUnit, false, true>(lds, g, S1, ER); }
            { OneUnit S1; S1.init(NP, 2048, G, bid); S1.k = 1; pg8::gemm_phase<EpiRoute, OneUnit, false, true>(lds, g, S1, ER); }
            { OneUnit S1; S1.init(NP, 2048, G, bid); S1.k = 2; pg8::gemm_phase<EpiRoute, OneUnit, false, true>(lds, g, S1, ER); }
            { OneUnit S1; S1.init(NP, 2048, G, bid); S1.k = 3; pg8::gemm_phase<EpiRoute, OneUnit, false, true>(lds, g, S1, ER); }
        } else { pg8::StaticOrder S; S.init(NP, 2048, G, bid); pg8::EpiScaleF16 E{SH, 2048, SS1};
            pg8::gemm_phase<pg8::EpiScaleF16, pg8::StaticOrder, true, true>(lds, g, S, E); }
        for (int tk = bid; tk < 2048 / 32; tk += G) { float v0, v1; thin_gemm_tile<1024>(X1B + (size_t)NP * 1024, WP0T, tk * 32, (LAS float*)lds, tid, v0, v1);
            const int r = tid >> 4, row = NP + r, col = tk * 32 + 2 * (tid & 15); const float rs = rsqrtf(pg8::ss_get(SS1 + row) * (1.0f / 1024.0f) + EPS);
            *(GAS unsigned*)(SH + (size_t)row * 2048 + col) = pg8::EpiScaleF16::pkh(v0 * rs, v1 * rs); } }
    SEAM(4);
    if (IN(5)) for (int rep = 0; rep < REP(5); ++rep) { { RouteIn RA, RB; int task = gw + (G == 256 ? NP * 2 : 0); if (task < NT * 2) peer_route_load(RA, SH, task, lane);
          for (; task < NT * 2; task += 2 * NGW) {
              if (task + NGW < NT * 2) peer_route_load(RB, SH, task + NGW, lane);
              peer_route_task(RA, EIDX, GATE, task, lane);
              if (task + NGW >= NT * 2) break;
              if (task + 2 * NGW < NT * 2) peer_route_load(RA, SH, task + 2 * NGW, lane);
              peer_route_task(RB, EIDX, GATE, task + NGW, lane); } }
        { XqIn QA, QB2; int tok = gw; if (tok < NT) peer_xq_load(QA, X1B, SS1, tok, lane);
          for (; tok < NT; tok += 2 * NGW) {
              if (tok + NGW < NT) peer_xq_load(QB2, X1B, SS1, tok + NGW, lane);
              peer_xq_token(QA, XQ, RSX, tok, lane);
              if (tok + NGW >= NT) break;
              if (tok + 2 * NGW < NT) peer_xq_load(QA, X1B, SS1, tok + 2 * NGW, lane);
              peer_xq_token(QB2, XQ, RSX, tok + NGW, lane); } } }
    SEAM(5);
    if (IN(6)) {
        LAS unsigned* lst = (LAS unsigned*)(lds + wave * 9216);
        PEER_QLOOP_CHUNK(QC + 0 * 512, peer_e1_chunk(XQ, RSX, EIDX, GATE, U8, SU, SV, ACT, lst, t0, t1, pi, lane));
        if (REP(6) == 2) PEER_QLOOP_CHUNK(QC + 4 * 512, peer_e1_chunk(XQ, RSX, EIDX, GATE, U8, SU, SV, ACT, lst, t0, t1, pi, lane));
        xcd_barrier(bar);
        if (REP(16) == 2) PEER_QLOOP_CHUNK(QC + 5 * 512, peer_e2_chunk<true>(X1B, EIDX, ACT, V8, nullptr, X2B, SS2, t0, t1, pi, lane));
        PEER_QLOOP_CHUNK(QC + 1 * 512, peer_e2_chunk<true>(X1B, EIDX, ACT, V8, nullptr, X2B, SS2, t0, t1, pi, lane));
        for (int r = NT + gw; r < MP; r += NGW) { (void)p0_row(nullptr, nullptr, X2B + (size_t)r * 1024, lane); if (lane < 8) SS2[(size_t)lane * MP + r] = 0.f; } }
    SEAM(6);
    if (IN(7)) for (int rep = 0; rep < REP(7); ++rep) { pg8::Gemm g{X2B, WIN1T, NP, APAD, 1024}; pg8::StaticOrder S; S.init(NP, APAD, G, bid); pg8::EpiScaleBf16 E{PBF, APAD, SS2, 8, MP};
        pg8::gemm_phase<pg8::EpiScaleBf16, pg8::StaticOrder, true, true>(lds, g, S, E);
        for (int tk = bid; tk < APAD / 32; tk += G) { float v0, v1; thin_gemm_tile<1024>(X2B + (size_t)NP * 1024, WIN1T, tk * 32, (LAS float*)lds, tid, v0, v1);
            const int r = tid >> 4, row = NP + r, col = tk * 32 + 2 * (tid & 15); float sa = 0.f;
#pragma unroll
            for (int pp = 0; pp < 8; ++pp) sa += SS2[(size_t)pp * MP + row];
            const float rs = rsqrtf(sa * (1.0f / 1024.0f) + EPS); *(GAS unsigned*)(PBF + (size_t)row * APAD + col) = pk2(v0 * rs, v1 * rs); } }
    SEAM(7);
    if (IN(8)) for (int rep = 0; rep < REP(8); ++rep) { { const float gq = att_qg[lane], gk = att_kg[lane], gik = att_ikg[lane]; PostRow RA, RB;
            int row = gw; if (row < NT) att_post_load(RA, PBF, row, lane);
            for (; row < NT; row += 2 * NGW) {
                if (row + NGW < NT) att_post_load(RB, PBF, row + NGW, lane);
                att_post_compute(RA, gq, gk, gik, ROPE, QB, KB, V2B, QIB, KIB, WI, out, row, lane);
                if (row + NGW >= NT) break;
                if (row + 2 * NGW < NT) att_post_load(RA, PBF, row + 2 * NGW, lane);
                att_post_compute(RB, gq, gk, gik, ROPE, QB, KB, V2B, QIB, KIB, WI, out, row + NGW, lane);
            } }
        for (int grp = gw; grp < NP / 8; grp += NGW) {
            const int row0 = grp * 8, b = row0 >> 12, t0 = row0 & 4095;
#pragma unroll
            for (int i = 0; i < 4; ++i) { unsigned v[8];
#pragma unroll
                for (int tt = 0; tt < 8; ++tt) v[tt] = (unsigned)PBF[(size_t)(row0 + tt) * APAD + 1280 + i * 64 + lane];
                v4u w; w.x = v[0] | (v[1] << 16); w.y = v[2] | (v[3] << 16); w.z = v[4] | (v[5] << 16); w.w = v[6] | (v[7] << 16);
                *(GAS v4u*)(VT + ((size_t)b * 256 + i * 64 + lane) * SEQ + t0) = w; } } }
    SEAM(8);
    if (IN(9)) for (int rep = 0; rep < REP(9); ++rep) {
        for (int w = gw; w < 2048; w += NGW) { const int b = w >> 8, half = (w >> 7) & 1, p = w & 127;
#pragma unroll 1
            for (int rep = 0; rep < 2; ++rep) { const int qb = rep ? 255 - p : p, nk = qb + 1; idx_scores_task(QIB, KIB, WI, SC, b, qb, (half * nk) >> 1, ((half + 1) * nk) >> 1, lane); } }
        LAS float* scr = (LAS float*)(lds + wave * 4096);
        for (int w = gw; w < NS * 129; w += NGW) samp_scores_task(QIB, WI, KIB, cache_ik, page_table, SKEYS, scr, w / 129, w % 129, lane);
    }
    SEAM(9);
    if (IN(10)) for (int rep = 0; rep < REP(10); ++rep) { unsigned raw[64], x[64];
        int p = gw; if (p < 8 * 2048) select_load(raw, SC, (p >> 11) * 4096 + (p & 2047), lane);
        for (; p < 8 * 2048; p += NGW) { const int rA = (p >> 11) * 4096 + (p & 2047), rB = (p >> 11) * 4096 + 4095 - (p & 2047);
            select_keys(x, raw, rA, lane); select_load(raw, SC, rB, lane); select_run(x, BM, rA, lane);
            select_keys(x, raw, rB, lane); if (p + NGW < 8 * 2048) select_load(raw, SC, ((p + NGW) >> 11) * 4096 + ((p + NGW) & 2047), lane); select_run(x, BM, rB, lane); } }
    SEAM(10);
    if (IN(11)) for (int rep = 0; rep < REP(11); ++rep) {
        for (int b = bid; b < NS; b += G) samp_select_attend(SKEYS, QB, KB, V2B, cache_k, cache_v, page_table, OB, lds, b, tid);
        __syncthreads();
        { float mq = fabsf(att_qg[lane]), mkk = fabsf(att_kg[lane]);
#pragma unroll
          for (int o = 1; o < 64; o <<= 1) { mq = fmaxf(mq, __shfl_xor(mq, o)); mkk = fmaxf(mkk, __shfl_xor(mkk, o)); }
          const float nbound = -(QSCALE * 64.0f * mq * mkk);
          if (tid < 16) { LAS unsigned* mt = (LAS unsigned*)(lds + 3 * ATT_STAGE + 64); mt[2 * tid] = ((tid & 1) ? 0xFFFFu : 0u) | ((tid & 2) ? 0xFFFF0000u : 0u); mt[2 * tid + 1] = ((tid & 4) ? 0xFFFFu : 0u) | ((tid & 8) ? 0xFFFF0000u : 0u); }
          __syncthreads();
          unsigned* qa = QC + 6 * 512; const int home = (int)(xb_xcc_id() & 7u); LAS int* tkp = (LAS int*)(lds + 3 * ATT_STAGE);
#pragma unroll 1
          for (int k = 0; k < 8; ++k) { const int pi = (home + k) & 7; unsigned* qh = qa + pi * 64;
              int nxt = 0; if (tid == 0) nxt = (int)__hip_atomic_fetch_add(qh, 1u, __ATOMIC_RELAXED, __HIP_MEMORY_SCOPE_AGENT);
#pragma unroll 1
              for (;;) { if (tid == 0) *tkp = nxt; __syncthreads(); const int c = __builtin_amdgcn_readfirstlane(*tkp);
                  if (c >= 256) break;
                  const int bk = pi * 4 + (c & 3), qt = 63 - (c >> 2); attend_unit(QB, KB, VT, BM, OB, lds, bk >> 2, bk & 3, qt, nbound, tid, qh, nxt); }
              __syncthreads(); } }
        for (int r = NT + gw; r < MP; r += NGW) (void)p0_row(nullptr, nullptr, OB + (size_t)r * 1024, lane);
    }
    SEAM(11);
    if (IN(12)) for (int rep = 0; rep < REP(12); ++rep) { pg8::Gemm g{OB, WOUT1T, NP, 1024, 1024}; pg8::StaticOrder S; S.init(NP, 1024, G, bid); pg8::EpiResid<true> E{X2B, nullptr, X3B, SS3, NP, NT, rep == 0};
        pg8::gemm_phase<pg8::EpiResid<true>, pg8::StaticOrder, true, true>(lds, g, S, E);
        for (int tk = bid; tk < 1024 / 32; tk += G) { float v0, v1; thin_gemm_tile<1024>(OB + (size_t)NP * 1024, WOUT1T, tk * 32, (LAS float*)lds, tid, v0, v1);
            const int r = tid >> 4, row = NP + r, col = tk * 32 + 2 * (tid & 15); const unsigned xr = *(const GAS unsigned*)(X2B + (size_t)row * 1024 + col); v0 += bflo(xr); v1 += bfhi(xr);
            *(GAS unsigned*)(X3B + (size_t)row * 1024 + col) = pk2(v0, v1); const float sq = row16_sum(v0 * v0 + v1 * v1); if ((tid & 15) == 0 && rep == 0) pg8::ss_add(SS3 + row, sq); } }
    SEAM(12);
    if (IN(13)) for (int rep = 0; rep < REP(13); ++rep) { pg8::Gemm g{X3B, WP1T, NP, 2048, 1024};
        if (G == 256) {
            const EpiRoute ER{SS3, EIDX, GATE};
            { OneUnit S1; S1.init(NP, 2048, G, bid); S1.k = 0; pg8::gemm_phase<EpiRoute, OneUnit, false, true>(lds, g, S1, ER); }
            { OneUnit S1; S1.init(NP, 2048, G, bid); S1.k = 1; pg8::gemm_phase<EpiRoute, OneUnit, false, true>(lds, g, S1, ER); }
            { OneUnit S1; S1.init(NP, 2048, G, bid); S1.k = 2; pg8::gemm_phase<EpiRoute, OneUnit, false, true>(lds, g, S1, ER); }
            { OneUnit S1; S1.init(NP, 2048, G, bid); S1.k = 3; pg8::gemm_phase<EpiRoute, OneUnit, false, true>(lds, g, S1, ER); }
        } else { pg8::StaticOrder S; S.init(NP, 2048, G, bid); pg8::EpiScaleF16 E{SH, 2048, SS3};
            pg8::gemm_phase<pg8::EpiScaleF16, pg8::StaticOrder, true, true>(lds, g, S, E); }
        for (int tk = bid; tk < 2048 / 32; tk += G) { float v0, v1; thin_gemm_tile<1024>(X3B + (size_t)NP * 1024, WP1T, tk * 32, (LAS float*)lds, tid, v0, v1);
            const int r = tid >> 4, row = NP + r, col = tk * 32 + 2 * (tid & 15); const float rs = rsqrtf(pg8::ss_get(SS3 + row) * (1.0f / 1024.0f) + EPS);
            *(GAS unsigned*)(SH + (size_t)row * 2048 + col) = pg8::EpiScaleF16::pkh(v0 * rs, v1 * rs); } }
    SEAM(13);
    if (IN(14)) for (int rep = 0; rep < REP(14); ++rep) { { RouteIn RA, RB; int task = gw + (G == 256 ? NP * 2 : 0); if (task < NT * 2) peer_route_load(RA, SH, task, lane);
          for (; task < NT * 2; task += 2 * NGW) {
              if (task + NGW < NT * 2) peer_route_load(RB, SH, task + NGW, lane);
              peer_route_task(RA, EIDX, GATE, task, lane);
              if (task + NGW >= NT * 2) break;
              if (task + 2 * NGW < NT * 2) peer_route_load(RA, SH, task + 2 * NGW, lane);
              peer_route_task(RB, EIDX, GATE, task + NGW, lane); } }
        { XqIn QA, QB2; int tok = gw; if (tok < NT) peer_xq_load(QA, X3B, SS3, tok, lane);
          for (; tok < NT; tok += 2 * NGW) {
              if (tok + NGW < NT) peer_xq_load(QB2, X3B, SS3, tok + NGW, lane);
              peer_xq_token(QA, XQ, RSX, tok, lane);
              if (tok + NGW >= NT) break;
              if (tok + 2 * NGW < NT) peer_xq_load(QA, X3B, SS3, tok + 2 * NGW, lane);
              peer_xq_token(QB2, XQ, RSX, tok + NGW, lane); } } }
    SEAM(14);
    if (IN(15)) {
        LAS unsigned* lst = (LAS unsigned*)(lds + wave * 9216);
        PEER_QLOOP_CHUNK(QC + 2 * 512, peer_e1_chunk(XQ, RSX, EIDX, GATE, U8 + (size_t)16384 * 1024, SU + 16384, SV + 16384, ACT, lst, t0, t1, pi, lane));
        xcd_barrier(bar);
        PEER_QLOOP_CHUNK(QC + 3 * 512, peer_e2_chunk<false>(X3B, EIDX, ACT, V8 + (size_t)16384 * 1024, out + O_Y, nullptr, nullptr, t0, t1, pi, lane)); }
#undef IN
#undef SEAM
}
constexpr int N_PHASES = 16;
}


extern "C" void kernel_launch(void* const* d_in, const int* in_sizes, int n_in, void* d_out, int out_size, void* d_ws, size_t ws_size, hipStream_t stream) {
    using namespace mk;
    static int grid = 0;
    if (grid == 0) {
        int dev = 0, cus = 0;
        if (hipGetDevice(&dev) != hipSuccess || hipDeviceGetAttribute(&cus, hipDeviceAttributeMultiprocessorCount, dev) != hipSuccess) { fprintf(stderr, "kernel_launch: device query failed\n"); grid = -1; return; }
        if (hipFuncSetAttribute((const void*)fused_fwd, hipFuncAttributeMaxDynamicSharedMemorySize, LDS_BYTES) != hipSuccess) { fprintf(stderr, "kernel_launch: hipFuncSetAttribute failed\n"); grid = -1; return; }
        int per_cu = 0;
        if (hipOccupancyMaxActiveBlocksPerMultiprocessor(&per_cu, (const void*)fused_fwd, NTHR, LDS_BYTES) != hipSuccess || per_cu < 1) fprintf(stderr, "kernel_launch: occupancy query says %d\n", per_cu);
        (void)hipGetLastError();
        grid = cus;
        if (ws_size < W_END) { fprintf(stderr, "kernel_launch: workspace too small (%zu < %zu)\n", ws_size, (size_t)W_END); grid = -1; return; }
    }
    if (grid < 0) return;
    (void)hipMemsetAsync(d_ws, 0, CTL_BYTES, stream);
    Params p{};
    for (int i = 0; i < 23; ++i) p.in[i] = (const float*)d_in[i];
    p.out = (float*)d_out; p.ws = (unsigned char*)d_ws;
    for (int i = 0; i < 32; ++i) p.inv[i] = (float)exp(-log(10000.0) * (double)i / 32.0);
    p.ph_lo = 0; p.ph_hi = N_PHASES;
    hipLaunchKernelGGL(fused_fwd, dim3(grid), dim3(NTHR), LDS_BYTES, stream, p);
}
```

```cpp
#include <hip/hip_runtime.h>
#include <cstdio>
#include <cstdint>
#include <math.h>
namespace pg8 {
#define PG8_LAS __attribute__((address_space(3)))
typedef unsigned short bf16_t;
typedef short bf16x8 __attribute__((ext_vector_type(8)));
typedef float f32x4 __attribute__((ext_vector_type(4)));
typedef unsigned u32x4 __attribute__((ext_vector_type(4)));
constexpr int BM = 256, BK = 64, HALF = 128, HTB = HALF * BK * 2  , STAGE_BYTES = 8 * HTB, NXCD = 8, WGM = 8;

__host__ __device__ __forceinline__ int lds_byte(int r, int c) { const int st = (r >> 4) * 2 + (c >> 5), rr = r & 15, cc = c & 31, ob = rr * 64 + cc * 2; return st * 1024 + (ob ^ (((ob >> 9) & 1) << 5)); }
__host__ __device__ __forceinline__ void stage_rc(int b, int& R, int& C) { const int st = b / 1024, sb = b % 1024, swz = sb ^ (((sb >> 9) & 1) << 5); R = (st >> 1) * 16 + swz / 64; C = (st & 1) * 32 + (swz % 64) / 2; }
__host__ __device__ __forceinline__ int perm32(int rho) { const int n = rho >> 4, i = rho & 15; return 8 * (i >> 2) + 4 * n + (i & 3); }

struct Unit { int pm, pn; };
struct Gemm { const bf16_t* A; const bf16_t* Bt; int M, N, K; };

struct StaticOrder {
    int nM, nN, nwg, G, c;
    __host__ __device__ void init(int M, int N, int G_, int c_) { nM = M / BM; nN = N / BM; nwg = nM * nN; G = G_; c = c_; }
    __host__ __device__ bool next(int i, Unit& u) const {
        const long L = (long)i * G + c; if (L >= nwg) return false;
        int wgid = (int)L; { const int q = nwg / NXCD, r = nwg % NXCD, xcd = wgid % NXCD, off = wgid / NXCD; wgid = (xcd < r ? xcd * (q + 1) : r * (q + 1) + (xcd - r) * q) + off; }
        const int nig = WGM * nN, gid = wgid / nig, fm = gid * WGM, gsz = (nM - fm) < WGM ? (nM - fm) : WGM;
        u.pm = fm + ((wgid % nig) % gsz); u.pn = (wgid % nig) / gsz; return true;
    }
    __device__ __forceinline__ void a_ready(const Unit&) const {}
    __device__ __forceinline__ void done(const Unit&) const {}
};

__device__ __forceinline__ unsigned cvt_pk_bf16(float lo, float hi) { unsigned r; asm volatile("v_cvt_pk_bf16_f32 %0, %1, %2" : "=v"(r) : "v"(lo), "v"(hi)); return r; }
typedef float f32x2 __attribute__((ext_vector_type(2)));

__device__ __forceinline__ void ss_add(unsigned long long* p, float sq) { (void)__hip_atomic_fetch_add(p, (unsigned long long)(sq * 16777216.0f), __ATOMIC_RELAXED, __HIP_MEMORY_SCOPE_AGENT); }
__device__ __forceinline__ float ss_get(const unsigned long long* p) { return (float)*p * (1.0f / 16777216.0f); }
struct EpiUV { static constexpr bool PERM = true, AFTER_DRAIN = false;
    bf16_t* U; bf16_t* V; const float* ss0; unsigned long long* ssv; int do_at;
    __device__ __forceinline__ void operator()(const f32x4 (&acc)[2][2][4][2], const Unit& u, int wr, int wc, int fr, int fq) const {
        const int row0 = u.pm * BM + wr * 64 + fr; const bool isv = u.pn >= 8; bf16_t* base = isv ? V : U;
        const int col0 = (u.pn & 7) * BM + wc * 32 + 8 * fq;
#pragma unroll
        for (int ai = 0; ai < 2; ++ai)
#pragma unroll
            for (int m = 0; m < 4; ++m) { const int row = row0 + ai * HALF + m * 16; const float rs = rsqrtf(ss0[row] * (1.0f / 1024.0f) + 1e-6f); float sq = 0.f;
                bf16_t* rowp = base + (size_t)row * 2048 + col0;
#pragma unroll
                for (int bj = 0; bj < 2; ++bj) { const f32x4 v0 = acc[ai][bj][m][0] * rs, v1 = acc[ai][bj][m][1] * rs;
                    sq += (v0[0] * v0[0] + v0[1] * v0[1]) + (v0[2] * v0[2] + v0[3] * v0[3]) + (v1[0] * v1[0] + v1[1] * v1[1]) + (v1[2] * v1[2] + v1[3] * v1[3]);
                    u32x4 w; w.x = cvt_pk_bf16(v0[0], v0[1]); w.y = cvt_pk_bf16(v0[2], v0[3]); w.z = cvt_pk_bf16(v1[0], v1[1]); w.w = cvt_pk_bf16(v1[2], v1[3]);
                    *(u32x4*)(rowp + bj * HALF) = w; }
                if (isv) { sq += __shfl_xor(sq, 16); sq += __shfl_xor(sq, 32); if (fq == 0 && do_at) ss_add(ssv + row, sq); } }
    }
};
template <bool RB16> struct EpiResid { static constexpr bool PERM = true, AFTER_DRAIN = false;
    const void* R0; const void* R1; bf16_t* Xb; unsigned long long* ssout; int np, nt, do_at;
    __device__ __forceinline__ void operator()(const f32x4 (&acc)[2][2][4][2], const Unit& u, int wr, int wc, int fr, int fq) const {
        const int row0 = u.pm * BM + wr * 64 + fr, col0 = u.pn * BM + wc * 32 + 8 * fq;
#pragma unroll
        for (int ai = 0; ai < 2; ++ai)
#pragma unroll
            for (int m = 0; m < 4; ++m) { const int row = row0 + ai * HALF + m * 16; float sq = 0.f;
#pragma unroll
                for (int bj = 0; bj < 2; ++bj) { f32x4 r0 = (f32x4){0.f, 0.f, 0.f, 0.f}, r1 = r0;
                    if constexpr (RB16) { if (row < nt) { const u32x4 rw = *(const u32x4*)((const bf16_t*)R0 + (size_t)row * 1024 + col0 + bj * HALF);
                            r0 = (f32x4){__uint_as_float(rw.x << 16), __uint_as_float(rw.x & 0xffff0000u), __uint_as_float(rw.y << 16), __uint_as_float(rw.y & 0xffff0000u)};
                            r1 = (f32x4){__uint_as_float(rw.z << 16), __uint_as_float(rw.z & 0xffff0000u), __uint_as_float(rw.w << 16), __uint_as_float(rw.w & 0xffff0000u)}; } }
                    else { const float* rp = row < np ? (const float*)R0 + (size_t)row * 1024 : (row < nt ? (const float*)R1 + (size_t)(row - np) * 1024 : nullptr);
                        if (rp) { r0 = *(const f32x4*)(rp + col0 + bj * HALF); r1 = *(const f32x4*)(rp + col0 + bj * HALF + 4); } }
                    const f32x4 v0 = acc[ai][bj][m][0] + r0, v1 = acc[ai][bj][m][1] + r1;
                    sq += (v0[0] * v0[0] + v0[1] * v0[1]) + (v0[2] * v0[2] + v0[3] * v0[3]) + (v1[0] * v1[0] + v1[1] * v1[1]) + (v1[2] * v1[2] + v1[3] * v1[3]);
                    u32x4 w; w.x = cvt_pk_bf16(v0[0], v0[1]); w.y = cvt_pk_bf16(v0[2], v0[3]); w.z = cvt_pk_bf16(v1[0], v1[1]); w.w = cvt_pk_bf16(v1[2], v1[3]);
                    *(u32x4*)(Xb + (size_t)row * 1024 + col0 + bj * HALF) = w; }
                sq += __shfl_xor(sq, 16); sq += __shfl_xor(sq, 32); if (fq == 0 && do_at) ss_add(ssout + row, sq); }
    }
};
struct EpiScaleF32 { static constexpr bool PERM = false, AFTER_DRAIN = false;
    float* C; int ldc; const float* ss; int nparts; int pstride;
    __device__ __forceinline__ void operator()(const f32x4 (&acc)[2][2][4][2], const Unit& u, int wr, int wc, int fr, int fq) const {
        const int row0 = u.pm * BM + wr * 64 + fr, col0 = u.pn * BM + wc * 32 + 4 * fq;
#pragma unroll
        for (int ai = 0; ai < 2; ++ai)
#pragma unroll
            for (int m = 0; m < 4; ++m) { const int row = row0 + ai * HALF + m * 16; float sa = ss[row]; for (int pp = 1; pp < nparts; ++pp) sa += ss[(size_t)pp * pstride + row];
                const float rs = rsqrtf(sa * (1.0f / 1024.0f) + 1e-6f);
                float* rowp = C + (size_t)row * ldc + col0;
#pragma unroll
                for (int bj = 0; bj < 2; ++bj)
#pragma unroll
                    for (int n = 0; n < 2; ++n) *(f32x4*)(rowp + bj * HALF + n * 16) = acc[ai][bj][m][n] * rs; }
    }
};
struct EpiScaleBf16 { static constexpr bool PERM = true, AFTER_DRAIN = false;
    bf16_t* O; int ldc; const float* ss; int nparts; int pstride;
    __device__ __forceinline__ void operator()(const f32x4 (&acc)[2][2][4][2], const Unit& u, int wr, int wc, int fr, int fq) const {
        const int row0 = u.pm * BM + wr * 64 + fr, col0 = u.pn * BM + wc * 32 + 8 * fq;
#pragma unroll
        for (int ai = 0; ai < 2; ++ai)
#pragma unroll
            for (int m = 0; m < 4; ++m) { const int row = row0 + ai * HALF + m * 16; float sa = ss[row]; for (int pp = 1; pp < nparts; ++pp) sa += ss[(size_t)pp * pstride + row];
                const float rs = rsqrtf(sa * (1.0f / 1024.0f) + 1e-6f);
                bf16_t* rowp = O + (size_t)row * ldc + col0;
#pragma unroll
                for (int bj = 0; bj < 2; ++bj) { const f32x4 v0 = acc[ai][bj][m][0] * rs, v1 = acc[ai][bj][m][1] * rs;
                    u32x4 w; w.x = cvt_pk_bf16(v0[0], v0[1]); w.y = cvt_pk_bf16(v0[2], v0[3]); w.z = cvt_pk_bf16(v1[0], v1[1]); w.w = cvt_pk_bf16(v1[2], v1[3]);
                    *(u32x4*)(rowp + bj * HALF) = w; } }
    }
};
struct EpiScaleF16 { static constexpr bool PERM = true, AFTER_DRAIN = false;
    unsigned short* O; int ldc; const unsigned long long* ss;
    __device__ __forceinline__ static unsigned pkh(float a, float b) { typedef _Float16 h2 __attribute__((ext_vector_type(2))); h2 h; h[0] = (_Float16)a; h[1] = (_Float16)b; return __builtin_bit_cast(unsigned, h); }
    __device__ __forceinline__ void operator()(const f32x4 (&acc)[2][2][4][2], const Unit& u, int wr, int wc, int fr, int fq) const {
        const int row0 = u.pm * BM + wr * 64 + fr, col0 = u.pn * BM + wc * 32 + 8 * fq;
#pragma unroll
        for (int ai = 0; ai < 2; ++ai)
#pragma unroll
            for (int m = 0; m < 4; ++m) { const int row = row0 + ai * HALF + m * 16; const float rs = rsqrtf(ss_get(ss + row) * (1.0f / 1024.0f) + 1e-6f);
                unsigned short* rowp = O + (size_t)row * ldc + col0;
#pragma unroll
                for (int bj = 0; bj < 2; ++bj) { const f32x4 v0 = acc[ai][bj][m][0] * rs, v1 = acc[ai][bj][m][1] * rs;
                    u32x4 w; w.x = pkh(v0[0], v0[1]); w.y = pkh(v0[2], v0[3]); w.z = pkh(v1[0], v1[1]); w.w = pkh(v1[2], v1[3]);
                    *(u32x4*)(rowp + bj * HALF) = w; } }
    }
};
template <class Epi, class Sched, bool ALIGN_EPI = false, bool SP2 = false>
__device__ __forceinline__ void gemm_phase(PG8_LAS unsigned char* lds, const Gemm g, const Sched& S, const Epi& E) {
    const int tid = threadIdx.x, wid = __builtin_amdgcn_readfirstlane(tid >> 6), lane = tid & 63, wr = wid >> 2, wc = wid & 3, fr = lane & 15, fq = lane >> 4;
    const int K = g.K, nt = K / BK;
    unsigned voffA[2], voffB[2];
#pragma unroll
    for (int i = 0; i < 2; ++i) { int R, C; stage_rc(tid * 16 + i * 8192, R, C); const int Rb = Epi::PERM ? ((R & ~31) + perm32(R & 31)) : R;
        voffA[i] = (unsigned)(R * K + C) * 2u; voffB[i] = (unsigned)(Rb * K + C) * 2u; }
    const size_t kstep = (size_t)(BK * 2);
    const size_t hstep = (size_t)HALF * K * 2;
    const size_t tstep = 2 * hstep;
    const unsigned ldsw = (unsigned)wid * 1024u;
    const int aoff = lds_byte(wr * 64 + fr, fq * 8), boff = lds_byte(wc * 32 + fr, fq * 8);
#define PG8_SA(b, h) (((b) * 2 + (h)) * HTB)
#define PG8_SB(b, h) ((4 + (b) * 2 + (h)) * HTB)
#define PG8_STAGE(bufoff, gbase, voff) do { _Pragma("unroll") for (int _i = 0; _i < 2; ++_i) \
        __builtin_amdgcn_global_load_lds((const unsigned*)((const char*)(gbase) + (voff)[_i]), (PG8_LAS unsigned*)(lds + (bufoff) + ldsw + _i * 8192), 16, 0, 0); } while (0)
#define PG8_LDA(dst, b, h) do { _Pragma("unroll") for (int m = 0; m < 4; ++m) _Pragma("unroll") for (int k = 0; k < 2; ++k) dst[m][k] = *(const PG8_LAS bf16x8*)(lds + PG8_SA(b, h) + aoff + m * 2048 + k * 1024); } while (0)
#define PG8_LDB(dst, b, h) do { _Pragma("unroll") for (int n = 0; n < 2; ++n) _Pragma("unroll") for (int k = 0; k < 2; ++k) dst[n][k] = *(const PG8_LAS bf16x8*)(lds + PG8_SB(b, h) + boff + n * 2048 + k * 1024); } while (0)
#define PG8_MMA(ai, bj, At, Bt) do { __builtin_amdgcn_s_setprio(1); _Pragma("unroll") for (int m = 0; m < 4; ++m) _Pragma("unroll") for (int n = 0; n < 2; ++n) _Pragma("unroll") for (int k = 0; k < 2; ++k) \
        acc[ai][bj][m][n] = __builtin_amdgcn_mfma_f32_16x16x32_bf16(Bt[n][k], At[m][k], acc[ai][bj][m][n], 0, 0, 0); __builtin_amdgcn_s_setprio(0); } while (0)
#define PG8_WAIT_V(n) asm volatile("s_waitcnt vmcnt(" #n ")" ::: "memory")
#define PG8_WAIT_L(n) asm volatile("s_waitcnt lgkmcnt(" #n ")" ::: "memory")
#define PG8_BAR __builtin_amdgcn_s_barrier()
#define PG8_SCHED __builtin_amdgcn_sched_barrier(0)
    Unit cur, nxt; int ui = 0;
    if (!S.next(0, cur)) return;
    f32x4 acc[2][2][4][2];
#pragma unroll
    for (int a = 0; a < 2; ++a)
#pragma unroll
        for (int b = 0; b < 2; ++b)
#pragma unroll
            for (int m = 0; m < 4; ++m)
#pragma unroll
                for (int n = 0; n < 2; ++n) acc[a][b][m][n] = (f32x4){0.f, 0.f, 0.f, 0.f};
    bf16x8 At[4][2], B0[2][2], B1[2][2];
    const char* cA = (const char*)g.A + (size_t)cur.pm * tstep; const char* cB = (const char*)g.Bt + (size_t)cur.pn * tstep;
    S.a_ready(cur);
    if constexpr (SP2) {
        PG8_STAGE(PG8_SB(0, 0), cB, voffB); PG8_STAGE(PG8_SB(0, 1), cB + hstep, voffB); PG8_STAGE(PG8_SA(0, 0), cA, voffA); PG8_STAGE(PG8_SA(0, 1), cA + hstep, voffA);
        if (wr == 1) PG8_BAR;
        PG8_WAIT_V(2); PG8_BAR;
        PG8_STAGE(PG8_SB(1, 0), cB + kstep, voffB); PG8_STAGE(PG8_SA(1, 0), cA + kstep, voffA); PG8_STAGE(PG8_SB(1, 1), cB + hstep + kstep, voffB);
        PG8_WAIT_V(6); PG8_BAR;
    } else {
        PG8_STAGE(PG8_SB(0, 0), cB, voffB); PG8_STAGE(PG8_SA(0, 0), cA, voffA); PG8_STAGE(PG8_SB(0, 1), cB + hstep, voffB); PG8_STAGE(PG8_SA(0, 1), cA + hstep, voffA);
        if (wr == 1) PG8_BAR;
        PG8_WAIT_V(4); PG8_BAR;
        PG8_STAGE(PG8_SB(1, 0), cB + kstep, voffB); PG8_STAGE(PG8_SA(1, 0), cA + kstep, voffA); PG8_STAGE(PG8_SB(1, 1), cB + hstep + kstep, voffB);
        PG8_WAIT_V(6); PG8_BAR;
    }
    for (;;) {
        const bool has_next = S.next(ui + 1, nxt);
        const char* nA = has_next ? (const char*)g.A + (size_t)nxt.pm * tstep : cA; const char* nB = has_next ? (const char*)g.Bt + (size_t)nxt.pn * tstep : cB;
        for (int t = 0; t < nt; t += 2) {
            const bool last = (t == nt - 2);
            const char* a1 = cA + (size_t)(t + 1) * kstep;
            const char* a2 = last ? nA : cA + (size_t)(t + 2) * kstep; const char* b2 = last ? nB : cB + (size_t)(t + 2) * kstep;
            const char* a3 = a2 + kstep; const char* b3 = b2 + kstep;
            if (last && has_next) S.a_ready(nxt);
            if constexpr (SP2) {
            PG8_LDB(B0, 0, 0); PG8_LDB(B1, 0, 1); PG8_SCHED; PG8_LDA(At, 0, 0); PG8_STAGE(PG8_SA(1, 1), a1 + hstep, voffA);
            PG8_WAIT_V(8); PG8_WAIT_L(0); PG8_BAR; PG8_MMA(0, 0, At, B0); PG8_MMA(0, 1, At, B1); PG8_BAR; PG8_SCHED;
            PG8_LDA(At, 0, 1); PG8_STAGE(PG8_SB(0, 0), b2, voffB); PG8_STAGE(PG8_SB(0, 1), b2 + hstep, voffB); PG8_STAGE(PG8_SA(0, 0), a2, voffA);
            PG8_WAIT_V(8); PG8_WAIT_L(0); PG8_BAR; PG8_MMA(1, 0, At, B0); PG8_MMA(1, 1, At, B1); PG8_BAR; PG8_SCHED;
            PG8_LDB(B0, 1, 0); PG8_LDB(B1, 1, 1); PG8_SCHED; PG8_LDA(At, 1, 0); PG8_STAGE(PG8_SA(0, 1), a2 + hstep, voffA);
            PG8_WAIT_V(8); PG8_WAIT_L(0); PG8_BAR; PG8_MMA(0, 0, At, B0); PG8_MMA(0, 1, At, B1); PG8_BAR; PG8_SCHED;
            PG8_LDA(At, 1, 1); PG8_STAGE(PG8_SB(1, 0), b3, voffB); PG8_STAGE(PG8_SB(1, 1), b3 + hstep, voffB); PG8_STAGE(PG8_SA(1, 0), a3, voffA);
            PG8_WAIT_V(8); PG8_WAIT_L(0); PG8_BAR; PG8_MMA(1, 0, At, B0); PG8_MMA(1, 1, At, B1); PG8_BAR; PG8_SCHED;
            } else {
            PG8_LDB(B0, 0, 0); PG8_SCHED; PG8_LDA(At, 0, 0); PG8_STAGE(PG8_SA(1, 1), a1 + hstep, voffA);
            PG8_WAIT_L(8); PG8_BAR; PG8_WAIT_L(0); PG8_MMA(0, 0, At, B0); PG8_BAR; PG8_SCHED;
            PG8_LDB(B1, 0, 1); PG8_STAGE(PG8_SB(0, 0), b2, voffB);
            PG8_BAR; PG8_WAIT_L(0); PG8_MMA(0, 1, At, B1); PG8_BAR;
            PG8_LDA(At, 0, 1); PG8_STAGE(PG8_SA(0, 0), a2, voffA);
            PG8_BAR; PG8_WAIT_L(0); PG8_MMA(1, 0, At, B0); PG8_BAR; PG8_SCHED;
            PG8_STAGE(PG8_SB(0, 1), b2 + hstep, voffB);
            PG8_WAIT_V(6); PG8_BAR; PG8_MMA(1, 1, At, B1); PG8_BAR;
            PG8_LDB(B0, 1, 0); PG8_SCHED; PG8_LDA(At, 1, 0); PG8_STAGE(PG8_SA(0, 1), a2 + hstep, voffA);
            PG8_WAIT_L(8); PG8_BAR; PG8_WAIT_L(0); PG8_MMA(0, 0, At, B0); PG8_BAR; PG8_SCHED;
            PG8_LDB(B1, 1, 1); PG8_STAGE(PG8_SB(1, 0), b3, voffB);
            PG8_BAR; PG8_WAIT_L(0); PG8_MMA(0, 1, At, B1); PG8_BAR;
            PG8_LDA(At, 1, 1); PG8_STAGE(PG8_SA(1, 0), a3, voffA);
            PG8_BAR; PG8_WAIT_L(0); PG8_MMA(1, 0, At, B0); PG8_BAR; PG8_SCHED;
            PG8_STAGE(PG8_SB(1, 1), b3 + hstep, voffB);
            PG8_WAIT_V(6); PG8_BAR; PG8_MMA(1, 1, At, B1); PG8_BAR;
            }
        }
        if constexpr (ALIGN_EPI) { if (wr == 0) PG8_BAR; }
        if constexpr (!Epi::AFTER_DRAIN) { E(acc, cur, wr, wc, fr, fq); S.done(cur); }
        if (!has_next) break;
#pragma unroll
        for (int a = 0; a < 2; ++a)
#pragma unroll
            for (int b = 0; b < 2; ++b)
#pragma unroll
                for (int m = 0; m < 4; ++m)
#pragma unroll
                    for (int n = 0; n < 2; ++n) acc[a][b][m][n] = (f32x4){0.f, 0.f, 0.f, 0.f};
        cur = nxt; cA = nA; cB = nB; ++ui;
        if constexpr (ALIGN_EPI) { if (wr == 1) PG8_BAR; }
    }
    PG8_WAIT_V(0);
    if constexpr (!ALIGN_EPI) { if (wr == 0) PG8_BAR; }
    PG8_BAR;
    if constexpr (Epi::AFTER_DRAIN) { E.fused(acc, cur, wr, wc, fr, fq, lds, wid, lane); S.done(cur); }
#undef PG8_SA
#undef PG8_SB
#undef PG8_STAGE
#undef PG8_LDA
#undef PG8_LDB
#undef PG8_MMA
#undef PG8_WAIT_V
#undef PG8_WAIT_L
#undef PG8_BAR
#undef PG8_SCHED
}

}

#define GAS __attribute__((address_space(1)))
#define LAS __attribute__((address_space(3)))
typedef unsigned short bf16;
typedef unsigned v4u __attribute__((ext_vector_type(4)));
typedef unsigned v2u __attribute__((ext_vector_type(2)));
typedef float f32x4 __attribute__((ext_vector_type(4)));
typedef float f32x2 __attribute__((ext_vector_type(2)));
typedef float f32x16 __attribute__((ext_vector_type(16)));
typedef short bf16x8 __attribute__((ext_vector_type(8)));
typedef __bf16 bf16x2_t __attribute__((ext_vector_type(2)));
typedef GAS unsigned gu32;
typedef GAS unsigned long long gu64;
#define RLX_AGENT __ATOMIC_RELAXED, __HIP_MEMORY_SCOPE_AGENT
#define LDS_WAIT() asm volatile("s_waitcnt lgkmcnt(0)" ::: "memory")
#define VM_WAIT() asm volatile("s_waitcnt vmcnt(0)" ::: "memory")
__device__ __forceinline__ unsigned long long rt() { return __builtin_amdgcn_s_memrealtime(); }
__device__ __forceinline__ unsigned f2bf(float f) { unsigned u = __builtin_bit_cast(unsigned, f); return (u + 0x7fffu + ((u >> 16) & 1u)) >> 16; }
__device__ __forceinline__ unsigned pk2(float lo, float hi) { return f2bf(lo) | (f2bf(hi) << 16); }

#define XB_TMO      128
#define XB_XCNT(j)  (256  + 64 * (j))
#define XB_XSUB(j)  (1280 + 64 * (j))
#define XB_XGEN(j)  (2304 + 64 * (j))
#define XB_TOP      3328
#define XB_TOPGEN   3392
#define XCD_BAR_WORDS 3456
#define XB_SPIN_CAP (1u << 18)

__device__ __forceinline__ unsigned xb_ld(unsigned* p)              { return __hip_atomic_load(p, __ATOMIC_RELAXED, __HIP_MEMORY_SCOPE_AGENT); }
__device__ __forceinline__ unsigned xb_add(unsigned* p, unsigned v) { return __hip_atomic_fetch_add(p, v, __ATOMIC_RELAXED, __HIP_MEMORY_SCOPE_AGENT); }
__device__ __forceinline__ unsigned xb_xcc_id() { return (unsigned)__builtin_amdgcn_s_getreg((3 << 11) | 20) & 0xFu; }
#define XB_SPIN(cond, bar) do { unsigned _sp = 0; while (cond) { __builtin_amdgcn_s_sleep(1); \
    if ((++_sp & 255u) == 0u) { if (xb_ld(&(bar)[XB_TMO])) break; if (_sp > XB_SPIN_CAP) { atomicAdd(&(bar)[XB_TMO], 1u); break; } } } } while (0)

struct XcdBarrier {
    unsigned* bar; unsigned x;
    volatile LAS unsigned* st;
};

__device__ __forceinline__ XcdBarrier xcd_barrier_post(unsigned* bar, volatile LAS unsigned* st) {
    XcdBarrier b; b.bar = bar; b.x = xb_xcc_id(); b.st = st;
    if (threadIdx.x == 0) (void)xb_add(&bar[XB_XCNT(b.x)], 1u);
    return b;
}
__device__ __forceinline__ void xcd_barrier_complete(unsigned* bar, unsigned x, unsigned& nloc, unsigned& nx) {
    const unsigned G = gridDim.x * gridDim.y * gridDim.z;
    unsigned sum, cnt, mine, sp = 0u;
    for (;;) {
        sum = 0u; cnt = 0u; mine = 0u;
#pragma unroll
        for (unsigned j = 0; j < 16; ++j) { const unsigned c = xb_ld(&bar[XB_XCNT(j)]); sum += c; cnt += (c > 0u) ? 1u : 0u; mine = (j == x) ? c : mine; }
        if (sum == G) break;
        __builtin_amdgcn_s_sleep(1);
        if ((++sp & 255u) == 0u) { if (xb_ld(&bar[XB_TMO])) break; if (sp > XB_SPIN_CAP) { atomicAdd(&bar[XB_TMO], 1u); break; } }
    }
    nloc = mine > 0u ? mine : 1u; nx = cnt > 0u ? cnt : 1u;
}

__device__ __forceinline__ void xcd_barrier(const XcdBarrier& b) {
    asm volatile("s_waitcnt vmcnt(0)" ::: "memory");
    __syncthreads();
    if (threadIdx.x == 0) {
        unsigned* bar = b.bar;
        __builtin_amdgcn_s_waitcnt(0);
        unsigned nloc = b.st[0], nx = b.st[1];
        if (nloc == 0u) { xcd_barrier_complete(bar, b.x, nloc, nx); b.st[0] = nloc; b.st[1] = nx; }
        const unsigned old = xb_add(&bar[XB_XSUB(b.x)], 1u);
        const unsigned gen = old / nloc;
        if (old + 1u == (gen + 1u) * nloc) {
            __builtin_amdgcn_fence(__ATOMIC_RELEASE, "agent");
            asm volatile("s_waitcnt vmcnt(0)" ::: "memory");
            const unsigned og = xb_add(&bar[XB_TOP], 1u);
            const unsigned tg = og / nx;
            if (og + 1u == (tg + 1u) * nx) xb_add(&bar[XB_TOPGEN], 1u);
            else XB_SPIN(xb_ld(&bar[XB_TOPGEN]) == tg, bar);
            __builtin_amdgcn_fence(__ATOMIC_ACQUIRE, "agent");
            xb_add(&bar[XB_XGEN(b.x)], 1u);
            asm volatile("s_waitcnt vmcnt(0)" ::: "memory");
        } else {
            XB_SPIN(xb_ld(&bar[XB_XGEN(b.x)]) == gen, bar);
            __builtin_amdgcn_fence(__ATOMIC_ACQUIRE, "agent");
            asm volatile("s_waitcnt vmcnt(0)" ::: "memory");
        }
    }

    __syncthreads();
}

namespace mk {
constexpr int D = 1024, NP = 32768, NS = 32, NT = NP + NS, MP = 33024, SEQ = 4096;
constexpr int PAST = 16384, NPAGE = 128, APROJ = 2120, APAD = 2304;
constexpr int NWAVES = 8, NTHR = 512;
constexpr float EPS = 1e-6f;
constexpr float IDX_SCALE = 0.04419417382415922f;
constexpr float QSCALE = 0.125f * 1.4426950408889634f;
constexpr size_t O_Y = 0, O_KP = 33587200, O_VP = 41975808, O_IP = 50364416, O_KS = 52461568, O_VS = 52469760, O_IS = 52477952, O_CV = 52480000;
constexpr size_t A256(size_t x) { return (x + 255) & ~(size_t)255; }
constexpr size_t CTL_BYTES = 2u << 20;
constexpr int CW_BAR = 4096;
constexpr size_t W_SSV = 256u << 10, W_SS1 = 576u << 10, W_SS3 = 896u << 10, W_QC = 64u << 10;
constexpr size_t W_SS0 = CTL_BYTES;
constexpr size_t W_SS2 = W_SS0 + A256((size_t)MP * 4);
constexpr size_t W_X0B = W_SS2 + A256((size_t)8 * MP * 4);
constexpr size_t W_WIN0T = W_X0B + A256((size_t)MP * 1024 * 2);
constexpr size_t W_WOUT0T = W_WIN0T + A256((size_t)4096 * 1024 * 2);
constexpr size_t W_WP0T = W_WOUT0T + A256((size_t)1024 * 2048 * 2);
constexpr size_t W_WP1T = W_WP0T + A256((size_t)2048 * 1024 * 2);
constexpr size_t W_WIN1T = W_WP1T + A256((size_t)2048 * 1024 * 2);
constexpr size_t W_WOUT1T = W_WIN1T + A256((size_t)APAD * 1024 * 2);
constexpr size_t W_WSMT = W_WOUT1T + A256((size_t)1024 * 1024 * 2);
constexpr size_t W_ROPE = W_WSMT + A256((size_t)8 * 128 * 128 * 4);
constexpr size_t W_UB = W_ROPE + A256((size_t)4097 * 64 * 4);
constexpr size_t W_VB = W_UB + A256((size_t)2 * 16384 * 1024 * 2);
constexpr size_t W_SU = W_VB + A256((size_t)2 * 16384 * 1024 * 2);
constexpr size_t W_SV = W_SU + A256((size_t)2 * 16384 * 4);
constexpr size_t W_X1B = W_SV + A256((size_t)2 * 16384 * 4);
constexpr size_t W_X2B = W_X1B + A256((size_t)MP * 1024 * 2);
constexpr size_t W_X3B = W_X2B + A256((size_t)MP * 1024 * 2);
constexpr size_t W_X1 = W_X3B + A256((size_t)MP * 1024 * 2);
constexpr size_t W_X2 = W_X1 + A256((size_t)MP * 1024 * 4);
constexpr size_t W_X3 = W_X2 + A256((size_t)MP * 1024 * 4);
constexpr size_t W_BIG = W_X3 + A256((size_t)MP * 1024 * 4);
constexpr size_t BIG_BYTES = (size_t)NP * 4096 * 4;
constexpr size_t W_U0 = W_BIG, W_V0 = W_U0 + A256((size_t)MP * 2048 * 2), W_G0 = W_V0 + A256((size_t)MP * 2048 * 2);
static_assert(W_G0 + (size_t)MP * 2048 * 2 <= W_BIG + BIG_BYTES, "union");
static_assert((size_t)MP * APAD * 4 <= BIG_BYTES, "union");
constexpr size_t W_EIDX = W_BIG + A256(BIG_BYTES);
constexpr size_t W_GATE = W_EIDX + A256((size_t)MP * 128 * 4);
constexpr size_t W_QB = W_GATE + A256((size_t)MP * 128 * 4);
constexpr size_t W_KB = W_QB + A256((size_t)MP * 1024 * 2);
constexpr size_t W_V2B = W_KB + A256((size_t)MP * 256 * 2);
constexpr size_t W_QIB = W_V2B + A256((size_t)MP * 256 * 2);
constexpr size_t W_KIB = W_QIB + A256((size_t)MP * 512 * 2);
constexpr size_t W_WI = W_KIB + A256((size_t)MP * 64 * 2);
constexpr size_t W_SEL = W_WI + A256((size_t)MP * 8 * 4);
constexpr size_t W_SKEYS = W_SEL + A256((size_t)NP * 64 * 8);
constexpr size_t W_OB = W_SKEYS + A256((size_t)32 * 16640 * 4);
constexpr size_t W_VT = W_OB + A256((size_t)MP * 1024 * 2);
constexpr size_t W_XQ = W_VT + A256((size_t)NP * 256 * 2);
constexpr size_t W_RSX = W_XQ + A256((size_t)MP * 1024);
constexpr size_t W_ACT = W_RSX + A256((size_t)MP * 4);
constexpr size_t W_END = W_ACT + A256((size_t)MP * 128 * 4);
constexpr int RING_BYTES = 131072, MISC_OFF = RING_BYTES + 320, LDS_BYTES = 147456;

struct Params { const float* in[23]; float* out; unsigned char* ws; float inv[32]; int ph_lo, ph_hi; };

__device__ __forceinline__ float wave_sum(float v) {
#pragma unroll
    for (int o = 1; o < 64; o <<= 1) v += __shfl_xor(v, o);
    return v;
}
__device__ __forceinline__ float bflo(unsigned w) { return __uint_as_float(w << 16); }
__device__ __forceinline__ float bfhi(unsigned w) { return __uint_as_float(w & 0xffff0000u); }
__device__ __forceinline__ unsigned f2key(float f) { f = f + 0.0f; const unsigned u = __float_as_uint(f); return (u & 0x80000000u) ? ~u : (u | 0x80000000u); }
__device__ __forceinline__ float key2f(unsigned k) { const unsigned u = (k & 0x80000000u) ? (k & 0x7fffffffu) : ~k; return __uint_as_float(u); }
__device__ __forceinline__ float fast_exp2(float x) { return __builtin_amdgcn_exp2f(x); }
__device__ __forceinline__ float gelu_tanh(float x) {
    const float a = 0.7978845608028654f * (x + 0.044715f * x * x * x);
    const float e = fast_exp2(a * 2.8853900817779268f);
    const float t = 1.0f - 2.0f * __builtin_amdgcn_rcpf(1.0f + e);
    return 0.5f * x * (1.0f + t);
}
__device__ __forceinline__ unsigned long long lanemask_lt(int lane) { return (1ull << lane) - 1ull; }
__device__ __forceinline__ float dot2bf(unsigned a, unsigned b, float c) { return __builtin_amdgcn_fdot2_f32_bf16(__builtin_bit_cast(bf16x2_t, a), __builtin_bit_cast(bf16x2_t, b), c, false); }

__device__ __forceinline__ int xadd32i(int a, int b) { const auto r = __builtin_amdgcn_permlane32_swap((unsigned)a, (unsigned)b, false, false); return (int)r[0] + (int)r[1]; }
__device__ __forceinline__ int xadd16i(int a, int b) { const auto r = __builtin_amdgcn_permlane16_swap((unsigned)a, (unsigned)b, false, false); return (int)r[0] + (int)r[1]; }
__device__ __forceinline__ int ror8i(int v) { return __builtin_amdgcn_update_dpp(0, v, 0x128, 0xf, 0xf, false); }
__device__ __forceinline__ int sum8i(int t) { t += __builtin_amdgcn_update_dpp(0, t, 0xB1, 0xf, 0xf, false); t += __builtin_amdgcn_update_dpp(0, t, 0x4E, 0xf, 0xf, false); t += __builtin_amdgcn_update_dpp(0, t, 0x141, 0xf, 0xf, false); return t; }
__device__ __forceinline__ float wave_max_f(float m) {
    m = fmaxf(m, __int_as_float(__builtin_amdgcn_update_dpp(0, __float_as_int(m), 0x121, 0xf, 0xf, false))); m = fmaxf(m, __int_as_float(__builtin_amdgcn_update_dpp(0, __float_as_int(m), 0x122, 0xf, 0xf, false)));
    m = fmaxf(m, __int_as_float(__builtin_amdgcn_update_dpp(0, __float_as_int(m), 0x124, 0xf, 0xf, false))); m = fmaxf(m, __int_as_float(__builtin_amdgcn_update_dpp(0, __float_as_int(m), 0x128, 0xf, 0xf, false)));
    { const auto r = __builtin_amdgcn_permlane16_swap(__float_as_uint(m), __float_as_uint(m), false, false); m = fmaxf(__uint_as_float(r[0]), __uint_as_float(r[1])); }
    { const auto r = __builtin_amdgcn_permlane32_swap(__float_as_uint(m), __float_as_uint(m), false, false); m = fmaxf(__uint_as_float(r[0]), __uint_as_float(r[1])); }
    return m;
}
__device__ __forceinline__ unsigned cvtpk(float lo, float hi) { const f32x2 v = {lo, hi}; const bf16x2_t b = __builtin_convertvector(v, bf16x2_t); return __builtin_bit_cast(unsigned, b); }
__device__ __forceinline__ void p0_transpose_item(const float* W, int ldw, int K, int nblk, int Nvalid, const float* gain, bf16* WT, LAS float* scr, int item, int lane) {
    const int kb = item / nblk, nb = item % nblk, k0 = 64 * kb, n0 = 32 * nb;
    const int nn = n0 + (lane & 31); const bool ok = nn < Nvalid;
#pragma unroll 8
    for (int i = 0; i < 32; ++i) { const int kk = 2 * i + (lane >> 5); float v = ok ? W[(size_t)(k0 + kk) * ldw + nn] : 0.f; if (gain) v *= gain[k0 + kk]; scr[kk * 33 + (lane & 31)] = v; }
    LDS_WAIT(); asm volatile("" ::: "memory");
    const int c = lane & 7;
#pragma unroll
    for (int j = 0; j < 4; ++j) { const int n = (lane >> 3) + 8 * j; const LAS float* s = scr + (8 * c) * 33 + n;
        v4u o; o.x = pk2(s[0 * 33], s[1 * 33]); o.y = pk2(s[2 * 33], s[3 * 33]); o.z = pk2(s[4 * 33], s[5 * 33]); o.w = pk2(s[6 * 33], s[7 * 33]);
        *(GAS v4u*)(WT + (size_t)(n0 + n) * K + k0 + 8 * c) = o; }
    LDS_WAIT(); asm volatile("" ::: "memory");
}
__device__ __forceinline__ float p0_row(const float* src, const float* gain, bf16* dst, int lane) {
    f32x4 v[4]; float s = 0.f;
#pragma unroll
    for (int j = 0; j < 4; ++j) { v[j] = src ? *((const GAS f32x4*)src + lane + 64 * j) : (f32x4){0.f, 0.f, 0.f, 0.f}; s += (v[j].x * v[j].x + v[j].y * v[j].y) + (v[j].z * v[j].z + v[j].w * v[j].w); }
    if (gain) {
#pragma unroll
        for (int j = 0; j < 4; ++j) v[j] = v[j] * *((const GAS f32x4*)gain + lane + 64 * j); }
    GAS unsigned long long* o8 = (GAS unsigned long long*)dst + lane;
#pragma unroll
    for (int j = 0; j < 4; ++j) o8[64 * j] = (unsigned long long)pk2(v[j].x, v[j].y) | ((unsigned long long)pk2(v[j].z, v[j].w) << 32);
    return wave_sum(s);
}
__device__ __forceinline__ void p0_quant_row(const float* src, const float* gain, unsigned char* dst, float* scale_out, int bias, int lane, bool part = false, int erow = 0) {
    f32x4 v[4]; float am = 0.f;
#pragma unroll
    for (int j = 0; j < 4; ++j) { v[j] = *((const GAS f32x4*)src + lane * 4 + j); if (gain) v[j] = v[j] * *((const GAS f32x4*)gain + lane * 4 + j);
        am = fmaxf(am, fmaxf(fmaxf(fabsf(v[j].x), fabsf(v[j].y)), fmaxf(fabsf(v[j].z), fabsf(v[j].w)))); }
    am = wave_max_f(am);
    const float sc = am > 0.f ? am * (1.0f / 127.0f) : 1.0f, inv = 1.0f / sc;
    v4u w;
#pragma unroll
    for (int j = 0; j < 4; ++j) { unsigned pk = 0u;
#pragma unroll
        for (int e = 0; e < 4; ++e) { int q = (int)rintf(v[j][e] * inv); q = q > 127 ? 127 : (q < -127 ? -127 : q); pk |= ((unsigned)(q + bias) & 0xffu) << (8 * e); }
        w[j] = pk; }
    if (part) *(GAS v4u*)(dst + (size_t)(lane >> 3) * (16384 * 128) + (size_t)erow * 128 + (lane & 7) * 16) = w;
    else *((GAS v4u*)dst + lane) = w;
    if (lane == 0) *scale_out = sc;
}
struct RowIn { f32x4 v[4]; };
__device__ __forceinline__ void p0_rowq_load(RowIn& R, const float* src, int lane) {
#pragma unroll
    for (int j = 0; j < 4; ++j) R.v[j] = *((const GAS f32x4*)src + lane * 4 + j);
}
__device__ __forceinline__ void p0_rowq_store(const RowIn& R, const float* gain, unsigned char* dst, float* scale_out, int lane, bool part, int erow) {
    f32x4 v[4]; float am = 0.f;
#pragma unroll
    for (int j = 0; j < 4; ++j) { v[j] = R.v[j]; if (gain) v[j] = v[j] * *((const GAS f32x4*)gain + lane * 4 + j);
        am = fmaxf(am, fmaxf(fmaxf(fabsf(v[j].x), fabsf(v[j].y)), fmaxf(fabsf(v[j].z), fabsf(v[j].w)))); }
    am = wave_max_f(am);
    const float sc = am > 0.f ? am * (1.0f / 127.0f) : 1.0f, inv = 1.0f / sc;
    v4u w;
#pragma unroll
    for (int j = 0; j < 4; ++j) { unsigned pk = 0u;
#pragma unroll
        for (int e = 0; e < 4; ++e) { int q = (int)rintf(v[j][e] * inv); q = q > 127 ? 127 : (q < -127 ? -127 : q); pk |= ((unsigned)q & 0xffu) << (8 * e); }
        w[j] = pk; }
    if (part) *(GAS v4u*)(dst + (size_t)(lane >> 3) * (16384 * 128) + (size_t)erow * 128 + (lane & 7) * 16) = w;
    else *((GAS v4u*)dst + lane) = w;
    if (lane == 0) *scale_out = sc;
}
__device__ __forceinline__ void p0_rowx_load(RowIn& R, const float* src, int lane) {
#pragma unroll
    for (int j = 0; j < 4; ++j) R.v[j] = src ? *((const GAS f32x4*)src + lane + 64 * j) : (f32x4){0.f, 0.f, 0.f, 0.f};
}
__device__ __forceinline__ float p0_rowx_store(const RowIn& R, bf16* dst, int lane) {
    float s = 0.f;
#pragma unroll
    for (int j = 0; j < 4; ++j) s += (R.v[j].x * R.v[j].x + R.v[j].y * R.v[j].y) + (R.v[j].z * R.v[j].z + R.v[j].w * R.v[j].w);
    GAS unsigned long long* o8 = (GAS unsigned long long*)dst + lane;
#pragma unroll
    for (int j = 0; j < 4; ++j) o8[64 * j] = (unsigned long long)pk2(R.v[j].x, R.v[j].y) | ((unsigned long long)pk2(R.v[j].z, R.v[j].w) << 32);
    return wave_sum(s);
}
__device__ __forceinline__ void p0_wp_item(const float* wq, const float* subk, const float* gain, bf16* WT, int col0, int j0, LAS float* scr, int lane) {
#pragma unroll 4
    for (int i = 0; i < 32; ++i) { const int idx = i * 64 + lane, jj = idx >> 7, d = idx & 127; scr[d * 16 + jj] = wq[(size_t)(j0 + jj) * 2048 + col0 + d] * gain[j0 + jj]; }
    LDS_WAIT(); asm volatile("" ::: "memory");
    float a0[16], a1[16];
#pragma unroll
    for (int i = 0; i < 16; ++i) { a0[i] = 0.f; a1[i] = 0.f; }
    const float* r0 = subk + (size_t)lane * 128; const float* r1 = subk + (size_t)(lane + 64) * 128;
#pragma unroll 1
    for (int d8 = 0; d8 < 4; ++d8) {
      f32x4 xs[8], ys[8];
#pragma unroll
      for (int u = 0; u < 8; ++u) { xs[u] = *(const GAS f32x4*)(r0 + (d8 * 8 + u) * 4); ys[u] = *(const GAS f32x4*)(r1 + (d8 * 8 + u) * 4); }
#pragma unroll
      for (int u = 0; u < 8; ++u) { const int d4 = d8 * 8 + u;
        const f32x4 x = xs[u], y = ys[u];
#pragma unroll
        for (int dd = 0; dd < 4; ++dd) { const LAS f32x4* wv = (const LAS f32x4*)(scr + (d4 * 4 + dd) * 16);
#pragma unroll
            for (int q = 0; q < 4; ++q) { const f32x4 w = wv[q];
#pragma unroll
                for (int e = 0; e < 4; ++e) { a0[q * 4 + e] += x[dd] * w[e]; a1[q * 4 + e] += y[dd] * w[e]; } } }
      }
    }
    { v4u o0, o1; o0.x = pk2(a0[0], a0[1]); o0.y = pk2(a0[2], a0[3]); o0.z = pk2(a0[4], a0[5]); o0.w = pk2(a0[6], a0[7]); o1.x = pk2(a0[8], a0[9]); o1.y = pk2(a0[10], a0[11]); o1.z = pk2(a0[12], a0[13]); o1.w = pk2(a0[14], a0[15]);
      GAS v4u* p = (GAS v4u*)(WT + (size_t)(col0 + lane) * 1024 + j0); p[0] = o0; p[1] = o1; }
    { v4u o0, o1; o0.x = pk2(a1[0], a1[1]); o0.y = pk2(a1[2], a1[3]); o0.z = pk2(a1[4], a1[5]); o0.w = pk2(a1[6], a1[7]); o1.x = pk2(a1[8], a1[9]); o1.y = pk2(a1[10], a1[11]); o1.z = pk2(a1[12], a1[13]); o1.w = pk2(a1[14], a1[15]);
      GAS v4u* p = (GAS v4u*)(WT + (size_t)(col0 + lane + 64) * 1024 + j0); p[0] = o0; p[1] = o1; }
    LDS_WAIT(); asm volatile("" ::: "memory");
}

#define ROWMAX16(m) do { m = max(m, (unsigned)__builtin_amdgcn_update_dpp(0, (int)m, 0x121, 0xf, 0xf, false)); m = max(m, (unsigned)__builtin_amdgcn_update_dpp(0, (int)m, 0x122, 0xf, 0xf, false)); \
    m = max(m, (unsigned)__builtin_amdgcn_update_dpp(0, (int)m, 0x124, 0xf, 0xf, false)); m = max(m, (unsigned)__builtin_amdgcn_update_dpp(0, (int)m, 0x128, 0xf, 0xf, false)); } while (0)
#define ROWSUM16F(s) do { s += __int_as_float(__builtin_amdgcn_update_dpp(0, __float_as_int(s), 0x121, 0xf, 0xf, false)); s += __int_as_float(__builtin_amdgcn_update_dpp(0, __float_as_int(s), 0x122, 0xf, 0xf, false)); \
    s += __int_as_float(__builtin_amdgcn_update_dpp(0, __float_as_int(s), 0x124, 0xf, 0xf, false)); s += __int_as_float(__builtin_amdgcn_update_dpp(0, __float_as_int(s), 0x128, 0xf, 0xf, false)); } while (0)
__device__ __forceinline__ unsigned top16_of_128(unsigned (&x)[8], int sub) {
#define CE(i, j) do { const unsigned hi_ = max(x[i], x[j]), lo_ = min(x[i], x[j]); x[i] = hi_; x[j] = lo_; } while (0)
    CE(0, 1); CE(2, 3); CE(4, 5); CE(6, 7);
    CE(0, 2); CE(1, 3); CE(4, 6); CE(5, 7);
    CE(1, 2); CE(5, 6); CE(0, 4); CE(3, 7);
    CE(1, 5); CE(2, 6);
    CE(1, 4); CE(3, 6);
    CE(2, 4); CE(3, 5);
    CE(3, 4);
#undef CE
    unsigned res = 0u;
#pragma unroll
    for (int r = 0; r < 16; ++r) {
        unsigned m = x[0];
        ROWMAX16(m);
        res = (sub == r) ? m : res;
        const bool win = (x[0] == m);
#pragma unroll
        for (int i = 0; i < 7; ++i) x[i] = win ? x[i + 1] : x[i];
        x[7] = win ? 0u : x[7];
    }
    return res;
}
struct RouteIn { f32x4 a, b, c, d; };
__device__ __forceinline__ void peer_route_load(RouteIn& R, const unsigned short* S, int task, int lane) {
    const int sub = lane & 15, grp = lane >> 4, p = task * 4 + grp, tok = p >> 3, h = p & 7;
    const unsigned short* sp = S + (size_t)tok * 2048 + h * 256 + sub * 8;
    typedef _Float16 h8 __attribute__((ext_vector_type(8)));
    const h8 x = *(const GAS h8*)sp, y = *(const GAS h8*)(sp + 128);
    R.a = (f32x4){(float)x[0], (float)x[1], (float)x[2], (float)x[3]}; R.b = (f32x4){(float)x[4], (float)x[5], (float)x[6], (float)x[7]};
    R.c = (f32x4){(float)y[0], (float)y[1], (float)y[2], (float)y[3]}; R.d = (f32x4){(float)y[4], (float)y[5], (float)y[6], (float)y[7]};
}
__device__ __forceinline__ void peer_route_core(const RouteIn& R, unsigned* EIDX, float* GATE, int tok, int h, int lane) {
    const int sub = lane & 15;
    unsigned x1[8], x2[8];
    { const f32x4 a = R.a, b = R.b, c = R.c, d = R.d;
#pragma unroll
      for (int i = 0; i < 4; ++i) { x1[i] = (f2key(a[i]) & ~127u) | (unsigned)(127 - (sub * 8 + i)); x1[4 + i] = (f2key(b[i]) & ~127u) | (unsigned)(127 - (sub * 8 + 4 + i));
                                    x2[i] = (f2key(c[i]) & ~127u) | (unsigned)(127 - (sub * 8 + i)); x2[4 + i] = (f2key(d[i]) & ~127u) | (unsigned)(127 - (sub * 8 + 4 + i)); } }
    const unsigned r1 = top16_of_128(x1, sub), r2 = top16_of_128(x2, sub);
    const float v1 = key2f(r1 & ~127u), v2 = key2f(r2 & ~127u); const int i1 = 127 - (int)(r1 & 127u), i2 = 127 - (int)(r2 & 127u);
    unsigned c[8];
    const int La = (sub == 0 || sub == 1) ? 8 : (sub == 2 ? 5 : (sub == 3 ? 4 : (sub == 4 ? 3 : (sub < 8 ? 2 : 1))));
#pragma unroll
    for (int j = 0; j < 8; ++j) { const float vj = __shfl(v2, (lane & 48) | j); c[j] = (j < La) ? ((f2key(v1 + vj) & ~255u) | (unsigned)((15 - sub) << 4) | (unsigned)(15 - j)) : 0u; }
    { const float v10 = __shfl(v1, lane & 48); if (sub >= 8) { const unsigned extra = (f2key(v10 + v2) & ~255u) | (unsigned)(15 << 4) | (unsigned)(15 - sub);
          const unsigned hi_ = max(c[0], extra), lo_ = min(c[0], extra); c[0] = hi_; c[1] = lo_; } }
    unsigned res = 0u;
#pragma unroll
    for (int r = 0; r < 16; ++r) {
        unsigned m = c[0]; ROWMAX16(m);
        res = (sub == r) ? m : res;
        const bool win = (c[0] == m);
#pragma unroll
        for (int j = 0; j < 7; ++j) c[j] = win ? c[j + 1] : c[j];
        c[7] = win ? 0u : c[7];
    }
    const float ts = key2f(res & ~255u); const int a = 15 - (int)((res >> 4) & 15u), b = 15 - (int)(res & 15u);
    const int ia = __shfl(i1, (lane & 48) | a), ib = __shfl(i2, (lane & 48) | b);
    unsigned mk = f2key(ts); ROWMAX16(mk); const float mx = key2f(mk);
    const float e = fast_exp2((ts - mx) * 1.4426950408889634f); float sum = e; ROWSUM16F(sum);
    { const int j = h * 16 + sub, pos = (j & 64) + (j & 7) * 8 + ((j >> 3) & 7);
      if (tok < NT) { EIDX[(size_t)tok * 128 + pos] = (unsigned)(ia * 128 + ib); GATE[(size_t)tok * 128 + pos] = e / sum; } }
}

__device__ __forceinline__ void peer_route_task(const RouteIn& R, unsigned* EIDX, float* GATE, int task, int lane) { const int p = task * 4 + (lane >> 4); peer_route_core(R, EIDX, GATE, p >> 3, p & 7, lane); }
struct OneUnit : pg8::StaticOrder { int k;
    __device__ __forceinline__ bool next(int i, pg8::Unit& u) const { return i == 0 && pg8::StaticOrder::next(k, u); } };
struct EpiRoute { static constexpr bool PERM = true, AFTER_DRAIN = true;
    const unsigned long long* ss; unsigned* EIDX; float* GATE;
    __device__ __forceinline__ void fused(f32x4 (&acc)[2][2][4][2], const pg8::Unit& u, int wr, int wc, int fr, int fq, LAS unsigned char* tile, int wid, int lane) const {
#pragma unroll
        for (int ai = 0; ai < 2; ++ai)
#pragma unroll
            for (int m = 0; m < 4; ++m) { const int row = ai * 128 + wr * 64 + m * 16 + fr; const float rs = rsqrtf(pg8::ss_get(ss + u.pm * 256 + row) * (1.0f / 1024.0f) + EPS);
#pragma unroll
                for (int bj = 0; bj < 2; ++bj) { const f32x4 v0 = acc[ai][bj][m][0] * rs, v1 = acc[ai][bj][m][1] * rs; v4u w;
                    w.x = pg8::EpiScaleF16::pkh(v0[0], v0[1]); w.y = pg8::EpiScaleF16::pkh(v0[2], v0[3]); w.z = pg8::EpiScaleF16::pkh(v1[0], v1[1]); w.w = pg8::EpiScaleF16::pkh(v1[2], v1[3]);
                    const int ci = bj * 16 + wc * 4 + fq; *(LAS v4u*)(tile + row * 512 + ((ci ^ (row & 7)) * 16)) = w; } }
        asm volatile("s_waitcnt lgkmcnt(0)" ::: "memory"); __builtin_amdgcn_s_barrier(); asm volatile("" ::: "memory");
        const int sub = lane & 15, grp = lane >> 4;
#pragma unroll 1
        for (int tk = wid; tk < 64; tk += 8) { const int row = tk * 4 + grp; const LAS unsigned char* rp = tile + row * 512; const int sw = sub ^ (row & 7);
            typedef _Float16 h8 __attribute__((ext_vector_type(8)));
            const h8 x = *(const LAS h8*)(rp + sw * 16), y = *(const LAS h8*)(rp + 256 + sw * 16);
            RouteIn R; R.a = (f32x4){(float)x[0], (float)x[1], (float)x[2], (float)x[3]}; R.b = (f32x4){(float)x[4], (float)x[5], (float)x[6], (float)x[7]};
            R.c = (f32x4){(float)y[0], (float)y[1], (float)y[2], (float)y[3]}; R.d = (f32x4){(float)y[4], (float)y[5], (float)y[6], (float)y[7]};
            peer_route_core(R, EIDX, GATE, u.pm * 256 + row, u.pn, lane); }
        asm volatile("s_waitcnt lgkmcnt(0)" ::: "memory"); __builtin_amdgcn_s_barrier(); asm volatile("" ::: "memory");
    }
};
struct XqIn { f32x4 xv[4]; float ss; };
__device__ __forceinline__ void peer_xq_load(XqIn& R, const bf16* X, const unsigned long long* ss, int tok, int lane) {
    const v4u a = *(const GAS v4u*)(X + (size_t)tok * 1024 + lane * 16), b = *(const GAS v4u*)(X + (size_t)tok * 1024 + lane * 16 + 8);
    R.xv[0] = (f32x4){bflo(a.x), bfhi(a.x), bflo(a.y), bfhi(a.y)}; R.xv[1] = (f32x4){bflo(a.z), bfhi(a.z), bflo(a.w), bfhi(a.w)};
    R.xv[2] = (f32x4){bflo(b.x), bfhi(b.x), bflo(b.y), bfhi(b.y)}; R.xv[3] = (f32x4){bflo(b.z), bfhi(b.z), bflo(b.w), bfhi(b.w)};
    R.ss = pg8::ss_get(ss + tok);
}
__device__ __forceinline__ void peer_xq_token(const XqIn& R, unsigned char* XQ, float* RSX, int tok, int lane) {
    float am = 0.f;
#pragma unroll
    for (int j = 0; j < 4; ++j) am = fmaxf(am, fmaxf(fmaxf(fabsf(R.xv[j].x), fabsf(R.xv[j].y)), fmaxf(fabsf(R.xv[j].z), fabsf(R.xv[j].w))));
    am = wave_max_f(am);
    const float sx = am > 0.f ? am * (1.0f / 127.0f) : 1.0f, isx = 1.0f / sx;
    v4u w;
#pragma unroll
    for (int j = 0; j < 4; ++j) { unsigned pk = 0u;
#pragma unroll
        for (int e = 0; e < 4; ++e) { const int q = (int)rintf(R.xv[j][e] * isx); pk |= ((unsigned)q & 0xffu) << (8 * e); }
        w[j] = pk; }
    *((GAS v4u*)(XQ + (size_t)tok * 1024) + lane) = w;
    if (lane == 0) RSX[tok] = rsqrtf(R.ss * (1.0f / 1024.0f) + EPS) * sx;
}
struct E1Set { v4u uu[8]; v4u xw; float rs, su, sv, gt; int tokj; };
__device__ __forceinline__ void e1_load(E1Set& S, const LAS unsigned* wl, int b, int ts, const unsigned char* XQ, const float* RSX, const float* GATE, const unsigned char* U8, const float* SU, const float* SV, int lane) {
    const unsigned d = (unsigned)__builtin_amdgcn_readfirstlane((int)wl[2048 + b]); const int start = (int)(d & 0xffffu), n = (int)((d >> 16) & 0xffu), tok = ts + (int)(d >> 24), grp = (lane >> 3) & 7;
    const unsigned ev8 = wl[start + ((lane & 7) < n ? (lane & 7) : n - 1)];
#pragma unroll
    for (int i = 0; i < 8; ++i) { const unsigned e = (unsigned)__builtin_amdgcn_readlane((int)ev8, i); S.uu[i] = *((const GAS v4u*)(U8 + (size_t)e * 1024) + lane); }
    S.xw = *((const GAS v4u*)(XQ + (size_t)tok * 1024) + lane); S.rs = RSX[tok];
    { const int gi = grp < n ? grp : n - 1; const unsigned ek = wl[start + gi], jk = wl[1024 + start + gi] & 0xffu; S.tokj = grp < n ? tok * 128 + (int)jk : -1; S.su = SU[ek]; S.sv = SV[ek]; S.gt = GATE[(size_t)tok * 128 + jk]; }
}
__device__ __forceinline__ void e1_compute(const E1Set& S, float* ACT, int lane) {
    const int b5 = (lane >> 5) & 1, b4 = (lane >> 4) & 1, b3 = (lane >> 3) & 1; int p[8];
#pragma unroll
    for (int i = 0; i < 8; ++i) { int d = __builtin_amdgcn_sdot4((int)S.uu[i].x, (int)S.xw.x, 0, false); d = __builtin_amdgcn_sdot4((int)S.uu[i].y, (int)S.xw.y, d, false);
        d = __builtin_amdgcn_sdot4((int)S.uu[i].z, (int)S.xw.z, d, false); d = __builtin_amdgcn_sdot4((int)S.uu[i].w, (int)S.xw.w, d, false); p[i] = d; }
    const int r0 = xadd32i(p[0], p[4]), r1 = xadd32i(p[1], p[5]), r2 = xadd32i(p[2], p[6]), r3 = xadd32i(p[3], p[7]);
    const int q0 = xadd16i(r0, r2), q1 = xadd16i(r1, r3);
    int t = (b3 ? q1 : q0) + ror8i(b3 ? q0 : q1);
    t = sum8i(t); (void)b5; (void)b4;
    if (S.tokj >= 0 && (lane & 7) == 0) ACT[S.tokj] = S.gt * gelu_tanh(S.rs * S.su * (float)t) * S.sv;
}
__device__ __forceinline__ void peer_e1_chunk(const unsigned char* XQ, const float* RSX, const unsigned* EIDX, const float* GATE, const unsigned char* U8, const float* SU, const float* SV,
                                              float* ACT, LAS unsigned* wl, int t0, int t1, int pi, int lane) {
    const unsigned long long lt = lanemask_lt(lane);
#pragma unroll 1
    for (int ts = t0; ts < t1; ts += 8) {
        const int nt = (t1 - ts) < 8 ? (t1 - ts) : 8;
        unsigned ee[8][2];
#pragma unroll
        for (int tl = 0; tl < 8; ++tl) { ee[tl][0] = 0xffffffffu; ee[tl][1] = 0xffffffffu; if (tl < nt) { ee[tl][0] = EIDX[(size_t)(ts + tl) * 128 + lane]; ee[tl][1] = EIDX[(size_t)(ts + tl) * 128 + 64 + lane]; } }
        int nent = 0, nbat = 0;
#pragma unroll
        for (int tl = 0; tl < 8; ++tl) {
            const bool s0 = (int)(ee[tl][0] >> 11) == pi, s1 = (int)(ee[tl][1] >> 11) == pi;
            const unsigned long long m0 = __ballot(s0), m1 = __ballot(s1);
            const int c0 = __builtin_popcountll(m0), c = c0 + __builtin_popcountll(m1);
            if (s0) { const int p = nent + __builtin_popcountll(m0 & lt); wl[p] = ee[tl][0]; wl[1024 + p] = (unsigned)lane; }
            if (s1) { const int p = nent + c0 + __builtin_popcountll(m1 & lt); wl[p] = ee[tl][1]; wl[1024 + p] = (unsigned)(64 + lane); }
            const int nb = (c + 7) >> 3;
            if (lane < nb) { const int rem = c - 8 * lane; wl[2048 + nbat + lane] = (unsigned)(nent + 8 * lane) | ((unsigned)(rem < 8 ? rem : 8) << 16) | ((unsigned)tl << 24); }
            nent += c; nbat += nb;
        }
        LDS_WAIT(); asm volatile("" ::: "memory");
        if (nbat > 0) {
            E1Set A, B;
            e1_load(A, wl, 0, ts, XQ, RSX, GATE, U8, SU, SV, lane);
#pragma unroll 1
            for (int b = 0; b < nbat; b += 2) {
                if (b + 1 < nbat) e1_load(B, wl, b + 1, ts, XQ, RSX, GATE, U8, SU, SV, lane);
                e1_compute(A, ACT, lane);
                if (b + 1 >= nbat) break;
                if (b + 2 < nbat) e1_load(A, wl, b + 2, ts, XQ, RSX, GATE, U8, SU, SV, lane);
                e1_compute(B, ACT, lane);
            }
        }
        LDS_WAIT(); asm volatile("" ::: "memory");
    }
}
__device__ __forceinline__ void e2_accum4(const v4u& d0v, const v4u& d1v, const v4u& d2v, const v4u& d3v, int W4, int (&y)[16]) {
#pragma unroll
    for (int k = 0; k < 4; ++k) { const unsigned d0 = d0v[k], d1 = d1v[k], d2 = d2v[k], d3 = d3v[k];
        const unsigned p01l = __builtin_amdgcn_perm(d1, d0, 0x05010400u), p01h = __builtin_amdgcn_perm(d1, d0, 0x07030602u);
        const unsigned p23l = __builtin_amdgcn_perm(d3, d2, 0x05010400u), p23h = __builtin_amdgcn_perm(d3, d2, 0x07030602u);
        y[4 * k + 0] = __builtin_amdgcn_sdot4((int)__builtin_amdgcn_perm(p23l, p01l, 0x05040100u), W4, y[4 * k + 0], false);
        y[4 * k + 1] = __builtin_amdgcn_sdot4((int)__builtin_amdgcn_perm(p23l, p01l, 0x07060302u), W4, y[4 * k + 1], false);
        y[4 * k + 2] = __builtin_amdgcn_sdot4((int)__builtin_amdgcn_perm(p23h, p01h, 0x05040100u), W4, y[4 * k + 2], false);
        y[4 * k + 3] = __builtin_amdgcn_sdot4((int)__builtin_amdgcn_perm(p23h, p01h, 0x07060302u), W4, y[4 * k + 3], false); }
}
struct E2Meta { f32x4 a[4]; unsigned x; };
template <bool HAS_B> __device__ __forceinline__ void e2_finish(const v4u (&V)[16], const E2Meta& M, float* Xo, bf16* Xob, float* sso, int tok, int pi, int col, int lane) {
    const int b3 = (lane >> 3) & 1;
    int y[16];
#pragma unroll
    for (int i = 0; i < 16; ++i) y[i] = 0;
    float am = 0.f;
#pragma unroll
    for (int i = 0; i < 4; ++i) am = fmaxf(am, fmaxf(fmaxf(fabsf(M.a[i].x), fabsf(M.a[i].y)), fmaxf(fabsf(M.a[i].z), fabsf(M.a[i].w))));
    am = wave_max_f(am);
    const float sw = am > 0.f ? am * (1.0f / 127.0f) : 1.0f, isw = 1.0f / sw;
#pragma unroll
    for (int g4 = 0; g4 < 4; ++g4) { const f32x4 a = M.a[g4];
        const int W4 = (int)(((unsigned)(int)rintf(a.x * isw) & 0xffu) | (((unsigned)(int)rintf(a.y * isw) & 0xffu) << 8) | (((unsigned)(int)rintf(a.z * isw) & 0xffu) << 16) | ((unsigned)(int)rintf(a.w * isw) << 24));
        e2_accum4(V[4 * g4], V[4 * g4 + 1], V[4 * g4 + 2], V[4 * g4 + 3], W4, y); }
    int z8[8];
#pragma unroll
    for (int i = 0; i < 8; ++i) z8[i] = (b3 ? y[8 + i] : y[i]) + ror8i(b3 ? y[i] : y[8 + i]);
    int z4[4];
#pragma unroll
    for (int i = 0; i < 4; ++i) z4[i] = xadd16i(z8[i], z8[4 + i]);
    int z2[2];
#pragma unroll
    for (int i = 0; i < 2; ++i) z2[i] = xadd32i(z4[i], z4[2 + i]);
    const float o0 = bflo(M.x) + sw * (float)z2[0], o1 = bfhi(M.x) + sw * (float)z2[1];
    if constexpr (!HAS_B) *(GAS f32x2*)(Xo + (size_t)tok * 1024 + col) = (f32x2){o0, o1};
    if constexpr (HAS_B) { *(GAS unsigned*)(Xob + (size_t)tok * 1024 + col) = pk2(o0, o1);
        float sq = o0 * o0 + o1 * o1; ROWSUM16F(sq);
        const float tot = (__int_as_float(__builtin_amdgcn_readlane(__float_as_int(sq), 0)) + __int_as_float(__builtin_amdgcn_readlane(__float_as_int(sq), 16))) + (__int_as_float(__builtin_amdgcn_readlane(__float_as_int(sq), 32)) + __int_as_float(__builtin_amdgcn_readlane(__float_as_int(sq), 48)));
        if (lane == 0) sso[(size_t)pi * MP + tok] = tot; }
}
template <bool HAS_B> __device__ __forceinline__ void peer_e2_chunk(const bf16* X, const unsigned* EIDX, const float* ACT, const unsigned char* V8, float* Xo, bf16* Xob, float* sso, int t0, int t1, int pi, int lane) {
    const int grp = lane >> 3, l8 = lane & 7, b3 = (lane >> 3) & 1, b4 = (lane >> 4) & 1, b5 = (lane >> 5) & 1;
    const int col = pi * 128 + l8 * 16 + b3 * 8 + b4 * 4 + b5 * 2;
    const unsigned char* vb = V8 + (size_t)pi * (16384 * 128) + l8 * 16;
    v4u vA[16], vB[16]; E2Meta mA, mB; v4u eN[4];
#define E2_LOADE(T) do { const GAS v4u* ep = (const GAS v4u*)(EIDX + (size_t)(T) * 128 + grp * 8); eN[0] = ep[0]; eN[1] = ep[1]; eN[2] = ep[16]; eN[3] = ep[17]; } while (0)
#define E2_META(T, M) do { const GAS f32x4* apn = (const GAS f32x4*)(ACT + (size_t)(T) * 128 + grp * 8); M.a[0] = apn[0]; M.a[1] = apn[1]; M.a[2] = apn[16]; M.a[3] = apn[17]; \
        M.x = *(const GAS unsigned*)(X + (size_t)(T) * 1024 + col); } while (0)
#define E2_GATHER16(V) do { _Pragma("unroll") for (int g4 = 0; g4 < 4; ++g4) { _Pragma("unroll") for (int k = 0; k < 4; ++k) V[4 * g4 + k] = *(const GAS v4u*)(vb + (size_t)eN[g4][k] * 128); } } while (0)
    E2_LOADE(t0); E2_META(t0, mA);
    E2_GATHER16(vA);
    if (t0 + 1 < t1) E2_LOADE(t0 + 1);
#pragma unroll 1
    for (int tok = t0; tok < t1; tok += 2) {
        if (tok + 1 < t1) { E2_GATHER16(vB); E2_META(tok + 1, mB); if (tok + 2 < t1) E2_LOADE(tok + 2); }
        e2_finish<HAS_B>(vA, mA, Xo, Xob, sso, tok, pi, col, lane);
        if (tok + 1 >= t1) break;
        if (tok + 2 < t1) { E2_GATHER16(vA); E2_META(tok + 2, mA); if (tok + 3 < t1) E2_LOADE(tok + 3); }
        e2_finish<HAS_B>(vB, mB, Xo, Xob, sso, tok + 1, pi, col, lane);
    }
#undef E2_GATHER16
#undef E2_META
#undef E2_LOADE
}
#define PEER_QLOOP_CHUNK(QBASE, BODY) do { const int home_ = (int)(xb_xcc_id() & 7u); \
    for (int k_ = 0; k_ < 8; ++k_) { const int pi = (home_ + k_) & 7; unsigned* qh_ = (QBASE) + pi * 64; \
        for (;;) { unsigned c_ = 0u; if (lane == 0) c_ = __hip_atomic_fetch_add(qh_, 16u, __ATOMIC_RELAXED, __HIP_MEMORY_SCOPE_AGENT); c_ = (unsigned)__builtin_amdgcn_readfirstlane((int)c_); \
            if (c_ >= (unsigned)NT) break; const int t0 = (int)c_, t1 = (int)c_ + 16 < NT ? (int)c_ + 16 : NT; BODY; } } } while (0)
__device__ __forceinline__ float wave_sum_dpp(float v) {
    ROWSUM16F(v);
    return (__int_as_float(__builtin_amdgcn_readlane(__float_as_int(v), 0)) + __int_as_float(__builtin_amdgcn_readlane(__float_as_int(v), 16))) + (__int_as_float(__builtin_amdgcn_readlane(__float_as_int(v), 32)) + __int_as_float(__builtin_amdgcn_readlane(__float_as_int(v), 48)));
}
struct PostRow { float x[33]; float wi; };
__device__ __forceinline__ void att_post_load(PostRow& R, const bf16* P, int row, int lane) {
    const bf16* p = P + (size_t)row * APAD;
#pragma unroll
    for (int i = 0; i < 33; ++i) R.x[i] = bflo((unsigned)p[i * 64 + lane]);
    R.wi = (lane < 8) ? bflo((unsigned)p[2112 + lane]) : 0.f;
}
__device__ __forceinline__ void att_post_compute(const PostRow& R, float gq, float gk, float gik, const float* tab,
                                                 bf16* QB, bf16* KB, bf16* V2B, bf16* QIB, bf16* KIB, float* WI, float* out, int row, int lane) {
    const float* tb = tab + (size_t)(row < NP ? (row & 4095) : 4096) * 64;
    const float cs = tb[lane & 31], sn0 = tb[32 + (lane & 31)], sn = (lane < 32) ? -sn0 : sn0;
    float* okp = (row < NP) ? out + O_KP + (size_t)row * 256 : out + O_KS + (size_t)(row - NP) * 256;
    float* ovp = (row < NP) ? out + O_VP + (size_t)row * 256 : out + O_VS + (size_t)(row - NP) * 256;
    float* oip = (row < NP) ? out + O_IP + (size_t)row * 64 : out + O_IS + (size_t)(row - NP) * 64;
#pragma unroll
    for (int i = 0; i < 33; ++i) {
        float x = R.x[i];
        if (i >= 20 && i < 24) { V2B[(size_t)row * 256 + (i - 20) * 64 + lane] = (bf16)f2bf(x); ovp[(i - 20) * 64 + lane] = x; continue; }
        const float g = (i < 16) ? gq : ((i < 20) ? gk : gik);
        if (i < 20 || i == 32) { const float ss = wave_sum_dpp(x * x); x = x * rsqrtf(ss * (1.0f / 64.0f) + EPS) * g; }
        const auto sw_ = __builtin_amdgcn_permlane32_swap(__float_as_uint(x), __float_as_uint(x), false, false);
        const float other = __uint_as_float(lane < 32 ? sw_[1] : sw_[0]);
        const float y = x * cs + other * sn;
        if (i < 16) QB[(size_t)row * 1024 + i * 64 + lane] = (bf16)f2bf(y * QSCALE);
        else if (i < 20) { KB[(size_t)row * 256 + (i - 16) * 64 + lane] = (bf16)f2bf(y); okp[(i - 16) * 64 + lane] = y; }
        else if (i < 32) QIB[(size_t)row * 512 + (i - 24) * 64 + lane] = (bf16)f2bf(y);
        else { KIB[(size_t)row * 64 + lane] = (bf16)f2bf(y); oip[lane] = y; }
    }
    if (lane < 8) WI[(size_t)row * 8 + lane] = R.wi * IDX_SCALE;
}

__device__ __forceinline__ void idx_scores_task(const bf16* QIB, const bf16* KIB, const float* WI, unsigned short* SC, int b, int qb, int kb_lo, int kb_hi, int lane) {
    const int l16 = lane & 15, q4 = lane >> 4; const size_t qrow = (size_t)b * SEQ + qb * 16 + l16;
    bf16x8 qf[8][2]; float wi[8];
#pragma unroll
    for (int h = 0; h < 8; ++h) { wi[h] = WI[qrow * 8 + h];
#pragma unroll
        for (int kk = 0; kk < 2; ++kk) qf[h][kk] = *(const GAS bf16x8*)(QIB + qrow * 512 + h * 64 + kk * 32 + q4 * 8); }
    const bf16* kbase = KIB + ((size_t)b * SEQ + l16) * 64 + q4 * 8;
    bf16x8 kr0[4], kr1[4];
#pragma unroll
    for (int j = 0; j < 4; ++j) { const int kb = (kb_lo + j < kb_hi) ? kb_lo + j : kb_lo; kr0[j] = *(const GAS bf16x8*)(kbase + (size_t)kb * 1024); kr1[j] = *(const GAS bf16x8*)(kbase + (size_t)kb * 1024 + 32); }
#pragma unroll 1
    for (int kb0 = kb_lo; kb0 < kb_hi; kb0 += 4) {
#pragma unroll
        for (int j = 0; j < 4; ++j) { const int kb = kb0 + j;
            const bf16x8 k0 = kr0[j], k1 = kr1[j];
            { const int kn = (kb + 4 < kb_hi) ? kb + 4 : kb_lo; kr0[j] = *(const GAS bf16x8*)(kbase + (size_t)kn * 1024); kr1[j] = *(const GAS bf16x8*)(kbase + (size_t)kn * 1024 + 32); }
            {
                f32x4 sc = {0.f, 0.f, 0.f, 0.f};
#pragma unroll
                for (int h = 0; h < 8; ++h) { f32x4 a = {0.f, 0.f, 0.f, 0.f};
                    a = __builtin_amdgcn_mfma_f32_16x16x32_bf16(k0, qf[h][0], a, 0, 0, 0);
                    a = __builtin_amdgcn_mfma_f32_16x16x32_bf16(k1, qf[h][1], a, 0, 0, 0);
#pragma unroll
                    for (int i = 0; i < 4; ++i) sc[i] += wi[h] * fmaxf(a[i], 0.f); }
                if (kb < kb_hi) { v2u w; w.x = pg8::EpiScaleF16::pkh(sc[0], sc[1]); w.y = pg8::EpiScaleF16::pkh(sc[2], sc[3]); *(GAS v2u*)(SC + qrow * 4096 + kb * 16 + 4 * q4) = w; } }
        }
    }
}

__device__ __forceinline__ void select_load(unsigned (&raw)[64], const unsigned short* SC, int row, int lane) {
    const int t = row & 4095, n = t + 1; if (n <= 256) return;
    const unsigned short* sc = SC + (size_t)row * 4096; const int nj = (n + 63) >> 6;
#pragma unroll
    for (int j = 0; j < 64; ++j) if (j < nj) raw[j] = (unsigned)sc[j * 64 + lane];
}
__device__ __forceinline__ void select_keys(unsigned (&x)[64], const unsigned (&raw)[64], int row, int lane) {
    const int t = row & 4095, n = t + 1; if (n <= 256) return; const int nj = (n + 63) >> 6;
#pragma unroll
    for (int j = 0; j < 64; ++j) { x[j] = 0u; if (j < nj) { const int s = j * 64 + lane; const unsigned h = raw[j];
            if (s < n) x[j] = ((h & 0x8000u) ? (~h & 0xffffu) : (h | 0x8000u)) + ((h & 0x7fffu) == 0u && (h & 0x8000u) ? 1u : 0u); } }
}
__device__ __forceinline__ void select_run(const unsigned (&x)[64], unsigned long long* BM, int row, int lane) {
    const int t = row & 4095, n = t + 1; unsigned long long* bm = BM + (size_t)row * 64;
    if (n <= 256) { const int lo = lane * 64; unsigned long long w = 0ull; if (lo + 63 <= t) w = ~0ull; else if (lo <= t) w = (2ull << (t - lo)) - 1ull; bm[lane] = w; return; }
    const int nj = (n + 63) >> 6;
    unsigned T = 0u; const int ngrp = (nj + 15) >> 4;
#pragma unroll 1
    for (int bit = 15; bit >= 0; --bit) { const unsigned c = T | (1u << bit); unsigned cv = 0u;
#pragma unroll
        for (int g = 0; g < 4; ++g) if (g < ngrp) {
#pragma unroll
            for (int j = g * 16; j < g * 16 + 16; ++j) asm("v_cmp_ge_u32 vcc, %1, %2\n\tv_addc_co_u32 %0, vcc, 0, %0, vcc" : "+v"(cv) : "v"(x[j]), "v"(c) : "vcc"); }
        asm volatile("s_nop 1" : "+v"(cv));
        int ci = (int)cv;
        ci += __builtin_amdgcn_update_dpp(0, ci, 0x121, 0xf, 0xf, false); ci += __builtin_amdgcn_update_dpp(0, ci, 0x122, 0xf, 0xf, false);
        ci += __builtin_amdgcn_update_dpp(0, ci, 0x124, 0xf, 0xf, false); ci += __builtin_amdgcn_update_dpp(0, ci, 0x128, 0xf, 0xf, false);
        const int cnt = __builtin_amdgcn_readlane(ci, 0) + __builtin_amdgcn_readlane(ci, 16) + __builtin_amdgcn_readlane(ci, 32) + __builtin_amdgcn_readlane(ci, 48);
        if (cnt >= 256) T = c; }
    int cgt = 0;
#pragma unroll
    for (int j = 0; j < 64; ++j) if (j < nj) cgt += __builtin_popcountll(__ballot(x[j] > T));
    const int need = 256 - cgt; int eqb = 0; const unsigned long long lt = lanemask_lt(lane); unsigned long long myw = 0ull;
#pragma unroll
    for (int j = 0; j < 64; ++j) if (j < nj) {
        const bool eq = (x[j] == T); const unsigned long long meq = __ballot(eq);
        const bool sl = (x[j] > T) || (eq && (eqb + __builtin_popcountll(meq & lt)) < need);
        const unsigned long long m = __ballot(sl);
        if (lane == j) myw = m;
        eqb += __builtin_popcountll(meq); }
    bm[lane] = myw;
}

constexpr int ATT_KP = 144, ATT_VP = 136, ATT_STAGE = 64 * ATT_KP + 64 * ATT_VP;
__device__ __forceinline__ void attend_unit(const bf16* QB, const bf16* KB, const bf16* VT, const unsigned long long* BM, bf16* OB, LAS unsigned char* lds, int b, int kvh, int qt, float nbound, int tid, unsigned* qnext, int& nxt) {
    const int lane = tid & 63, wave = tid >> 6, r32 = lane & 31, hi = lane >> 5, qh = wave >> 2, head = kvh * 4 + (wave & 3);
    const size_t qrow = (size_t)b * SEQ + qt * 64 + qh * 32 + r32;
    bf16x8 qf[4];
#pragma unroll
    for (int d0 = 0; d0 < 4; ++d0) qf[d0] = *(const GAS bf16x8*)(QB + qrow * 1024 + head * 64 + d0 * 16 + hi * 8);
    const int srow = tid >> 3, sch = tid & 7;
    const bf16* kg = KB + ((size_t)b * SEQ + srow) * 256 + kvh * 64 + sch * 8;
    const bf16* vg = VT + ((size_t)(b * 4 + kvh) * 64 + srow) * SEQ + sch * 8;
    const unsigned long long* bmq = BM + qrow * 64; const LAS unsigned char* mtab = lds + 3 * ATT_STAGE + 64;
    f32x16 o0 = {}, o1 = {}; f32x16 nb16; float ls[4] = {0.f, 0.f, 0.f, 0.f};
#pragma unroll
    for (int i = 0; i < 16; ++i) nb16[i] = nbound;
    const bf16x8 ones8 = {0x3F80, 0x3F80, 0x3F80, 0x3F80, 0x3F80, 0x3F80, 0x3F80, 0x3F80};
    const int nt = qt + 1;
#define ATT_STORE(T, KR, VR) do { LAS unsigned char* st_ = lds + ((T) % 3) * ATT_STAGE; *(LAS v4u*)(st_ + srow * ATT_KP + sch * 16) = KR; \
        LAS v2u* vp_ = (LAS v2u*)(st_ + 64 * ATT_KP + srow * ATT_VP + sch * 16); vp_[0] = (v2u){VR.x, VR.y}; vp_[1] = (v2u){VR.z, VR.w}; } while (0)
#define ATT_QK(T, P0, P1) do { const LAS unsigned char* st_ = lds + ((T) % 3) * ATT_STAGE; _Pragma("unroll") for (int d0 = 0; d0 < 4; ++d0) { \
        const bf16x8 k0 = *(const LAS bf16x8*)(st_ + r32 * ATT_KP + d0 * 32 + hi * 16), k1 = *(const LAS bf16x8*)(st_ + (32 + r32) * ATT_KP + d0 * 32 + hi * 16); \
        P0 = __builtin_amdgcn_mfma_f32_32x32x16_bf16(k0, qf[d0], P0, 0, 0, 0); P1 = __builtin_amdgcn_mfma_f32_32x32x16_bf16(k1, qf[d0], P1, 0, 0, 0); } } while (0)
#define ATT_BAR() do { asm volatile("s_waitcnt lgkmcnt(0)" ::: "memory"); __builtin_amdgcn_s_barrier(); asm volatile("" ::: "memory"); } while (0)
    auto tcl = [&](int t) { return t < nt ? t : nt - 1; };
    v4u kA = *(const GAS v4u*)kg, vA = *(const GAS v4u*)vg; unsigned long long wA = bmq[0];
    v4u kB = *(const GAS v4u*)(kg + (size_t)tcl(1) * 64 * 256), vB = *(const GAS v4u*)(vg + tcl(1) * 64); unsigned long long wB = bmq[tcl(1)];
    ATT_STORE(0, kA, vA);
    kA = *(const GAS v4u*)(kg + (size_t)tcl(2) * 64 * 256); vA = *(const GAS v4u*)(vg + tcl(2) * 64);
    ATT_BAR();
    f32x16 p0 = nb16, p1 = nb16;
    ATT_QK(0, p0, p1);
    auto step = [&](const int t, v4u& kq, v4u& vq, unsigned long long& wp) __attribute__((always_inline)) {
        const unsigned long long wcur = wp;
        if (t + 1 < nt) ATT_STORE(t + 1, kq, vq);
        ATT_BAR();
        { const int t3 = tcl(t + 3); wp = bmq[tcl(t + 2)]; kq = *(const GAS v4u*)(kg + (size_t)t3 * 64 * 256); vq = *(const GAS v4u*)(vg + t3 * 64); }
        if (t == 0 && tid == 0) nxt = (int)__hip_atomic_fetch_add(qnext, 1u, __ATOMIC_RELAXED, __HIP_MEMORY_SCOPE_AGENT);
        f32x16 n0 = nb16, n1 = nb16;
        ATT_QK(t + 1, n0, n1);
#pragma unroll
        for (int r = 0; r < 16; ++r) { p0[r] = fast_exp2(p0[r]); p1[r] = fast_exp2(p1[r]); }
        const unsigned ml = (unsigned)wcur >> (4 * hi), mh = (unsigned)(wcur >> 32) >> (4 * hi);
        unsigned pw[4][4];
#pragma unroll
        for (int g = 0; g < 4; ++g) {
            const v2u ma = *(const LAS v2u*)(mtab + (((ml >> (8 * g)) & 15u) << 3)), mb = *(const LAS v2u*)(mtab + (((mh >> (8 * g)) & 15u) << 3));
            const int r = 4 * g;
            pw[g >> 1][2 * (g & 1)] = cvtpk(p0[r], p0[r + 1]) & ma.x; pw[g >> 1][2 * (g & 1) + 1] = cvtpk(p0[r + 2], p0[r + 3]) & ma.y;
            pw[2 + (g >> 1)][2 * (g & 1)] = cvtpk(p1[r], p1[r + 1]) & mb.x; pw[2 + (g >> 1)][2 * (g & 1) + 1] = cvtpk(p1[r + 2], p1[r + 3]) & mb.y;
        }
        const LAS unsigned char* vb = lds + (t % 3) * ATT_STAGE + 64 * ATT_KP;
#pragma unroll
        for (int kk = 0; kk < 4; ++kk) {
            const bf16x8 pf = __builtin_bit_cast(bf16x8, (v4u){pw[kk][0], pw[kk][1], pw[kk][2], pw[kk][3]});
            const v2u a0 = *(const LAS v2u*)(vb + r32 * ATT_VP + (16 * kk + 4 * hi) * 2), a1 = *(const LAS v2u*)(vb + r32 * ATT_VP + (16 * kk + 4 * hi) * 2 + 16);
            const v2u c0 = *(const LAS v2u*)(vb + (32 + r32) * ATT_VP + (16 * kk + 4 * hi) * 2), c1 = *(const LAS v2u*)(vb + (32 + r32) * ATT_VP + (16 * kk + 4 * hi) * 2 + 16);
            o0 = __builtin_amdgcn_mfma_f32_32x32x16_bf16(__builtin_bit_cast(bf16x8, (v4u){a0.x, a0.y, a1.x, a1.y}), pf, o0, 0, 0, 0);
            o1 = __builtin_amdgcn_mfma_f32_32x32x16_bf16(__builtin_bit_cast(bf16x8, (v4u){c0.x, c0.y, c1.x, c1.y}), pf, o1, 0, 0, 0);
#pragma unroll
            for (int j = 0; j < 4; ++j) ls[j] = __builtin_amdgcn_fdot2_f32_bf16(__builtin_bit_cast(bf16x2_t, pw[kk][j]), __builtin_bit_cast(bf16x2_t, 0x3F803F80u), ls[j], false); }
        p0 = n0; p1 = n1;
    };
#pragma unroll 1
    for (int t = 0; t < nt; t += 2) {
        step(t, kB, vB, wA);
        if (t + 1 >= nt) break;
        step(t + 1, kA, vA, wB);
    }
#undef ATT_BAR
#undef ATT_STORE
#undef ATT_QK
    float lsum = (ls[0] + ls[1]) + (ls[2] + ls[3]); lsum += __shfl_xor(lsum, 32); const float inv = 1.0f / lsum;
    bf16* op = OB + qrow * 1024 + head * 64 + 4 * hi;
#pragma unroll
    for (int r4 = 0; r4 < 4; ++r4) {
        v2u w0, w1; w0.x = pk2(o0[4 * r4] * inv, o0[4 * r4 + 1] * inv); w0.y = pk2(o0[4 * r4 + 2] * inv, o0[4 * r4 + 3] * inv);
        w1.x = pk2(o1[4 * r4] * inv, o1[4 * r4 + 1] * inv); w1.y = pk2(o1[4 * r4 + 2] * inv, o1[4 * r4 + 3] * inv);
        *(GAS v2u*)(op + 8 * r4) = w0; *(GAS v2u*)(op + 32 + 8 * r4) = w1; }
    __syncthreads();
}

__device__ __forceinline__ void samp_scores_task(const bf16* QIB, const float* WI, const bf16* KIB, const float* cik, const int* page_table, unsigned* SKEYS, LAS float* scr, int b, int pg, int lane) {
    const size_t row = (size_t)NP + b;
    for (int i = lane; i < 512; i += 64) scr[i] = bflo((unsigned)QIB[row * 512 + i]);
    LDS_WAIT(); asm volatile("" ::: "memory");
    float wi[8];
#pragma unroll
    for (int h = 0; h < 8; ++h) wi[h] = WI[row * 8 + h];
    if (pg < NPAGE) {
        const int phys = page_table[b * NPAGE + pg];
#pragma unroll 1
        for (int rep = 0; rep < 2; ++rep) { const int kk = lane + rep * 64; const float* kr = cik + ((size_t)phys * 128 + kk) * 64; float d[8];
#pragma unroll
            for (int h = 0; h < 8; ++h) d[h] = 0.f;
#pragma unroll 4
            for (int c = 0; c < 16; ++c) { const f32x4 k4 = *(const GAS f32x4*)(kr + c * 4);
#pragma unroll
                for (int h = 0; h < 8; ++h) { const f32x4 q4 = *(const LAS f32x4*)(scr + h * 64 + c * 4); d[h] += k4[0] * q4[0] + k4[1] * q4[1] + k4[2] * q4[2] + k4[3] * q4[3]; } }
            float sc = 0.f;
#pragma unroll
            for (int h = 0; h < 8; ++h) sc += fmaxf(d[h], 0.f) * wi[h];
            SKEYS[(size_t)b * 16640 + pg * 128 + kk] = f2key(sc); }
    } else {
        const float kv = bflo((unsigned)KIB[row * 64 + lane]); float sc = 0.f;
#pragma unroll
        for (int h = 0; h < 8; ++h) { const float d = wave_sum(kv * scr[h * 64 + lane]); sc += fmaxf(d, 0.f) * wi[h]; }
        if (lane == 0) SKEYS[(size_t)b * 16640 + PAST] = f2key(sc);
    }
    LDS_WAIT(); asm volatile("" ::: "memory");
}
__device__ __forceinline__ void samp_select_attend(const unsigned* SKEYS, const bf16* QB, const bf16* KB, const bf16* V2B, const float* ck, const float* cv, const int* page_table,
                                                   bf16* OB, LAS unsigned char* lds, int b, int tid) {
    LAS int* cnt = (LAS int*)lds;
    LAS int* sl = (LAS int*)(lds + 64);
    LAS float* qs = (LAS float*)(lds + 64 + 1024);
    LAS float* lg = (LAS float*)(lds + 64 + 1024 + 4096);
    const int lane = tid & 63, w = tid >> 6; const size_t row = (size_t)NP + b; const int n = PAST + 1;
    const unsigned* kk = SKEYS + (size_t)b * 16640;
    unsigned x[33];
#pragma unroll
    for (int j = 0; j < 33; ++j) { const int s = j * 512 + tid; x[j] = (s < n) ? kk[s] : 0u; }
    for (int i = tid; i < 1024; i += NTHR) qs[i] = bflo((unsigned)QB[row * 1024 + i]);
    if (tid < 4) cnt[tid] = 0;
    __syncthreads();
    unsigned T = 0u;
#pragma unroll 1
    for (int bit = 31; bit >= 0; --bit) { const unsigned c = T | (1u << bit); int my = 0;
#pragma unroll
        for (int j = 0; j < 33; ++j) my += __builtin_popcountll(__ballot(x[j] >= c));
        if (lane == 0) atomicAdd((int*)&cnt[bit & 1], my);
        __syncthreads();
        const int tot = cnt[bit & 1]; if (tot >= 256) T = c;
        if (tid == 0) cnt[(bit + 1) & 1] = 0;
        __syncthreads(); }
    { const unsigned long long lt = lanemask_lt(lane); int cg = 0, ce = 0;
#pragma unroll
      for (int j = 0; j < 33; ++j) { cg += __builtin_popcountll(__ballot(x[j] > T)); ce += __builtin_popcountll(__ballot(x[j] == T)); }
      LAS int* wc = (LAS int*)(lds + 22656);
      if (lane == 0) { wc[w * 2] = cg; wc[w * 2 + 1] = ce; }
      __syncthreads();
      int bg = 0, be = 0, tg = 0;
      for (int ww = 0; ww < NWAVES; ++ww) { const int a_ = wc[ww * 2], e_ = wc[ww * 2 + 1]; if (ww < w) { bg += a_; be += e_; } tg += a_; }
      const int need = 256 - tg;
#pragma unroll
      for (int j = 0; j < 33; ++j) { const bool sg = x[j] > T, se = x[j] == T; const unsigned long long mg = __ballot(sg), me = __ballot(se);
          if (sg) sl[bg + __builtin_popcountll(mg & lt)] = j * 512 + tid;
          if (se) { const int r = be + __builtin_popcountll(me & lt); if (r < need) sl[tg + r] = j * 512 + tid; }
          bg += __builtin_popcountll(mg); be += __builtin_popcountll(me); } }
    __syncthreads();
    LAS int* prow = (LAS int*)(lds + 64 + 1024 + 4096 + 16384);
    if (tid < 256) { const int s = sl[tid]; prow[tid] = (s >= PAST) ? -1 : page_table[b * NPAGE + (s >> 7)] * 128 + (s & 127); }
    __syncthreads();
    { const int n_ = tid & 255, hh = tid >> 8; const int pr = prow[n_];
      float kv[2][64];
      if (pr >= 0) { const float* krf = ck + (size_t)pr * 256 + hh * 128;
#pragma unroll
          for (int i = 0; i < 32; ++i) { const f32x4 k4 = *(const GAS f32x4*)(krf + i * 4); kv[i >> 4][(i & 15) * 4] = k4[0]; kv[i >> 4][(i & 15) * 4 + 1] = k4[1]; kv[i >> 4][(i & 15) * 4 + 2] = k4[2]; kv[i >> 4][(i & 15) * 4 + 3] = k4[3]; } }
      else { const bf16* krb = KB + row * 256 + hh * 128;
#pragma unroll
          for (int i = 0; i < 128; ++i) kv[i >> 6][i & 63] = bflo((unsigned)krb[i]); }
#pragma unroll
      for (int hq = 0; hq < 8; ++hq) { const int h = hh * 8 + hq; float d = 0.f;
#pragma unroll
          for (int i = 0; i < 64; i += 4) { const f32x4 q4 = *(const LAS f32x4*)(qs + h * 64 + i); d += q4[0] * kv[hq >> 2][i] + q4[1] * kv[hq >> 2][i + 1] + q4[2] * kv[hq >> 2][i + 2] + q4[3] * kv[hq >> 2][i + 3]; }
          lg[h * 256 + n_] = d; } }
    __syncthreads();
    for (int h = w; h < 16; h += NWAVES) { float v[4]; float m = -INFINITY;
#pragma unroll
        for (int i = 0; i < 4; ++i) { v[i] = lg[h * 256 + i * 64 + lane]; m = fmaxf(m, v[i]); }
#pragma unroll
        for (int o = 1; o < 64; o <<= 1) m = fmaxf(m, __shfl_xor(m, o));
        float sum = 0.f;
#pragma unroll
        for (int i = 0; i < 4; ++i) { v[i] = fast_exp2(v[i] - m); sum += v[i]; }
        sum = wave_sum(sum); const float inv = 1.0f / sum;
#pragma unroll
        for (int i = 0; i < 4; ++i) lg[h * 256 + i * 64 + lane] = v[i] * inv; }
    __syncthreads();
    {
        LAS float* red = (LAS float*)(lds + 24576);
        const int kvh = lane >> 4, d0 = (lane & 15) * 4;
        f32x4 vr[32];
#pragma unroll
        for (int jj = 0; jj < 32; ++jj) { const int pr = prow[w * 32 + jj];
            if (pr >= 0) vr[jj] = *(const GAS f32x4*)(cv + (size_t)pr * 256 + kvh * 64 + d0);
            else { const v2u vb = *(const GAS v2u*)(V2B + row * 256 + kvh * 64 + d0); vr[jj] = (f32x4){bflo(vb.x), bfhi(vb.x), bflo(vb.y), bfhi(vb.y)}; } }
        f32x4 acc[4];
#pragma unroll
        for (int g = 0; g < 4; ++g) acc[g] = (f32x4){0.f, 0.f, 0.f, 0.f};
#pragma unroll
        for (int jj = 0; jj < 32; ++jj) {
#pragma unroll
            for (int g = 0; g < 4; ++g) acc[g] += vr[jj] * lg[(kvh * 4 + g) * 256 + w * 32 + jj]; }
#pragma unroll
        for (int g = 0; g < 4; ++g) *(LAS f32x4*)(red + w * 1024 + (kvh * 4 + g) * 64 + d0) = acc[g];
        __syncthreads();
        { const int c = tid * 2; float o0 = 0.f, o1 = 0.f;
#pragma unroll
          for (int ww = 0; ww < 8; ++ww) { const f32x2 r2 = *(const LAS f32x2*)(red + ww * 1024 + c); o0 += r2[0]; o1 += r2[1]; }
          *(GAS unsigned*)(OB + row * 1024 + c) = pk2(o0, o1); }
    }
    __syncthreads();
}

template <int K> __device__ __forceinline__ void thin_gemm_tile(const bf16* A, const bf16* Bt, int col0, LAS float* red, int tid, float& v0, float& v1) {
    const int lane = tid & 63, w = tid >> 6, r32 = lane & 31, hi = lane >> 5;
    constexpr int KS = K / 8, NS = KS / 16;
    const bf16* ap = A + (size_t)r32 * K + w * KS + hi * 8;
    const bf16* bp = Bt + (size_t)(col0 + r32) * K + w * KS + hi * 8;
    f32x16 acc = {};
    bf16x8 af[NS], bf_[NS];
#pragma unroll
    for (int i = 0; i < NS; ++i) { af[i] = *(const GAS bf16x8*)(ap + i * 16); bf_[i] = *(const GAS bf16x8*)(bp + i * 16); }
#pragma unroll
    for (int i = 0; i < NS; ++i) acc = __builtin_amdgcn_mfma_f32_32x32x16_bf16(af[i], bf_[i], acc, 0, 0, 0);
    __syncthreads();
#pragma unroll
    for (int i = 0; i < 16; ++i) red[w * 1024 + ((i & 3) + 8 * (i >> 2) + 4 * hi) * 32 + r32] = acc[i];
    __syncthreads();
    v0 = 0.f; v1 = 0.f;
#pragma unroll
    for (int ww = 0; ww < 8; ++ww) { const f32x2 t = *(const LAS f32x2*)(red + ww * 1024 + tid * 2); v0 += t[0]; v1 += t[1]; }
}
__device__ __forceinline__ float row16_sum(float v) {
    v += __shfl_xor(v, 1); v += __shfl_xor(v, 2); v += __shfl_xor(v, 4); v += __shfl_xor(v, 8); return v;
}

__global__ void __launch_bounds__(NTHR, 2) fused_fwd(Params prm) {
    extern __shared__ __attribute__((aligned(16))) unsigned char lds_raw[];
    LAS unsigned char* lds = (LAS unsigned char*)lds_raw;
    volatile LAS unsigned* MISC = (volatile LAS unsigned*)(lds + MISC_OFF);
    const int tid = threadIdx.x, lane = tid & 63, wave = __builtin_amdgcn_readfirstlane(tid >> 6);
    const int G = gridDim.x, bid = blockIdx.x;
    const int gw = bid * NWAVES + wave, NGW = G * NWAVES;
    unsigned char* ws = prm.ws;
    for (int u = tid; u < (LDS_BYTES - RING_BYTES) / 4; u += NTHR) ((LAS unsigned*)(lds + RING_BYTES))[u] = 0u;
    __syncthreads();
    XcdBarrier bar = xcd_barrier_post((unsigned*)ws + CW_BAR, MISC + 8);
    const int lo = prm.ph_lo, hi = prm.ph_hi;
#ifndef REPMASK
#define REPMASK 0
#endif
#define REP(k) (((REPMASK >> (k)) & 1) ? 2 : 1)
#ifndef DISMASK
#define DISMASK 0
#endif
#define IN(k) (lo <= (k) && (k) < hi && !((DISMASK >> (k)) & 1))
#define SEAM(k) do { if (IN(k) && IN((k) + 1)) xcd_barrier(bar); } while (0)
    const float* x_prompt = prm.in[0]; const float* x_sample = prm.in[1]; const float* cache_k = prm.in[2]; const float* cache_v = prm.in[3]; const float* cache_ik = prm.in[4];
    const int* page_table = (const int*)prm.in[5]; const float* norm_mix_g = prm.in[6]; const float* norm_ffn_g = prm.in[7];
    const float* gmlp_w_in = prm.in[8]; const float* gmlp_v_g = prm.in[9]; const float* gmlp_w_s = prm.in[10]; const float* gmlp_b_s = prm.in[11]; const float* gmlp_w_out = prm.in[12];
    const float* att_w_in = prm.in[13]; const float* att_qg = prm.in[14]; const float* att_kg = prm.in[15]; const float* att_ikg = prm.in[16]; const float* att_w_out = prm.in[17];
    const float* peer_wq = prm.in[18]; const float* peer_k1 = prm.in[19]; const float* peer_k2 = prm.in[20]; const float* peer_u = prm.in[21]; const float* peer_v = prm.in[22];
    float* out = prm.out;
    unsigned long long* SSV = (unsigned long long*)(ws + W_SSV); unsigned long long* SS1 = (unsigned long long*)(ws + W_SS1); unsigned long long* SS3 = (unsigned long long*)(ws + W_SS3); float* SS0 = (float*)(ws + W_SS0); float* SS2 = (float*)(ws + W_SS2); unsigned* QC = (unsigned*)(ws + W_QC);
    unsigned char* XQ = ws + W_XQ; float* RSX = (float*)(ws + W_RSX); float* ACT = (float*)(ws + W_ACT);
    bf16* X0B = (bf16*)(ws + W_X0B); bf16* WIN0T = (bf16*)(ws + W_WIN0T); bf16* WOUT0T = (bf16*)(ws + W_WOUT0T); bf16* WP0T = (bf16*)(ws + W_WP0T); bf16* WP1T = (bf16*)(ws + W_WP1T);
    bf16* WIN1T = (bf16*)(ws + W_WIN1T); bf16* WOUT1T = (bf16*)(ws + W_WOUT1T); float* WSMT = (float*)(ws + W_WSMT); float* ROPE = (float*)(ws + W_ROPE);
    unsigned char* U8 = ws + W_UB; unsigned char* V8 = ws + W_VB; float* SU = (float*)(ws + W_SU); float* SV = (float*)(ws + W_SV); bf16* X1B = (bf16*)(ws + W_X1B); bf16* X2B = (bf16*)(ws + W_X2B); bf16* X3B = (bf16*)(ws + W_X3B);
    bf16* U0 = (bf16*)(ws + W_U0); bf16* V0 = (bf16*)(ws + W_V0); bf16* G0 = (bf16*)(ws + W_G0); unsigned short* SH = (unsigned short*)(ws + W_BIG); bf16* PBF = (bf16*)(ws + W_BIG); unsigned short* SC = (unsigned short*)(ws + W_BIG);
    unsigned* EIDX = (unsigned*)(ws + W_EIDX); float* GATE = (float*)(ws + W_GATE);
    bf16* QB = (bf16*)(ws + W_QB); bf16* KB = (bf16*)(ws + W_KB); bf16* V2B = (bf16*)(ws + W_V2B); bf16* QIB = (bf16*)(ws + W_QIB); bf16* KIB = (bf16*)(ws + W_KIB); float* WI = (float*)(ws + W_WI);
    unsigned long long* BM = (unsigned long long*)(ws + W_SEL); bf16* VT = (bf16*)(ws + W_VT); unsigned* SKEYS = (unsigned*)(ws + W_SKEYS); bf16* OB = (bf16*)(ws + W_OB);

    if (IN(0)) for (int rep = 0; rep < REP(0); ++rep) {
        LAS float* scr = (LAS float*)(lds + wave * 16384);
        constexpr int I_X = MP, I_WIN0 = 16 * 128, I_WOUT0 = 32 * 32, I_WIN1 = 16 * 72, I_WOUT1 = 16 * 32, I_WP = 2 * 16 * 64, I_U = 2 * 16384, I_V = 2 * 16384, I_ROPE = (4097 * 32 + 63) / 64, I_WSM = 8 * 128 * 128 / 64;
        constexpr int TOTAL = I_WIN0 + I_WOUT0 + I_WIN1 + I_WOUT1 + I_WP + I_ROPE + I_WSM;
        for (int it = gw; it < TOTAL; it += NGW) {
            int r = it;
            if (r < I_WP) { const int l = r >> 10, hh = (r >> 6) & 15, jb = r & 63, h = hh >> 1, half = hh & 1;
                p0_wp_item(peer_wq + (size_t)l * 1024 * 2048, (half ? peer_k2 : peer_k1) + (size_t)l * 16384, norm_ffn_g + l * 1024, l ? WP1T : WP0T, h * 256 + half * 128, jb * 16, scr, lane); continue; } r -= I_WP;
            if (r < I_WIN0) { p0_transpose_item(gmlp_w_in, 4096, 1024, 128, 4096, norm_mix_g, WIN0T, scr, r, lane); continue; } r -= I_WIN0;
            if (r < I_WOUT0) { p0_transpose_item(gmlp_w_out, 1024, 2048, 32, 1024, nullptr, WOUT0T, scr, r, lane); continue; } r -= I_WOUT0;
            if (r < I_WIN1) { p0_transpose_item(att_w_in, APROJ, 1024, 72, APROJ, norm_mix_g + 1024, WIN1T, scr, r, lane); continue; } r -= I_WIN1;
            if (r < I_WOUT1) { p0_transpose_item(att_w_out, 1024, 1024, 32, 1024, nullptr, WOUT1T, scr, r, lane); continue; } r -= I_WOUT1;
            if (r < I_ROPE) { const int i = r * 64 + lane; if (i < 4097 * 32) { const int p = i >> 5, d = i & 31; const float pos = (p < 4096) ? (float)p : 16384.0f;
                    const float ang = pos * prm.inv[d]; const double rev = (double)ang * 0.15915494309189535; const float fr = (float)(rev - floor(rev));
                    ROPE[p * 64 + d] = __builtin_amdgcn_cosf(fr); ROPE[p * 64 + 32 + d] = __builtin_amdgcn_sinf(fr); } continue; } r -= I_ROPE;
            { const int e = r * 64 + lane, t = (e >> 7) & 127, s = e & 127; ((unsigned short*)WSMT)[e] = (unsigned short)((s <= t) ? (cvtpk(gmlp_w_s[e], 0.f) & 0xffffu) : 0u); }
        }
        {
            auto xsrc = [&](int r) { return r < NP ? x_prompt + (size_t)r * 1024 : (r < NT ? x_sample + (size_t)(r - NP) * 1024 : (const float*)nullptr); };
            RowIn A, B; int r = gw; if (r < I_X) p0_rowx_load(A, xsrc(r), lane);
            for (; r < I_X; r += 2 * NGW) {
                if (r + NGW < I_X) p0_rowx_load(B, xsrc(r + NGW), lane);
                { const float sq = p0_rowx_store(A, X0B + (size_t)r * 1024, lane); if (lane == 0) SS0[r] = sq; }
                if (r + NGW >= I_X) break;
                if (r + 2 * NGW < I_X) p0_rowx_load(A, xsrc(r + 2 * NGW), lane);
                { const float sq = p0_rowx_store(B, X0B + (size_t)(r + NGW) * 1024, lane); if (lane == 0) SS0[r + NGW] = sq; } } }
        {
            RowIn A, B; int r = gw;
            auto qsrc = [&](int q) { return q < I_U ? peer_u + (size_t)q * 1024 : peer_v + (size_t)(q - I_U) * 1024; };
            auto qst = [&](const RowIn& R, int q) { if (q < I_U) p0_rowq_store(R, norm_ffn_g + (q >> 14) * 1024, U8 + (size_t)q * 1024, SU + q, lane, false, 0);
                                                    else { const int v = q - I_U; p0_rowq_store(R, nullptr, V8 + (size_t)(v >> 14) * 16384 * 1024, SV + v, lane, true, v & 16383); } };
            if (r < I_U + I_V) p0_rowq_load(A, qsrc(r), lane);
            for (; r < I_U + I_V; r += 2 * NGW) {
                if (r + NGW < I_U + I_V) p0_rowq_load(B, qsrc(r + NGW), lane);
                qst(A, r);
                if (r + NGW >= I_U + I_V) break;
                if (r + 2 * NGW < I_U + I_V) p0_rowq_load(A, qsrc(r + 2 * NGW), lane);
                qst(B, r + NGW); } }
    }
    SEAM(0);
    if (IN(1)) for (int rep = 0; rep < REP(1); ++rep) { pg8::Gemm g{X0B, WIN0T, NP, 4096, 1024}; pg8::StaticOrder S; S.init(NP, 4096, G, bid); pg8::EpiUV E{U0, V0, SS0, SSV, rep == 0};
        pg8::gemm_phase<pg8::EpiUV, pg8::StaticOrder, true, true>(lds, g, S, E);
        for (int tk = bid; tk < 4096 / 32; tk += G) { float v0, v1; thin_gemm_tile<1024>(X0B + (size_t)NP * 1024, WIN0T, tk * 32, (LAS float*)lds, tid, v0, v1);
            const int r = tid >> 4, row = NP + r, col = tk * 32 + 2 * (tid & 15); const float rs = rsqrtf(SS0[row] * (1.0f / 1024.0f) + EPS); v0 *= rs; v1 *= rs;
            if (col < 2048) *(GAS unsigned*)(U0 + (size_t)row * 2048 + col) = pk2(v0, v1);
            else { *(GAS unsigned*)(V0 + (size_t)row * 2048 + col - 2048) = pk2(v0, v1); const float sq = row16_sum(v0 * v0 + v1 * v1); if ((tid & 15) == 0 && rep == 0) pg8::ss_add(SSV + row, sq); } } }
    SEAM(1);
    if (IN(2)) for (int rep = 0; rep < REP(2); ++rep) {
        typedef short s16x4_t __attribute__((ext_vector_type(4)));
        LAS float* rvs = (LAS float*)(lds + 98304); LAS unsigned char* slab = lds + wave * 8192; LAS float* vgl = (LAS float*)(lds + 65536 + wave * 1024);
        const int c = tid * 4, g = wave, r32 = lane & 31, hi = lane >> 5;
        for (int unit = bid; unit < 256; unit += G) {
            const int row0 = unit * 128;
            __syncthreads();
            { int tl = tid; asm volatile("" : "+v"(tl));
              if (tl < 128) rvs[tl] = rsqrtf(pg8::ss_get(SSV + row0 + tl) * (1.0f / 2048.0f) + EPS);
              for (int i = tl & 63; i < 256; i += 64) vgl[i] = gmlp_v_g[g * 256 + i]; }
            __syncthreads();
            const __amdgpu_buffer_rsrc_t rV = __builtin_amdgcn_make_buffer_rsrc((void*)V0, 0, 0x7fffffff, 0x00020000), rU = __builtin_amdgcn_make_buffer_rsrc((void*)U0, 0, 0x7fffffff, 0x00020000), rG = __builtin_amdgcn_make_buffer_rsrc((void*)G0, 0, 0x7fffffff, 0x00020000);
            const unsigned voffv = (unsigned)(((lane >> 2) * 2048 + g * 256 + (lane & 3) * 8) * 2), voffu = (unsigned)((r32 * 2048 + g * 256 + 4 * hi) * 2);
            const __amdgpu_buffer_rsrc_t rW = __builtin_amdgcn_make_buffer_rsrc((void*)WSMT, 0, 0x7fffffff, 0x00020000); const unsigned voffw = (unsigned)((r32 * 128 + 8 * hi) * 2); const int gs = __builtin_amdgcn_readfirstlane(g);
            v4u pv[8]; v2u pu[16];
#pragma unroll
            for (int i = 0; i < 8; ++i) pv[i] = __builtin_amdgcn_raw_buffer_load_b128(rV, voffv, (row0 + 16 * i) * 4096, 0);
#pragma unroll
            for (int j = 0; j < 16; ++j) pu[j] = __builtin_amdgcn_raw_buffer_load_b64(rU, voffu, (row0 + 32 * (j >> 2)) * 4096 + 16 * (j & 3), 0);
            bf16x8 wf[20]; float bias[4], rv8[8];
#pragma unroll
            for (int i = 0; i < 8; ++i) rv8[i] = rvs[(lane >> 2) + 16 * i];
#pragma unroll
            for (int tb = 0; tb < 4; ++tb) { bias[tb] = gmlp_b_s[g * 128 + tb * 32 + r32];
#pragma unroll
                for (int kk = 0; kk < 2 * tb + 2; ++kk) wf[tb * (tb + 1) + kk] = __builtin_bit_cast(bf16x8, __builtin_amdgcn_raw_buffer_load_b128(rW, voffw, (gs * 128 + tb * 32) * 256 + kk * 32, 0)); }
            LAS unsigned char* trp = slab + (8 * hi + ((lane & 15) >> 2)) * 64 + (((lane >> 4) & 1) * 16 + (lane & 3) * 4) * 2;
#pragma unroll 1
            for (int cb = 0; cb < 8; ++cb) {
#pragma unroll
                for (int i = 0; i < 8; ++i) { const float rv = rv8[i]; v4u w; w.x = cvtpk(bflo(pv[i].x) * rv, bfhi(pv[i].x) * rv); w.y = cvtpk(bflo(pv[i].y) * rv, bfhi(pv[i].y) * rv); w.z = cvtpk(bflo(pv[i].z) * rv, bfhi(pv[i].z) * rv); w.w = cvtpk(bflo(pv[i].w) * rv, bfhi(pv[i].w) * rv);
                    *(LAS v4u*)(slab + ((lane >> 2) + 16 * i) * 64 + (lane & 3) * 16) = w; }
                if (cb + 1 < 8) {
#pragma unroll
                    for (int i = 0; i < 8; ++i) pv[i] = __builtin_amdgcn_raw_buffer_load_b128(rV, voffv, (row0 + 16 * i) * 4096 + (cb + 1) * 64, 0); }
                LDS_WAIT(); asm volatile("" ::: "memory");
                bf16x8 af[8];
#pragma unroll
                for (int kk = 0; kk < 8; ++kk) { const s16x4_t lo = __builtin_amdgcn_ds_read_tr16_b64_v4i16((LAS s16x4_t*)(trp + kk * 1024)), h4 = __builtin_amdgcn_ds_read_tr16_b64_v4i16((LAS s16x4_t*)(trp + kk * 1024 + 256));
                    af[kk] = (bf16x8){lo[0], lo[1], lo[2], lo[3], h4[0], h4[1], h4[2], h4[3]}; }
#pragma unroll
                for (int tb = 0; tb < 4; ++tb) { f32x16 acc = {};
#pragma unroll
                    for (int kk = 0; kk < 2 * tb + 2; ++kk) acc = __builtin_amdgcn_mfma_f32_32x32x16_bf16(af[kk], wf[tb * (tb + 1) + kk], acc, 0, 0, 0);
#pragma unroll
                    for (int i4 = 0; i4 < 4; ++i4) { const f32x4 vg = *(const LAS f32x4*)(vgl + cb * 32 + 8 * i4 + 4 * hi); const v2u uu = pu[tb * 4 + i4];
                        const float o0 = bflo(uu.x) * (acc[4 * i4] * vg[0] + bias[tb]), o1 = bfhi(uu.x) * (acc[4 * i4 + 1] * vg[1] + bias[tb]), o2 = bflo(uu.y) * (acc[4 * i4 + 2] * vg[2] + bias[tb]), o3 = bfhi(uu.y) * (acc[4 * i4 + 3] * vg[3] + bias[tb]);
                        v2u w; w.x = pk2(o0, o1); w.y = pk2(o2, o3); __builtin_amdgcn_raw_buffer_store_b64(w, rG, voffu, (row0 + 32 * tb) * 4096 + cb * 64 + 16 * i4, 0); }
                    __builtin_amdgcn_sched_barrier(0); }
                if (cb + 1 < 8) {
#pragma unroll
                    for (int j = 0; j < 16; ++j) pu[j] = __builtin_amdgcn_raw_buffer_load_b64(rU, voffu, (row0 + 32 * (j >> 2)) * 4096 + (cb + 1) * 64 + 16 * (j & 3), 0); }
                LDS_WAIT(); asm volatile("" ::: "memory");
            }
        }
        for (int r = bid; r < MP - NP; r += G) {
            const int row = NP + r; const float rv = rsqrtf(pg8::ss_get(SSV + row) * (1.0f / 2048.0f) + EPS); const f32x4 vg = *(const GAS f32x4*)(gmlp_v_g + c);
            const v2u vv = *(const GAS v2u*)(V0 + (size_t)row * 2048 + c); const v2u uu = *(const GAS v2u*)(U0 + (size_t)row * 2048 + c);
            const float w00 = gmlp_w_s[(size_t)g * 16384], bias = gmlp_b_s[g * 128];
            const float n0 = bflo(vv.x) * rv * vg[0], n1 = bfhi(vv.x) * rv * vg[1], n2 = bflo(vv.y) * rv * vg[2], n3 = bfhi(vv.y) * rv * vg[3];
            v2u w; w.x = pk2(bflo(uu.x) * (w00 * n0 + bias), bfhi(uu.x) * (w00 * n1 + bias)); w.y = pk2(bflo(uu.y) * (w00 * n2 + bias), bfhi(uu.y) * (w00 * n3 + bias));
            *(GAS v2u*)(G0 + (size_t)row * 2048 + c) = w;
            if (r < NS) *(GAS f32x4*)(out + O_CV + (size_t)r * 2048 + c) = (f32x4){n0, n1, n2, n3};
        }
    }
    SEAM(2);
    if (IN(3)) for (int rep = 0; rep < REP(3); ++rep) { pg8::Gemm g{G0, WOUT0T, NP, 1024, 2048}; pg8::StaticOrder S; S.init(NP, 1024, G, bid); pg8::EpiResid<false> E{x_prompt, x_sample, X1B, SS1, NP, NT, rep == 0};
        pg8::gemm_phase<pg8::EpiResid<false>, pg8::StaticOrder, true, true>(lds, g, S, E);
        for (int tk = bid; tk < 1024 / 32; tk += G) { float v0, v1; thin_gemm_tile<2048>(G0 + (size_t)NP * 2048, WOUT0T, tk * 32, (LAS float*)lds, tid, v0, v1);
            const int r = tid >> 4, row = NP + r, col = tk * 32 + 2 * (tid & 15); const f32x2 xr = *(const GAS f32x2*)(x_sample + (size_t)r * 1024 + col); v0 += xr[0]; v1 += xr[1];
            *(GAS unsigned*)(X1B + (size_t)row * 1024 + col) = pk2(v0, v1); const float sq = row16_sum(v0 * v0 + v1 * v1); if ((tid & 15) == 0 && rep == 0) pg8::ss_add(SS1 + row, sq); } }
    SEAM(3);
    if (IN(4)) for (int rep = 0; rep < REP(4); ++rep) { pg8::Gemm g{X1B, WP0T, NP, 2048, 1024};
        if (G == 256) {
            const EpiRoute ER{SS1, EIDX, GATE};
            { OneUnit S1; S1.init(NP, 2048, G, bid); S1.k = 0; pg8::gemm_phase<EpiRoute, OneUnit, false, true>(lds, g, S1, ER); }
            { OneUnit S1; S1.init(NP, 2048, G, bid); S1.k = 1; pg8::gemm_phase<EpiRoute, OneUnit, false, true>(lds, g, S1, ER); }
            { OneUnit S1; S1.init(NP, 2048, G, bid); S1.k = 2; pg8::gemm_phase<EpiRoute, OneUnit, false, true>(lds, g, S1, ER); }
            { OneUnit S1; S1.init(NP, 2048, G, bid); S1.k = 3; pg8::gemm_phase<EpiRoute, OneUnit, false, true>(lds, g, S1, ER); }
        } else { pg8::StaticOrder S; S.init(NP, 2048, G, bid); pg8::EpiScaleF16 E{SH, 2048, SS1};
            pg8::gemm_phase<pg8::EpiScaleF16, pg8::StaticOrder, true, true>(lds, g, S, E); }
        for (int tk = bid; tk < 2048 / 32; tk += G) { float v0, v1; thin_gemm_tile<1024>(X1B + (size_t)NP * 1024, WP0T, tk * 32, (LAS float*)lds, tid, v0, v1);
            const int r = tid >> 4, row = NP + r, col = tk * 32 + 2 * (tid & 15); const float rs = rsqrtf(pg8::ss_get(SS1 + row) * (1.0f / 1024.0f) + EPS);
            *(GAS unsigned*)(SH + (size_t)row * 2048 + col) = pg8::EpiScaleF16::pkh(v0 * rs, v1 * rs); } }
    SEAM(4);
    if (IN(5)) for (int rep = 0; rep < REP(5); ++rep) { { RouteIn RA, RB; int task = gw + (G == 256 ? NP * 2 : 0); if (task < NT * 2) peer_route_load(RA, SH, task, lane);
          for (; task < NT * 2; task += 2 * NGW) {
              if (task + NGW < NT * 2) peer_route_load(RB, SH, task + NGW, lane);
              peer_route_task(RA, EIDX, GATE, task, lane);
              if (task + NGW >= NT * 2) break;
              if (task + 2 * NGW < NT * 2) peer_route_load(RA, SH, task + 2 * NGW, lane);
              peer_route_task(RB, EIDX, GATE, task + NGW, lane); } }
        { XqIn QA, QB2; int tok = gw; if (tok < NT) peer_xq_load(QA, X1B, SS1, tok, lane);
          for (; tok < NT; tok += 2 * NGW) {
              if (tok + NGW < NT) peer_xq_load(QB2, X1B, SS1, tok + NGW, lane);
              peer_xq_token(QA, XQ, RSX, tok, lane);
              if (tok + NGW >= NT) break;
              if (tok + 2 * NGW < NT) peer_xq_load(QA, X1B, SS1, tok + 2 * NGW, lane);
              peer_xq_token(QB2, XQ, RSX, tok + NGW, lane); } } }
    SEAM(5);
    if (IN(6)) {
        LAS unsigned* lst = (LAS unsigned*)(lds + wave * 9216);
        PEER_QLOOP_CHUNK(QC + 0 * 512, peer_e1_chunk(XQ, RSX, EIDX, GATE, U8, SU, SV, ACT, lst, t0, t1, pi, lane));
        if (REP(6) == 2) PEER_QLOOP_CHUNK(QC + 4 * 512, peer_e1_chunk(XQ, RSX, EIDX, GATE, U8, SU, SV, ACT, lst, t0, t1, pi, lane));
        xcd_barrier(bar);
        if (REP(16) == 2) PEER_QLOOP_CHUNK(QC + 5 * 512, peer_e2_chunk<true>(X1B, EIDX, ACT, V8, nullptr, X2B, SS2, t0, t1, pi, lane));
        PEER_QLOOP_CHUNK(QC + 1 * 512, peer_e2_chunk<true>(X1B, EIDX, ACT, V8, nullptr, X2B, SS2, t0, t1, pi, lane));
        for (int r = NT + gw; r < MP; r += NGW) { (void)p0_row(nullptr, nullptr, X2B + (size_t)r * 1024, lane); if (lane < 8) SS2[(size_t)lane * MP + r] = 0.f; } }
    SEAM(6);
    if (IN(7)) for (int rep = 0; rep < REP(7); ++rep) { pg8::Gemm g{X2B, WIN1T, NP, APAD, 1024}; pg8::StaticOrder S; S.init(NP, APAD, G, bid); pg8::EpiScaleBf16 E{PBF, APAD, SS2, 8, MP};
        pg8::gemm_phase<pg8::EpiScaleBf16, pg8::StaticOrder, true, true>(lds, g, S, E);
        for (int tk = bid; tk < APAD / 32; tk += G) { float v0, v1; thin_gemm_tile<1024>(X2B + (size_t)NP * 1024, WIN1T, tk * 32, (LAS float*)lds, tid, v0, v1);
            const int r = tid >> 4, row = NP + r, col = tk * 32 + 2 * (tid & 15); float sa = 0.f;
#pragma unroll
            for (int pp = 0; pp < 8; ++pp) sa += SS2[(size_t)pp * MP + row];
            const float rs = rsqrtf(sa * (1.0f / 1024.0f) + EPS); *(GAS unsigned*)(PBF + (size_t)row * APAD + col) = pk2(v0 * rs, v1 * rs); } }
    SEAM(7);
    if (IN(8)) for (int rep = 0; rep < REP(8); ++rep) { { const float gq = att_qg[lane], gk = att_kg[lane], gik = att_ikg[lane]; PostRow RA, RB;
            int row = gw; if (row < NT) att_post_load(RA, PBF, row, lane);
            for (; row < NT; row += 2 * NGW) {
                if (row + NGW < NT) att_post_load(RB, PBF, row + NGW, lane);
                att_post_compute(RA, gq, gk, gik, ROPE, QB, KB, V2B, QIB, KIB, WI, out, row, lane);
                if (row + NGW >= NT) break;
                if (row + 2 * NGW < NT) att_post_load(RA, PBF, row + 2 * NGW, lane);
                att_post_compute(RB, gq, gk, gik, ROPE, QB, KB, V2B, QIB, KIB, WI, out, row + NGW, lane);
            } }
        for (int grp = gw; grp < NP / 8; grp += NGW) {
            const int row0 = grp * 8, b = row0 >> 12, t0 = row0 & 4095;
#pragma unroll
            for (int i = 0; i < 4; ++i) { unsigned v[8];
#pragma unroll
                for (int tt = 0; tt < 8; ++tt) v[tt] = (unsigned)PBF[(size_t)(row0 + tt) * APAD + 1280 + i * 64 + lane];
                v4u w; w.x = v[0] | (v[1] << 16); w.y = v[2] | (v[3] << 16); w.z = v[4] | (v[5] << 16); w.w = v[6] | (v[7] << 16);
                *(GAS v4u*)(VT + ((size_t)b * 256 + i * 64 + lane) * SEQ + t0) = w; } } }
    SEAM(8);
    if (IN(9)) for (int rep = 0; rep < REP(9); ++rep) {
        for (int w = gw; w < 2048; w += NGW) { const int b = w >> 8, half = (w >> 7) & 1, p = w & 127;
#pragma unroll 1
            for (int rep = 0; rep < 2; ++rep) { const int qb = rep ? 255 - p : p, nk = qb + 1; idx_scores_task(QIB, KIB, WI, SC, b, qb, (half * nk) >> 1, ((half + 1) * nk) >> 1, lane); } }
        LAS float* scr = (LAS float*)(lds + wave * 4096);
        for (int w = gw; w < NS * 129; w += NGW) samp_scores_task(QIB, WI, KIB, cache_ik, page_table, SKEYS, scr, w / 129, w % 129, lane);
    }
    SEAM(9);
    if (IN(10)) for (int rep = 0; rep < REP(10); ++rep) { unsigned raw[64], x[64];
        int p = gw; if (p < 8 * 2048) select_load(raw, SC, (p >> 11) * 4096 + (p & 2047), lane);
        for (; p < 8 * 2048; p += NGW) { const int rA = (p >> 11) * 4096 + (p & 2047), rB = (p >> 11) * 4096 + 4095 - (p & 2047);
            select_keys(x, raw, rA, lane); select_load(raw, SC, rB, lane); select_run(x, BM, rA, lane);
            select_keys(x, raw, rB, lane); if (p + NGW < 8 * 2048) select_load(raw, SC, ((p + NGW) >> 11) * 4096 + ((p + NGW) & 2047), lane); select_run(x, BM, rB, lane); } }
    SEAM(10);
    if (IN(11)) for (int rep = 0; rep < REP(11); ++rep) {
        for (int b = bid; b < NS; b += G) samp_select_attend(SKEYS, QB, KB, V2B, cache_k, cache_v, page_table, OB, lds, b, tid);
        __syncthreads();
        { float mq = fabsf(att_qg[lane]), mkk = fabsf(att_kg[lane]);
#pragma unroll
          for (int o = 1; o < 64; o <<= 1) { mq = fmaxf(mq, __shfl_xor(mq, o)); mkk = fmaxf(mkk, __shfl_xor(mkk, o)); }
          const float nbound = -(QSCALE * 64.0f * mq * mkk);
          if (tid < 16) { LAS unsigned* mt = (LAS unsigned*)(lds + 3 * ATT_STAGE + 64); mt[2 * tid] = ((tid & 1) ? 0xFFFFu : 0u) | ((tid & 2) ? 0xFFFF0000u : 0u); mt[2 * tid + 1] = ((tid & 4) ? 0xFFFFu : 0u) | ((tid & 8) ? 0xFFFF0000u : 0u); }
          __syncthreads();
          unsigned* qa = QC + 6 * 512; const int home = (int)(xb_xcc_id() & 7u); LAS int* tkp = (LAS int*)(lds + 3 * ATT_STAGE);
#pragma unroll 1
          for (int k = 0; k < 8; ++k) { const int pi = (home + k) & 7; unsigned* qh = qa + pi * 64;
              int nxt = 0; if (tid == 0) nxt = (int)__hip_atomic_fetch_add(qh, 1u, __ATOMIC_RELAXED, __HIP_MEMORY_SCOPE_AGENT);
#pragma unroll 1
              for (;;) { if (tid == 0) *tkp = nxt; __syncthreads(); const int c = __builtin_amdgcn_readfirstlane(*tkp);
                  if (c >= 256) break;
                  const int bk = pi * 4 + (c & 3), qt = 63 - (c >> 2); attend_unit(QB, KB, VT, BM, OB, lds, bk >> 2, bk & 3, qt, nbound, tid, qh, nxt); }
              __syncthreads(); } }
        for (int r = NT + gw; r < MP; r += NGW) (void)p0_row(nullptr, nullptr, OB + (size_t)r * 1024, lane);
    }
    SEAM(11);
    if (IN(12)) for (int rep = 0; rep < REP(12); ++rep) { pg8::Gemm g{OB, WOUT1T, NP, 1024, 1024}; pg8::StaticOrder S; S.init(NP, 1024, G, bid); pg8::EpiResid<true> E{X2B, nullptr, X3B, SS3, NP, NT, rep == 0};
        pg8::gemm_phase<pg8::EpiResid<true>, pg8::StaticOrder, true, true>(lds, g, S, E);
        for (int tk = bid; tk < 1024 / 32; tk += G) { float v0, v1; thin_gemm_tile<1024>(OB + (size_t)NP * 1024, WOUT1T, tk * 32, (LAS float*)lds, tid, v0, v1);
            const int r = tid >> 4, row = NP + r, col = tk * 32 + 2 * (tid & 15); const unsigned xr = *(const GAS unsigned*)(X2B + (size_t)row * 1024 + col); v0 += bflo(xr); v1 += bfhi(xr);
            *(GAS unsigned*)(X3B + (size_t)row * 1024 + col) = pk2(v0, v1); const float sq = row16_sum(v0 * v0 + v1 * v1); if ((tid & 15) == 0 && rep == 0) pg8::ss_add(SS3 + row, sq); } }
    SEAM(12);
    if (IN(13)) for (int rep = 0; rep < REP(13); ++rep) { pg8::Gemm g{X3B, WP1T, NP, 2048, 1024};
        if (G == 256) {
            const EpiRoute ER{SS3, EIDX, GATE};
            { OneUnit S1; S1.init(NP, 2048, G, bid); S1.k = 0; pg8::gemm_phase<EpiRoute, OneUnit, false, true>(lds, g, S1, ER); }
            { OneUnit S1; S1.init(NP, 2048, G, bid); S1.k = 1; pg8::gemm_phase<EpiRoute, OneUnit, false, true>(lds, g, S1, ER); }
            { OneUnit S1; S1.init(NP, 2048, G, bid); S1.k = 2; pg8::gemm_phase<EpiRoute, OneUnit, false, true>(lds, g, S1, ER); }
            { OneUnit S1; S1.init(NP, 2048, G, bid); S1.k = 3; pg8::gemm_phase<EpiRoute, OneUnit, false, true>(lds, g, S1, ER); }
        } else { pg8::StaticOrder S; S.init(NP, 2048, G, bid); pg8::EpiScaleF16 E{SH, 2048, SS3};
            pg8::gemm_phase<pg8::EpiScaleF16, pg8::StaticOrder, true, true>(lds, g, S, E); }
        for (int tk = bid; tk < 2048 / 32; tk += G) { float v0, v1; thin_gemm_tile<1024>(X3B + (size_t)NP * 1024, WP1T, tk * 32, (LAS float*)lds, tid, v0, v1);
            const int r = tid >> 4, row = NP + r, col = tk * 32 + 2 * (tid & 15); const float rs = rsqrtf(pg8::ss_get(SS3 + row) * (1.0f / 1024.0f) + EPS);
            *(GAS unsigned*)(SH + (size_t)row * 2048 + col) = pg8::EpiScaleF16::pkh(v0 * rs, v1 * rs); } }
    SEAM(13);
    if (IN(14)) for (int rep = 0; rep < REP(14); ++rep) { { RouteIn RA, RB; int task = gw + (G == 256 ? NP * 2 : 0); if (task < NT * 2) peer_route_load(RA, SH, task, lane);
          for (; task < NT * 2; task += 2 * NGW) {
              if (task + NGW < NT * 2) peer_route_load(RB, SH, task + NGW, lane);
              peer_route_task(RA, EIDX, GATE, task, lane);
              if (task + NGW >= NT * 2) break;
              if (task + 2 * NGW < NT * 2) peer_route_load(RA, SH, task + 2 * NGW, lane);
              peer_route_task(RB, EIDX, GATE, task + NGW, lane); } }
        { XqIn QA, QB2; int tok = gw; if (tok < NT) peer_xq_load(QA, X3B, SS3, tok, lane);
          for (; tok < NT; tok += 2 * NGW) {
              if (tok + NGW < NT) peer_xq_load(QB2, X3B, SS3, tok + NGW, lane);
              peer_xq_token(QA, XQ, RSX, tok, lane);
              if (tok + NGW >= NT) break;
              if (tok + 2 * NGW < NT) peer_xq_load(QA, X3B, SS3, tok + 2 * NGW, lane);
              peer_xq_token(QB2, XQ, RSX, tok + NGW, lane); } } }
    SEAM(14);
    if (IN(15)) {
        LAS unsigned* lst = (LAS unsigned*)(lds + wave * 9216);
        PEER_QLOOP_CHUNK(QC + 2 * 512, peer_e1_chunk(XQ, RSX, EIDX, GATE, U8 + (size_t)16384 * 1024, SU + 16384, SV + 16384, ACT, lst, t0, t1, pi, lane));
        xcd_barrier(bar);
        PEER_QLOOP_CHUNK(QC + 3 * 512, peer_e2_chunk<false>(X3B, EIDX, ACT, V8 + (size_t)16384 * 1024, out + O_Y, nullptr, nullptr, t0, t1, pi, lane)); }
#undef IN
#undef SEAM
}
constexpr int N_PHASES = 16;
}


extern "C" void kernel_launch(void* const* d_in, const int* in_sizes, int n_in, void* d_out, int out_size, void* d_ws, size_t ws_size, hipStream_t stream) {
    using namespace mk;
    static int grid = 0;
    if (grid == 0) {
        int dev = 0, cus = 0;
        if (hipGetDevice(&dev) != hipSuccess || hipDeviceGetAttribute(&cus, hipDeviceAttributeMultiprocessorCount, dev) != hipSuccess) { fprintf(stderr, "kernel_launch: device query failed\n"); grid = -1; return; }
        if (hipFuncSetAttribute((const void*)fused_fwd, hipFuncAttributeMaxDynamicSharedMemorySize, LDS_BYTES) != hipSuccess) { fprintf(stderr, "kernel_launch: hipFuncSetAttribute failed\n"); grid = -1; return; }
        int per_cu = 0;
        if (hipOccupancyMaxActiveBlocksPerMultiprocessor(&per_cu, (const void*)fused_fwd, NTHR, LDS_BYTES) != hipSuccess || per_cu < 1) fprintf(stderr, "kernel_launch: occupancy query says %d\n", per_cu);
        (void)hipGetLastError();
        grid = cus;
        if (ws_size < W_END) { fprintf(stderr, "kernel_launch: workspace too small (%zu < %zu)\n", ws_size, (size_t)W_END); grid = -1; return; }
    }
    if (grid < 0) return;
    (void)hipMemsetAsync(d_ws, 0, CTL_BYTES, stream);
    Params p{};
    for (int i = 0; i < 23; ++i) p.in[i] = (const float*)d_in[i];
    p.out = (float*)d_out; p.ws = (unsigned char*)d_ws;
    for (int i = 0; i < 32; ++i) p.inv[i] = (float)exp(-log(10000.0) * (double)i / 32.0);
    p.ph_lo = 0; p.ph_hi = N_PHASES;
    hipLaunchKernelGGL(fused_fwd, dim3(grid), dim3(NTHR), LDS_BYTES, stream, p);
}
```

```cpp
#include <hip/hip_runtime.h>
#include <cstdio>
#include <cstdint>
#include <math.h>
namespace pg8 {
#define PG8_LAS __attribute__((address_space(3)))
typedef unsigned short bf16_t;
typedef short bf16x8 __attribute__((ext_vector_type(8)));
typedef float f32x4 __attribute__((ext_vector_type(4)));
typedef unsigned u32x4 __attribute__((ext_vector_type(4)));
constexpr int BM = 256, BK = 64, HALF = 128, HTB = HALF * BK * 2  , STAGE_BYTES = 8 * HTB, NXCD = 8, WGM = 8;

__host__ __device__ __forceinline__ int lds_byte(int r, int c) { const int st = (r >> 4) * 2 + (c >> 5), rr = r & 15, cc = c & 31, ob = rr * 64 + cc * 2; return st * 1024 + (ob ^ (((ob >> 9) & 1) << 5)); }
__host__ __device__ __forceinline__ void stage_rc(int b, int& R, int& C) { const int st = b / 1024, sb = b % 1024, swz = sb ^ (((sb >> 9) & 1) << 5); R = (st >> 1) * 16 + swz / 64; C = (st & 1) * 32 + (swz % 64) / 2; }
__host__ __device__ __forceinline__ int perm32(int rho) { const int n = rho >> 4, i = rho & 15; return 8 * (i >> 2) + 4 * n + (i & 3); }

struct Unit { int pm, pn; };
struct Gemm { const bf16_t* A; const bf16_t* Bt; int M, N, K; };

struct StaticOrder {
    int nM, nN, nwg, G, c;
    __host__ __device__ void init(int M, int N, int G_, int c_) { nM = M / BM; nN = N / BM; nwg = nM * nN; G = G_; c = c_; }
    __host__ __device__ bool next(int i, Unit& u) const {
        const long L = (long)i * G + c; if (L >= nwg) return false;
        int wgid = (int)L; { const int q = nwg / NXCD, r = nwg % NXCD, xcd = wgid % NXCD, off = wgid / NXCD; wgid = (xcd < r ? xcd * (q + 1) : r * (q + 1) + (xcd - r) * q) + off; }
        const int nig = WGM * nN, gid = wgid / nig, fm = gid * WGM, gsz = (nM - fm) < WGM ? (nM - fm) : WGM;
        u.pm = fm + ((wgid % nig) % gsz); u.pn = (wgid % nig) / gsz; return true;
    }
    __device__ __forceinline__ void a_ready(const Unit&) const {}
    __device__ __forceinline__ void done(const Unit&) const {}
};

__device__ __forceinline__ unsigned cvt_pk_bf16(float lo, float hi) { unsigned r; asm volatile("v_cvt_pk_bf16_f32 %0, %1, %2" : "=v"(r) : "v"(lo), "v"(hi)); return r; }
typedef float f32x2 __attribute__((ext_vector_type(2)));

__device__ __forceinline__ void ss_add(unsigned long long* p, float sq) { (void)__hip_atomic_fetch_add(p, (unsigned long long)(sq * 16777216.0f), __ATOMIC_RELAXED, __HIP_MEMORY_SCOPE_AGENT); }
__device__ __forceinline__ float ss_get(const unsigned long long* p) { return (float)*p * (1.0f / 16777216.0f); }
struct EpiUV { static constexpr bool PERM = true, AFTER_DRAIN = false;
    bf16_t* U; bf16_t* V; const float* ss0; unsigned long long* ssv; int do_at;
    __device__ __forceinline__ void operator()(const f32x4 (&acc)[2][2][4][2], const Unit& u, int wr, int wc, int fr, int fq) const {
        const int row0 = u.pm * BM + wr * 64 + fr; const bool isv = u.pn >= 8; bf16_t* base = isv ? V : U;
        const int col0 = (u.pn & 7) * BM + wc * 32 + 8 * fq;
#pragma unroll
        for (int ai = 0; ai < 2; ++ai)
#pragma unroll
            for (int m = 0; m < 4; ++m) { const int row = row0 + ai * HALF + m * 16; const float rs = rsqrtf(ss0[row] * (1.0f / 1024.0f) + 1e-6f); float sq = 0.f;
                bf16_t* rowp = base + (size_t)row * 2048 + col0;
#pragma unroll
                for (int bj = 0; bj < 2; ++bj) { const f32x4 v0 = acc[ai][bj][m][0] * rs, v1 = acc[ai][bj][m][1] * rs;
                    sq += (v0[0] * v0[0] + v0[1] * v0[1]) + (v0[2] * v0[2] + v0[3] * v0[3]) + (v1[0] * v1[0] + v1[1] * v1[1]) + (v1[2] * v1[2] + v1[3] * v1[3]);
                    u32x4 w; w.x = cvt_pk_bf16(v0[0], v0[1]); w.y = cvt_pk_bf16(v0[2], v0[3]); w.z = cvt_pk_bf16(v1[0], v1[1]); w.w = cvt_pk_bf16(v1[2], v1[3]);
                    *(u32x4*)(rowp + bj * HALF) = w; }
                if (isv) { sq += __shfl_xor(sq, 16); sq += __shfl_xor(sq, 32); if (fq == 0 && do_at) ss_add(ssv + row, sq); } }
    }
};
template <bool RB16> struct EpiResid { static constexpr bool PERM = true, AFTER_DRAIN = false;
    const void* R0; const void* R1; bf16_t* Xb; unsigned long long* ssout; int np, nt, do_at;
    __device__ __forceinline__ void operator()(const f32x4 (&acc)[2][2][4][2], const Unit& u, int wr, int wc, int fr, int fq) const {
        const int row0 = u.pm * BM + wr * 64 + fr, col0 = u.pn * BM + wc * 32 + 8 * fq;
#pragma unroll
        for (int ai = 0; ai < 2; ++ai)
#pragma unroll
            for (int m = 0; m < 4; ++m) { const int row = row0 + ai * HALF + m * 16; float sq = 0.f;
#pragma unroll
                for (int bj = 0; bj < 2; ++bj) { f32x4 r0 = (f32x4){0.f, 0.f, 0.f, 0.f}, r1 = r0;
                    if constexpr (RB16) { if (row < nt) { const u32x4 rw = *(const u32x4*)((const bf16_t*)R0 + (size_t)row * 1024 + col0 + bj * HALF);
                            r0 = (f32x4){__uint_as_float(rw.x << 16), __uint_as_float(rw.x & 0xffff0000u), __uint_as_float(rw.y << 16), __uint_as_float(rw.y & 0xffff0000u)};
                            r1 = (f32x4){__uint_as_float(rw.z << 16), __uint_as_float(rw.z & 0xffff0000u), __uint_as_float(rw.w << 16), __uint_as_float(rw.w & 0xffff0000u)}; } }
                    else { const float* rp = row < np ? (const float*)R0 + (size_t)row * 1024 : (row < nt ? (const float*)R1 + (size_t)(row - np) * 1024 : nullptr);
                        if (rp) { r0 = *(const f32x4*)(rp + col0 + bj * HALF); r1 = *(const f32x4*)(rp + col0 + bj * HALF + 4); } }
                    const f32x4 v0 = acc[ai][bj][m][0] + r0, v1 = acc[ai][bj][m][1] + r1;
                    sq += (v0[0] * v0[0] + v0[1] * v0[1]) + (v0[2] * v0[2] + v0[3] * v0[3]) + (v1[0] * v1[0] + v1[1] * v1[1]) + (v1[2] * v1[2] + v1[3] * v1[3]);
                    u32x4 w; w.x = cvt_pk_bf16(v0[0], v0[1]); w.y = cvt_pk_bf16(v0[2], v0[3]); w.z = cvt_pk_bf16(v1[0], v1[1]); w.w = cvt_pk_bf16(v1[2], v1[3]);
                    *(u32x4*)(Xb + (size_t)row * 1024 + col0 + bj * HALF) = w; }
                sq += __shfl_xor(sq, 16); sq += __shfl_xor(sq, 32); if (fq == 0 && do_at) ss_add(ssout + row, sq); }
    }
};
struct EpiScaleF32 { static constexpr bool PERM = false, AFTER_DRAIN = false;
    float* C; int ldc; const float* ss; int nparts; int pstride;
    __device__ __forceinline__ void operator()(const f32x4 (&acc)[2][2][4][2], const Unit& u, int wr, int wc, int fr, int fq) const {
        const int row0 = u.pm * BM + wr * 64 + fr, col0 = u.pn * BM + wc * 32 + 4 * fq;
#pragma unroll
        for (int ai = 0; ai < 2; ++ai)
#pragma unroll
            for (int m = 0; m < 4; ++m) { const int row = row0 + ai * HALF + m * 16; float sa = ss[row]; for (int pp = 1; pp < nparts; ++pp) sa += ss[(size_t)pp * pstride + row];
                const float rs = rsqrtf(sa * (1.0f / 1024.0f) + 1e-6f);
                float* rowp = C + (size_t)row * ldc + col0;
#pragma unroll
                for (int bj = 0; bj < 2; ++bj)
#pragma unroll
                    for (int n = 0; n < 2; ++n) *(f32x4*)(rowp + bj * HALF + n * 16) = acc[ai][bj][m][n] * rs; }
    }
};
struct EpiScaleBf16 { static constexpr bool PERM = true, AFTER_DRAIN = false;
    bf16_t* O; int ldc; const float* ss; int nparts; int pstride;
    __device__ __forceinline__ void operator()(const f32x4 (&acc)[2][2][4][2], const Unit& u, int wr, int wc, int fr, int fq) const {
        const int row0 = u.pm * BM + wr * 64 + fr, col0 = u.pn * BM + wc * 32 + 8 * fq;
#pragma unroll
        for (int ai = 0; ai < 2; ++ai)
#pragma unroll
            for (int m = 0; m < 4; ++m) { const int row = row0 + ai * HALF + m * 16; float sa = ss[row]; for (int pp = 1; pp < nparts; ++pp) sa += ss[(size_t)pp * pstride + row];
                const float rs = rsqrtf(sa * (1.0f / 1024.0f) + 1e-6f);
                bf16_t* rowp = O + (size_t)row * ldc + col0;
#pragma unroll
                for (int bj = 0; bj < 2; ++bj) { const f32x4 v0 = acc[ai][bj][m][0] * rs, v1 = acc[ai][bj][m][1] * rs;
                    u32x4 w; w.x = cvt_pk_bf16(v0[0], v0[1]); w.y = cvt_pk_bf16(v0[2], v0[3]); w.z = cvt_pk_bf16(v1[0], v1[1]); w.w = cvt_pk_bf16(v1[2], v1[3]);
                    *(u32x4*)(rowp + bj * HALF) = w; } }
    }
};
struct EpiScaleF16 { static constexpr bool PERM = true, AFTER_DRAIN = false;
    unsigned short* O; int ldc; const unsigned long long* ss;
    __device__ __forceinline__ static unsigned pkh(float a, float b) { typedef _Float16 h2 __attribute__((ext_vector_type(2))); h2 h; h[0] = (_Float16)a; h[1] = (_Float16)b; return __builtin_bit_cast(unsigned, h); }
    __device__ __forceinline__ void operator()(const f32x4 (&acc)[2][2][4][2], const Unit& u, int wr, int wc, int fr, int fq) const {
        const int row0 = u.pm * BM + wr * 64 + fr, col0 = u.pn * BM + wc * 32 + 8 * fq;
#pragma unroll
        for (int ai = 0; ai < 2; ++ai)
#pragma unroll
            for (int m = 0; m < 4; ++m) { const int row = row0 + ai * HALF + m * 16; const float rs = rsqrtf(ss_get(ss + row) * (1.0f / 1024.0f) + 1e-6f);
                unsigned short* rowp = O + (size_t)row * ldc + col0;
#pragma unroll
                for (int bj = 0; bj < 2; ++bj) { const f32x4 v0 = acc[ai][bj][m][0] * rs, v1 = acc[ai][bj][m][1] * rs;
                    u32x4 w; w.x = pkh(v0[0], v0[1]); w.y = pkh(v0[2], v0[3]); w.z = pkh(v1[0], v1[1]); w.w = pkh(v1[2], v1[3]);
                    *(u32x4*)(rowp + bj * HALF) = w; } }
    }
};
template <class Epi, class Sched, bool ALIGN_EPI = false, bool SP2 = false>
__device__ __forceinline__ void gemm_phase(PG8_LAS unsigned char* lds, const Gemm g, const Sched& S, const Epi& E) {
    const int tid = threadIdx.x, wid = __builtin_amdgcn_readfirstlane(tid >> 6), lane = tid & 63, wr = wid >> 2, wc = wid & 3, fr = lane & 15, fq = lane >> 4;
    const int K = g.K, nt = K / BK;
    unsigned voffA[2], voffB[2];
#pragma unroll
    for (int i = 0; i < 2; ++i) { int R, C; stage_rc(tid * 16 + i * 8192, R, C); const int Rb = Epi::PERM ? ((R & ~31) + perm32(R & 31)) : R;
        voffA[i] = (unsigned)(R * K + C) * 2u; voffB[i] = (unsigned)(Rb * K + C) * 2u; }
    const size_t kstep = (size_t)(BK * 2);
    const size_t hstep = (size_t)HALF * K * 2;
    const size_t tstep = 2 * hstep;
    const unsigned ldsw = (unsigned)wid * 1024u;
    const int aoff = lds_byte(wr * 64 + fr, fq * 8), boff = lds_byte(wc * 32 + fr, fq * 8);
#define PG8_SA(b, h) (((b) * 2 + (h)) * HTB)
#define PG8_SB(b, h) ((4 + (b) * 2 + (h)) * HTB)
#define PG8_STAGE(bufoff, gbase, voff) do { _Pragma("unroll") for (int _i = 0; _i < 2; ++_i) \
        __builtin_amdgcn_global_load_lds((const unsigned*)((const char*)(gbase) + (voff)[_i]), (PG8_LAS unsigned*)(lds + (bufoff) + ldsw + _i * 8192), 16, 0, 0); } while (0)
#define PG8_LDA(dst, b, h) do { _Pragma("unroll") for (int m = 0; m < 4; ++m) _Pragma("unroll") for (int k = 0; k < 2; ++k) dst[m][k] = *(const PG8_LAS bf16x8*)(lds + PG8_SA(b, h) + aoff + m * 2048 + k * 1024); } while (0)
#define PG8_LDB(dst, b, h) do { _Pragma("unroll") for (int n = 0; n < 2; ++n) _Pragma("unroll") for (int k = 0; k < 2; ++k) dst[n][k] = *(const PG8_LAS bf16x8*)(lds + PG8_SB(b, h) + boff + n * 2048 + k * 1024); } while (0)
#define PG8_MMA(ai, bj, At, Bt) do { __builtin_amdgcn_s_setprio(1); _Pragma("unroll") for (int m = 0; m < 4; ++m) _Pragma("unroll") for (int n = 0; n < 2; ++n) _Pragma("unroll") for (int k = 0; k < 2; ++k) \
        acc[ai][bj][m][n] = __builtin_amdgcn_mfma_f32_16x16x32_bf16(Bt[n][k], At[m][k], acc[ai][bj][m][n], 0, 0, 0); __builtin_amdgcn_s_setprio(0); } while (0)
#define PG8_WAIT_V(n) asm volatile("s_waitcnt vmcnt(" #n ")" ::: "memory")
#define PG8_WAIT_L(n) asm volatile("s_waitcnt lgkmcnt(" #n ")" ::: "memory")
#define PG8_BAR __builtin_amdgcn_s_barrier()
#define PG8_SCHED __builtin_amdgcn_sched_barrier(0)
    Unit cur, nxt; int ui = 0;
    if (!S.next(0, cur)) return;
    f32x4 acc[2][2][4][2];
#pragma unroll
    for (int a = 0; a < 2; ++a)
#pragma unroll
        for (int b = 0; b < 2; ++b)
#pragma unroll
            for (int m = 0; m < 4; ++m)
#pragma unroll
                for (int n = 0; n < 2; ++n) acc[a][b][m][n] = (f32x4){0.f, 0.f, 0.f, 0.f};
    bf16x8 At[4][2], B0[2][2], B1[2][2];
    const char* cA = (const char*)g.A + (size_t)cur.pm * tstep; const char* cB = (const char*)g.Bt + (size_t)cur.pn * tstep;
    S.a_ready(cur);
    if constexpr (SP2) {
        PG8_STAGE(PG8_SB(0, 0), cB, voffB); PG8_STAGE(PG8_SB(0, 1), cB + hstep, voffB); PG8_STAGE(PG8_SA(0, 0), cA, voffA); PG8_STAGE(PG8_SA(0, 1), cA + hstep, voffA);
        if (wr == 1) PG8_BAR;
        PG8_WAIT_V(2); PG8_BAR;
        PG8_STAGE(PG8_SB(1, 0), cB + kstep, voffB); PG8_STAGE(PG8_SA(1, 0), cA + kstep, voffA); PG8_STAGE(PG8_SB(1, 1), cB + hstep + kstep, voffB);
        PG8_WAIT_V(6); PG8_BAR;
    } else {
        PG8_STAGE(PG8_SB(0, 0), cB, voffB); PG8_STAGE(PG8_SA(0, 0), cA, voffA); PG8_STAGE(PG8_SB(0, 1), cB + hstep, voffB); PG8_STAGE(PG8_SA(0, 1), cA + hstep, voffA);
        if (wr == 1) PG8_BAR;
        PG8_WAIT_V(4); PG8_BAR;
        PG8_STAGE(PG8_SB(1, 0), cB + kstep, voffB); PG8_STAGE(PG8_SA(1, 0), cA + kstep, voffA); PG8_STAGE(PG8_SB(1, 1), cB + hstep + kstep, voffB);
        PG8_WAIT_V(6); PG8_BAR;
    }
    for (;;) {
        const bool has_next = S.next(ui + 1, nxt);
        const char* nA = has_next ? (const char*)g.A + (size_t)nxt.pm * tstep : cA; const char* nB = has_next ? (const char*)g.Bt + (size_t)nxt.pn * tstep : cB;
        for (int t = 0; t < nt; t += 2) {
            const bool last = (t == nt - 2);
            const char* a1 = cA + (size_t)(t + 1) * kstep;
            const char* a2 = last ? nA : cA + (size_t)(t + 2) * kstep; const char* b2 = last ? nB : cB + (size_t)(t + 2) * kstep;
            const char* a3 = a2 + kstep; const char* b3 = b2 + kstep;
            if (last && has_next) S.a_ready(nxt);
            if constexpr (SP2) {
            PG8_LDB(B0, 0, 0); PG8_LDB(B1, 0, 1); PG8_SCHED; PG8_LDA(At, 0, 0); PG8_STAGE(PG8_SA(1, 1), a1 + hstep, voffA);
            PG8_WAIT_V(8); PG8_WAIT_L(0); PG8_BAR; PG8_MMA(0, 0, At, B0); PG8_MMA(0, 1, At, B1); PG8_BAR; PG8_SCHED;
            PG8_LDA(At, 0, 1); PG8_STAGE(PG8_SB(0, 0), b2, voffB); PG8_STAGE(PG8_SB(0, 1), b2 + hstep, voffB); PG8_STAGE(PG8_SA(0, 0), a2, voffA);
            PG8_WAIT_V(8); PG8_WAIT_L(0); PG8_BAR; PG8_MMA(1, 0, At, B0); PG8_MMA(1, 1, At, B1); PG8_BAR; PG8_SCHED;
            PG8_LDB(B0, 1, 0); PG8_LDB(B1, 1, 1); PG8_SCHED; PG8_LDA(At, 1, 0); PG8_STAGE(PG8_SA(0, 1), a2 + hstep, voffA);
            PG8_WAIT_V(8); PG8_WAIT_L(0); PG8_BAR; PG8_MMA(0, 0, At, B0); PG8_MMA(0, 1, At, B1); PG8_BAR; PG8_SCHED;
            PG8_LDA(At, 1, 1); PG8_STAGE(PG8_SB(1, 0), b3, voffB); PG8_STAGE(PG8_SB(1, 1), b3 + hstep, voffB); PG8_STAGE(PG8_SA(1, 0), a3, voffA);
            PG8_WAIT_V(8); PG8_WAIT_L(0); PG8_BAR; PG8_MMA(1, 0, At, B0); PG8_MMA(1, 1, At, B1); PG8_BAR; PG8_SCHED;
            } else {
            PG8_LDB(B0, 0, 0); PG8_SCHED; PG8_LDA(At, 0, 0); PG8_STAGE(PG8_SA(1, 1), a1 + hstep, voffA);
            PG8_WAIT_L(8); PG8_BAR; PG8_WAIT_L(0); PG8_MMA(0, 0, At, B0); PG8_BAR; PG8_SCHED;
            PG8_LDB(B1, 0, 1); PG8_STAGE(PG8_SB(0, 0), b2, voffB);
            PG8_BAR; PG8_WAIT_L(0); PG8_MMA(0, 1, At, B1); PG8_BAR;
            PG8_LDA(At, 0, 1); PG8_STAGE(PG8_SA(0, 0), a2, voffA);
            PG8_BAR; PG8_WAIT_L(0); PG8_MMA(1, 0, At, B0); PG8_BAR; PG8_SCHED;
            PG8_STAGE(PG8_SB(0, 1), b2 + hstep, voffB);
            PG8_WAIT_V(6); PG8_BAR; PG8_MMA(1, 1, At, B1); PG8_BAR;
            PG8_LDB(B0, 1, 0); PG8_SCHED; PG8_LDA(At, 1, 0); PG8_STAGE(PG8_SA(0, 1), a2 + hstep, voffA);
            PG8_WAIT_L(8); PG8_BAR; PG8_WAIT_L(0); PG8_MMA(0, 0, At, B0); PG8_BAR; PG8_SCHED;
            PG8_LDB(B1, 1, 1); PG8_STAGE(PG8_SB(1, 0), b3, voffB);
            PG8_BAR; PG8_WAIT_L(0); PG8_MMA(0, 1, At, B1); PG8_BAR;
            PG8_LDA(At, 1, 1); PG8_STAGE(PG8_SA(1, 0), a3, voffA);
            PG8_BAR; PG8_WAIT_L(0); PG8_MMA(1, 0, At, B0); PG8_BAR; PG8_SCHED;
            PG8_STAGE(PG8_SB(1, 1), b3 + hstep, voffB);
            PG8_WAIT_V(6); PG8_BAR; PG8_MMA(1, 1, At, B1); PG8_BAR;
            }
        }
        if constexpr (ALIGN_EPI) { if (wr == 0) PG8_BAR; }
        if constexpr (!Epi::AFTER_DRAIN) { E(acc, cur, wr, wc, fr, fq); S.done(cur); }
        if (!has_next) break;
#pragma unroll
        for (int a = 0; a < 2; ++a)
#pragma unroll
            for (int b = 0; b < 2; ++b)
#pragma unroll
                for (int m = 0; m < 4; ++m)
#pragma unroll
                    for (int n = 0; n < 2; ++n) acc[a][b][m][n] = (f32x4){0.f, 0.f, 0.f, 0.f};
        cur = nxt; cA = nA; cB = nB; ++ui;
        if constexpr (ALIGN_EPI) { if (wr == 1) PG8_BAR; }
    }
    PG8_WAIT_V(0);
    if constexpr (!ALIGN_EPI) { if (wr == 0) PG8_BAR; }
    PG8_BAR;
    if constexpr (Epi::AFTER_DRAIN) { E.fused(acc, cur, wr, wc, fr, fq, lds, wid, lane); S.done(cur); }
#undef PG8_SA
#undef PG8_SB
#undef PG8_STAGE
#undef PG8_LDA
#undef PG8_LDB
#undef PG8_MMA
#undef PG8_WAIT_V
#undef PG8_WAIT_L
#undef PG8_BAR
#undef PG8_SCHED
}

}

#define GAS __attribute__((address_space(1)))
#define LAS __attribute__((address_space(3)))
typedef unsigned short bf16;
typedef unsigned v4u __attribute__((ext_vector_type(4)));
typedef unsigned v2u __attribute__((ext_vector_type(2)));
typedef float f32x4 __attribute__((ext_vector_type(4)));
typedef float f32x2 __attribute__((ext_vector_type(2)));
typedef float f32x16 __attribute__((ext_vector_type(16)));
typedef short bf16x8 __attribute__((ext_vector_type(8)));
typedef __bf16 bf16x2_t __attribute__((ext_vector_type(2)));
typedef GAS unsigned gu32;
typedef GAS unsigned long long gu64;
#define RLX_AGENT __ATOMIC_RELAXED, __HIP_MEMORY_SCOPE_AGENT
#define LDS_WAIT() asm volatile("s_waitcnt lgkmcnt(0)" ::: "memory")
#define VM_WAIT() asm volatile("s_waitcnt vmcnt(0)" ::: "memory")
__device__ __forceinline__ unsigned long long rt() { return __builtin_amdgcn_s_memrealtime(); }
__device__ __forceinline__ unsigned f2bf(float f) { unsigned u = __builtin_bit_cast(unsigned, f); return (u + 0x7fffu + ((u >> 16) & 1u)) >> 16; }
__device__ __forceinline__ unsigned pk2(float lo, float hi) { return f2bf(lo) | (f2bf(hi) << 16); }

#define XB_TMO      128
#define XB_XCNT(j)  (256  + 64 * (j))
#define XB_XSUB(j)  (1280 + 64 * (j))
#define XB_XGEN(j)  (2304 + 64 * (j))
#define XB_TOP      3328
#define XB_TOPGEN   3392
#define XCD_BAR_WORDS 3456
#define XB_SPIN_CAP (1u << 18)

__device__ __forceinline__ unsigned xb_ld(unsigned* p)              { return __hip_atomic_load(p, __ATOMIC_RELAXED, __HIP_MEMORY_SCOPE_AGENT); }
__device__ __forceinline__ unsigned xb_add(unsigned* p, unsigned v) { return __hip_atomic_fetch_add(p, v, __ATOMIC_RELAXED, __HIP_MEMORY_SCOPE_AGENT); }
__device__ __forceinline__ unsigned xb_xcc_id() { return (unsigned)__builtin_amdgcn_s_getreg((3 << 11) | 20) & 0xFu; }
#define XB_SPIN(cond, bar) do { unsigned _sp = 0; while (cond) { __builtin_amdgcn_s_sleep(1); \
    if ((++_sp & 255u) == 0u) { if (xb_ld(&(bar)[XB_TMO])) break; if (_sp > XB_SPIN_CAP) { atomicAdd(&(bar)[XB_TMO], 1u); break; } } } } while (0)

struct XcdBarrier {
    unsigned* bar; unsigned x;
    volatile LAS unsigned* st;
};

__device__ __forceinline__ XcdBarrier xcd_barrier_post(unsigned* bar, volatile LAS unsigned* st) {
    XcdBarrier b; b.bar = bar; b.x = xb_xcc_id(); b.st = st;
    if (threadIdx.x == 0) (void)xb_add(&bar[XB_XCNT(b.x)], 1u);
    return b;
}
__device__ __forceinline__ void xcd_barrier_complete(unsigned* bar, unsigned x, unsigned& nloc, unsigned& nx) {
    const unsigned G = gridDim.x * gridDim.y * gridDim.z;
    unsigned sum, cnt, mine, sp = 0u;
    for (;;) {
        sum = 0u; cnt = 0u; mine = 0u;
#pragma unroll
        for (unsigned j = 0; j < 16; ++j) { const unsigned c = xb_ld(&bar[XB_XCNT(j)]); sum += c; cnt += (c > 0u) ? 1u : 0u; mine = (j == x) ? c : mine; }
        if (sum == G) break;
        __builtin_amdgcn_s_sleep(1);
        if ((++sp & 255u) == 0u) { if (xb_ld(&bar[XB_TMO])) break; if (sp > XB_SPIN_CAP) { atomicAdd(&bar[XB_TMO], 1u); break; } }
    }
    nloc = mine > 0u ? mine : 1u; nx = cnt > 0u ? cnt : 1u;
}

__device__ __forceinline__ void xcd_barrier(const XcdBarrier& b) {
    asm volatile("s_waitcnt vmcnt(0)" ::: "memory");
    __syncthreads();
    if (threadIdx.x == 0) {
        unsigned* bar = b.bar;
        __builtin_amdgcn_s_waitcnt(0);
        unsigned nloc = b.st[0], nx = b.st[1];
        if (nloc == 0u) { xcd_barrier_complete(bar, b.x, nloc, nx); b.st[0] = nloc; b.st[1] = nx; }
        const unsigned old = xb_add(&bar[XB_XSUB(b.x)], 1u);
        const unsigned gen = old / nloc;
        if (old + 1u == (gen + 1u) * nloc) {
            __builtin_amdgcn_fence(__ATOMIC_RELEASE, "agent");
            asm volatile("s_waitcnt vmcnt(0)" ::: "memory");
            const unsigned og = xb_add(&bar[XB_TOP], 1u);
            const unsigned tg = og / nx;
            if (og + 1u == (tg + 1u) * nx) xb_add(&bar[XB_TOPGEN], 1u);
            else XB_SPIN(xb_ld(&bar[XB_TOPGEN]) == tg, bar);
            __builtin_amdgcn_fence(__ATOMIC_ACQUIRE, "agent");
            xb_add(&bar[XB_XGEN(b.x)], 1u);
            asm volatile("s_waitcnt vmcnt(0)" ::: "memory");
        } else {
            XB_SPIN(xb_ld(&bar[XB_XGEN(b.x)]) == gen, bar);
            __builtin_amdgcn_fence(__ATOMIC_ACQUIRE, "agent");
            asm volatile("s_waitcnt vmcnt(0)" ::: "memory");
        }
    }

    __syncthreads();
}

namespace mk {
constexpr int D = 1024, NP = 32768, NS = 32, NT = NP + NS, MP = 33024, SEQ = 4096;
constexpr int PAST = 16384, NPAGE = 128, APROJ = 2120, APAD = 2304;
constexpr int NWAVES = 8, NTHR = 512;
constexpr float EPS = 1e-6f;
constexpr float IDX_SCALE = 0.04419417382415922f;
constexpr float QSCALE = 0.125f * 1.4426950408889634f;
constexpr size_t O_Y = 0, O_KP = 33587200, O_VP = 41975808, O_IP = 50364416, O_KS = 52461568, O_VS = 52469760, O_IS = 52477952, O_CV = 52480000;
constexpr size_t A256(size_t x) { return (x + 255) & ~(size_t)255; }
constexpr size_t CTL_BYTES = 2u << 20;
constexpr int CW_BAR = 4096;
constexpr size_t W_SSV = 256u << 10, W_SS1 = 576u << 10, W_SS3 = 896u << 10, W_QC = 64u << 10;
constexpr size_t W_SS0 = CTL_BYTES;
constexpr size_t W_SS2 = W_SS0 + A256((size_t)MP * 4);
constexpr size_t W_X0B = W_SS2 + A256((size_t)8 * MP * 4);
constexpr size_t W_WIN0T = W_X0B + A256((size_t)MP * 1024 * 2);
constexpr size_t W_WOUT0T = W_WIN0T + A256((size_t)4096 * 1024 * 2);
constexpr size_t W_WP0T = W_WOUT0T + A256((size_t)1024 * 2048 * 2);
constexpr size_t W_WP1T = W_WP0T + A256((size_t)2048 * 1024 * 2);
constexpr size_t W_WIN1T = W_WP1T + A256((size_t)2048 * 1024 * 2);
constexpr size_t W_WOUT1T = W_WIN1T + A256((size_t)APAD * 1024 * 2);
constexpr size_t W_WSMT = W_WOUT1T + A256((size_t)1024 * 1024 * 2);
constexpr size_t W_ROPE = W_WSMT + A256((size_t)8 * 128 * 128 * 4);
constexpr size_t W_UB = W_ROPE + A256((size_t)4097 * 64 * 4);
constexpr size_t W_VB = W_UB + A256((size_t)2 * 16384 * 1024 * 2);
constexpr size_t W_SU = W_VB + A256((size_t)2 * 16384 * 1024 * 2);
constexpr size_t W_SV = W_SU + A256((size_t)2 * 16384 * 4);
constexpr size_t W_X1B = W_SV + A256((size_t)2 * 16384 * 4);
constexpr size_t W_X2B = W_X1B + A256((size_t)MP * 1024 * 2);
constexpr size_t W_X3B = W_X2B + A256((size_t)MP * 1024 * 2);
constexpr size_t W_X1 = W_X3B + A256((size_t)MP * 1024 * 2);
constexpr size_t W_X2 = W_X1 + A256((size_t)MP * 1024 * 4);
constexpr size_t W_X3 = W_X2 + A256((size_t)MP * 1024 * 4);
constexpr size_t W_BIG = W_X3 + A256((size_t)MP * 1024 * 4);
constexpr size_t BIG_BYTES = (size_t)NP * 4096 * 4;
constexpr size_t W_U0 = W_BIG, W_V0 = W_U0 + A256((size_t)MP * 2048 * 2), W_G0 = W_V0 + A256((size_t)MP * 2048 * 2);
static_assert(W_G0 + (size_t)MP * 2048 * 2 <= W_BIG + BIG_BYTES, "union");
static_assert((size_t)MP * APAD * 4 <= BIG_BYTES, "union");
constexpr size_t W_EIDX = W_BIG + A256(BIG_BYTES);
constexpr size_t W_GATE = W_EIDX + A256((size_t)MP * 128 * 4);
constexpr size_t W_QB = W_GATE + A256((size_t)MP * 128 * 4);
constexpr size_t W_KB = W_QB + A256((size_t)MP * 1024 * 2);
constexpr size_t W_V2B = W_KB + A256((size_t)MP * 256 * 2);
constexpr size_t W_QIB = W_V2B + A256((size_t)MP * 256 * 2);
constexpr size_t W_KIB = W_QIB + A256((size_t)MP * 512 * 2);
constexpr size_t W_WI = W_KIB + A256((size_t)MP * 64 * 2);
constexpr size_t W_SEL = W_WI + A256((size_t)MP * 8 * 4);
constexpr size_t W_SKEYS = W_SEL + A256((size_t)NP * 64 * 8);
constexpr size_t W_OB = W_SKEYS + A256((size_t)32 * 16640 * 4);
constexpr size_t W_VT = W_OB + A256((size_t)MP * 1024 * 2);
constexpr size_t W_XQ = W_VT + A256((size_t)NP * 256 * 2);
constexpr size_t W_RSX = W_XQ + A256((size_t)MP * 1024);
constexpr size_t W_ACT = W_RSX + A256((size_t)MP * 4);
constexpr size_t W_END = W_ACT + A256((size_t)MP * 128 * 4);
constexpr int RING_BYTES = 131072, MISC_OFF = RING_BYTES + 320, LDS_BYTES = 147456;

struct Params { const float* in[23]; float* out; unsigned char* ws; float inv[32]; int ph_lo, ph_hi; };

__device__ __forceinline__ float wave_sum(float v) {
#pragma unroll
    for (int o = 1; o < 64; o <<= 1) v += __shfl_xor(v, o);
    return v;
}
__device__ __forceinline__ float bflo(unsigned w) { return __uint_as_float(w << 16); }
__device__ __forceinline__ float bfhi(unsigned w) { return __uint_as_float(w & 0xffff0000u); }
__device__ __forceinline__ unsigned f2key(float f) { f = f + 0.0f; const unsigned u = __float_as_uint(f); return (u & 0x80000000u) ? ~u : (u | 0x80000000u); }
__device__ __forceinline__ float key2f(unsigned k) { const unsigned u = (k & 0x80000000u) ? (k & 0x7fffffffu) : ~k; return __uint_as_float(u); }
__device__ __forceinline__ float fast_exp2(float x) { return __builtin_amdgcn_exp2f(x); }
__device__ __forceinline__ float gelu_tanh(float x) {
    const float a = 0.7978845608028654f * (x + 0.044715f * x * x * x);
    const float e = fast_exp2(a * 2.8853900817779268f);
    const float t = 1.0f - 2.0f * __builtin_amdgcn_rcpf(1.0f + e);
    return 0.5f * x * (1.0f + t);
}
__device__ __forceinline__ unsigned long long lanemask_lt(int lane) { return (1ull << lane) - 1ull; }
__device__ __forceinline__ float dot2bf(unsigned a, unsigned b, float c) { return __builtin_amdgcn_fdot2_f32_bf16(__builtin_bit_cast(bf16x2_t, a), __builtin_bit_cast(bf16x2_t, b), c, false); }

__device__ __forceinline__ int xadd32i(int a, int b) { const auto r = __builtin_amdgcn_permlane32_swap((unsigned)a, (unsigned)b, false, false); return (int)r[0] + (int)r[1]; }
__device__ __forceinline__ int xadd16i(int a, int b) { const auto r = __builtin_amdgcn_permlane16_swap((unsigned)a, (unsigned)b, false, false); return (int)r[0] + (int)r[1]; }
__device__ __forceinline__ int ror8i(int v) { return __builtin_amdgcn_update_dpp(0, v, 0x128, 0xf, 0xf, false); }
__device__ __forceinline__ int sum8i(int t) { t += __builtin_amdgcn_update_dpp(0, t, 0xB1, 0xf, 0xf, false); t += __builtin_amdgcn_update_dpp(0, t, 0x4E, 0xf, 0xf, false); t += __builtin_amdgcn_update_dpp(0, t, 0x141, 0xf, 0xf, false); return t; }
__device__ __forceinline__ float wave_max_f(float m) {
    m = fmaxf(m, __int_as_float(__builtin_amdgcn_update_dpp(0, __float_as_int(m), 0x121, 0xf, 0xf, false))); m = fmaxf(m, __int_as_float(__builtin_amdgcn_update_dpp(0, __float_as_int(m), 0x122, 0xf, 0xf, false)));
    m = fmaxf(m, __int_as_float(__builtin_amdgcn_update_dpp(0, __float_as_int(m), 0x124, 0xf, 0xf, false))); m = fmaxf(m, __int_as_float(__builtin_amdgcn_update_dpp(0, __float_as_int(m), 0x128, 0xf, 0xf, false)));
    { const auto r = __builtin_amdgcn_permlane16_swap(__float_as_uint(m), __float_as_uint(m), false, false); m = fmaxf(__uint_as_float(r[0]), __uint_as_float(r[1])); }
    { const auto r = __builtin_amdgcn_permlane32_swap(__float_as_uint(m), __float_as_uint(m), false, false); m = fmaxf(__uint_as_float(r[0]), __uint_as_float(r[1])); }
    return m;
}
__device__ __forceinline__ unsigned cvtpk(float lo, float hi) { const f32x2 v = {lo, hi}; const bf16x2_t b = __builtin_convertvector(v, bf16x2_t); return __builtin_bit_cast(unsigned, b); }
__device__ __forceinline__ void p0_transpose_item(const float* W, int ldw, int K, int nblk, int Nvalid, const float* gain, bf16* WT, LAS float* scr, int item, int lane) {
    const int kb = item / nblk, nb = item % nblk, k0 = 64 * kb, n0 = 32 * nb;
    const int nn = n0 + (lane & 31); const bool ok = nn < Nvalid;
#pragma unroll 8
    for (int i = 0; i < 32; ++i) { const int kk = 2 * i + (lane >> 5); float v = ok ? W[(size_t)(k0 + kk) * ldw + nn] : 0.f; if (gain) v *= gain[k0 + kk]; scr[kk * 33 + (lane & 31)] = v; }
    LDS_WAIT(); asm volatile("" ::: "memory");
    const int c = lane & 7;
#pragma unroll
    for (int j = 0; j < 4; ++j) { const int n = (lane >> 3) + 8 * j; const LAS float* s = scr + (8 * c) * 33 + n;
        v4u o; o.x = pk2(s[0 * 33], s[1 * 33]); o.y = pk2(s[2 * 33], s[3 * 33]); o.z = pk2(s[4 * 33], s[5 * 33]); o.w = pk2(s[6 * 33], s[7 * 33]);
        *(GAS v4u*)(WT + (size_t)(n0 + n) * K + k0 + 8 * c) = o; }
    LDS_WAIT(); asm volatile("" ::: "memory");
}
__device__ __forceinline__ float p0_row(const float* src, const float* gain, bf16* dst, int lane) {
    f32x4 v[4]; float s = 0.f;
#pragma unroll
    for (int j = 0; j < 4; ++j) { v[j] = src ? *((const GAS f32x4*)src + lane + 64 * j) : (f32x4){0.f, 0.f, 0.f, 0.f}; s += (v[j].x * v[j].x + v[j].y * v[j].y) + (v[j].z * v[j].z + v[j].w * v[j].w); }
    if (gain) {
#pragma unroll
        for (int j = 0; j < 4; ++j) v[j] = v[j] * *((const GAS f32x4*)gain + lane + 64 * j); }
    GAS unsigned long long* o8 = (GAS unsigned long long*)dst + lane;
#pragma unroll
    for (int j = 0; j < 4; ++j) o8[64 * j] = (unsigned long long)pk2(v[j].x, v[j].y) | ((unsigned long long)pk2(v[j].z, v[j].w) << 32);
    return wave_sum(s);
}
__device__ __forceinline__ void p0_quant_row(const float* src, const float* gain, unsigned char* dst, float* scale_out, int bias, int lane, bool part = false, int erow = 0) {
    f32x4 v[4]; float am = 0.f;
#pragma unroll
    for (int j = 0; j < 4; ++j) { v[j] = *((const GAS f32x4*)src + lane * 4 + j); if (gain) v[j] = v[j] * *((const GAS f32x4*)gain + lane * 4 + j);
        am = fmaxf(am, fmaxf(fmaxf(fabsf(v[j].x), fabsf(v[j].y)), fmaxf(fabsf(v[j].z), fabsf(v[j].w)))); }
    am = wave_max_f(am);
    const float sc = am > 0.f ? am * (1.0f / 127.0f) : 1.0f, inv = 1.0f / sc;
    v4u w;
#pragma unroll
    for (int j = 0; j < 4; ++j) { unsigned pk = 0u;
#pragma unroll
        for (int e = 0; e < 4; ++e) { int q = (int)rintf(v[j][e] * inv); q = q > 127 ? 127 : (q < -127 ? -127 : q); pk |= ((unsigned)(q + bias) & 0xffu) << (8 * e); }
        w[j] = pk; }
    if (part) *(GAS v4u*)(dst + (size_t)(lane >> 3) * (16384 * 128) + (size_t)erow * 128 + (lane & 7) * 16) = w;
    else *((GAS v4u*)dst + lane) = w;
    if (lane == 0) *scale_out = sc;
}
struct RowIn { f32x4 v[4]; };
__device__ __forceinline__ void p0_rowq_load(RowIn& R, const float* src, int lane) {
#pragma unroll
    for (int j = 0; j < 4; ++j) R.v[j] = *((const GAS f32x4*)src + lane * 4 + j);
}
__device__ __forceinline__ void p0_rowq_store(const RowIn& R, const float* gain, unsigned char* dst, float* scale_out, int lane, bool part, int erow) {
    f32x4 v[4]; float am = 0.f;
#pragma unroll
    for (int j = 0; j < 4; ++j) { v[j] = R.v[j]; if (gain) v[j] = v[j] * *((const GAS f32x4*)gain + lane * 4 + j);
        am = fmaxf(am, fmaxf(fmaxf(fabsf(v[j].x), fabsf(v[j].y)), fmaxf(fabsf(v[j].z), fabsf(v[j].w)))); }
    am = wave_max_f(am);
    const float sc = am > 0.f ? am * (1.0f / 127.0f) : 1.0f, inv = 1.0f / sc;
    v4u w;
#pragma unroll
    for (int j = 0; j < 4; ++j) { unsigned pk = 0u;
#pragma unroll
        for (int e = 0; e < 4; ++e) { int q = (int)rintf(v[j][e] * inv); q = q > 127 ? 127 : (q < -127 ? -127 : q); pk |= ((unsigned)q & 0xffu) << (8 * e); }
        w[j] = pk; }
    if (part) *(GAS v4u*)(dst + (size_t)(lane >> 3) * (16384 * 128) + (size_t)erow * 128 + (lane & 7) * 16) = w;
    else *((GAS v4u*)dst + lane) = w;
    if (lane == 0) *scale_out = sc;
}
__device__ __forceinline__ void p0_rowx_load(RowIn& R, const float* src, int lane) {
#pragma unroll
    for (int j = 0; j < 4; ++j) R.v[j] = src ? *((const GAS f32x4*)src + lane + 64 * j) : (f32x4){0.f, 0.f, 0.f, 0.f};
}
__device__ __forceinline__ float p0_rowx_store(const RowIn& R, bf16* dst, int lane) {
    float s = 0.f;
#pragma unroll
    for (int j = 0; j < 4; ++j) s += (R.v[j].x * R.v[j].x + R.v[j].y * R.v[j].y) + (R.v[j].z * R.v[j].z + R.v[j].w * R.v[j].w);
    GAS unsigned long long* o8 = (GAS unsigned long long*)dst + lane;
#pragma unroll
    for (int j = 0; j < 4; ++j) o8[64 * j] = (unsigned long long)pk2(R.v[j].x, R.v[j].y) | ((unsigned long long)pk2(R.v[j].z, R.v[j].w) << 32);
    return wave_sum(s);
}
__device__ __forceinline__ void p0_wp_item(const float* wq, const float* subk, const float* gain, bf16* WT, int col0, int j0, LAS float* scr, int lane) {
#pragma unroll 4
    for (int i = 0; i < 32; ++i) { const int idx = i * 64 + lane, jj = idx >> 7, d = idx & 127; scr[d * 16 + jj] = wq[(size_t)(j0 + jj) * 2048 + col0 + d] * gain[j0 + jj]; }
    LDS_WAIT(); asm volatile("" ::: "memory");
    float a0[16], a1[16];
#pragma unroll
    for (int i = 0; i < 16; ++i) { a0[i] = 0.f; a1[i] = 0.f; }
    const float* r0 = subk + (size_t)lane * 128; const float* r1 = subk + (size_t)(lane + 64) * 128;
#pragma unroll 1
    for (int d8 = 0; d8 < 4; ++d8) {
      f32x4 xs[8], ys[8];
#pragma unroll
      for (int u = 0; u < 8; ++u) { xs[u] = *(const GAS f32x4*)(r0 + (d8 * 8 + u) * 4); ys[u] = *(const GAS f32x4*)(r1 + (d8 * 8 + u) * 4); }
#pragma unroll
      for (int u = 0; u < 8; ++u) { const int d4 = d8 * 8 + u;
        const f32x4 x = xs[u], y = ys[u];
#pragma unroll
        for (int dd = 0; dd < 4; ++dd) { const LAS f32x4* wv = (const LAS f32x4*)(scr + (d4 * 4 + dd) * 16);
#pragma unroll
            for (int q = 0; q < 4; ++q) { const f32x4 w = wv[q];
#pragma unroll
                for (int e = 0; e < 4; ++e) { a0[q * 4 + e] += x[dd] * w[e]; a1[q * 4 + e] += y[dd] * w[e]; } } }
      }
    }
    { v4u o0, o1; o0.x = pk2(a0[0], a0[1]); o0.y = pk2(a0[2], a0[3]); o0.z = pk2(a0[4], a0[5]); o0.w = pk2(a0[6], a0[7]); o1.x = pk2(a0[8], a0[9]); o1.y = pk2(a0[10], a0[11]); o1.z = pk2(a0[12], a0[13]); o1.w = pk2(a0[14], a0[15]);
      GAS v4u* p = (GAS v4u*)(WT + (size_t)(col0 + lane) * 1024 + j0); p[0] = o0; p[1] = o1; }
    { v4u o0, o1; o0.x = pk2(a1[0], a1[1]); o0.y = pk2(a1[2], a1[3]); o0.z = pk2(a1[4], a1[5]); o0.w = pk2(a1[6], a1[7]); o1.x = pk2(a1[8], a1[9]); o1.y = pk2(a1[10], a1[11]); o1.z = pk2(a1[12], a1[13]); o1.w = pk2(a1[14], a1[15]);
      GAS v4u* p = (GAS v4u*)(WT + (size_t)(col0 + lane + 64) * 1024 + j0); p[0] = o0; p[1] = o1; }
    LDS_WAIT(); asm volatile("" ::: "memory");
}

#define ROWMAX16(m) do { m = max(m, (unsigned)__builtin_amdgcn_update_dpp(0, (int)m, 0x121, 0xf, 0xf, false)); m = max(m, (unsigned)__builtin_amdgcn_update_dpp(0, (int)m, 0x122, 0xf, 0xf, false)); \
    m = max(m, (unsigned)__builtin_amdgcn_update_dpp(0, (int)m, 0x124, 0xf, 0xf, false)); m = max(m, (unsigned)__builtin_amdgcn_update_dpp(0, (int)m, 0x128, 0xf, 0xf, false)); } while (0)
#define ROWSUM16F(s) do { s += __int_as_float(__builtin_amdgcn_update_dpp(0, __float_as_int(s), 0x121, 0xf, 0xf, false)); s += __int_as_float(__builtin_amdgcn_update_dpp(0, __float_as_int(s), 0x122, 0xf, 0xf, false)); \
    s += __int_as_float(__builtin_amdgcn_update_dpp(0, __float_as_int(s), 0x124, 0xf, 0xf, false)); s += __int_as_float(__builtin_amdgcn_update_dpp(0, __float_as_int(s), 0x128, 0xf, 0xf, false)); } while (0)
__device__ __forceinline__ unsigned top16_of_128(unsigned (&x)[8], int sub) {
#define CE(i, j) do { const unsigned hi_ = max(x[i], x[j]), lo_ = min(x[i], x[j]); x[i] = hi_; x[j] = lo_; } while (0)
    CE(0, 1); CE(2, 3); CE(4, 5); CE(6, 7);
    CE(0, 2); CE(1, 3); CE(4, 6); CE(5, 7);
    CE(1, 2); CE(5, 6); CE(0, 4); CE(3, 7);
    CE(1, 5); CE(2, 6);
    CE(1, 4); CE(3, 6);
    CE(2, 4); CE(3, 5);
    CE(3, 4);
#undef CE
    unsigned res = 0u;
#pragma unroll
    for (int r = 0; r < 16; ++r) {
        unsigned m = x[0];
        ROWMAX16(m);
        res = (sub == r) ? m : res;
        const bool win = (x[0] == m);
#pragma unroll
        for (int i = 0; i < 7; ++i) x[i] = win ? x[i + 1] : x[i];
        x[7] = win ? 0u : x[7];
    }
    return res;
}
struct RouteIn { f32x4 a, b, c, d; };
__device__ __forceinline__ void peer_route_load(RouteIn& R, const unsigned short* S, int task, int lane) {
    const int sub = lane & 15, grp = lane >> 4, p = task * 4 + grp, tok = p >> 3, h = p & 7;
    const unsigned short* sp = S + (size_t)tok * 2048 + h * 256 + sub * 8;
    typedef _Float16 h8 __attribute__((ext_vector_type(8)));
    const h8 x = *(const GAS h8*)sp, y = *(const GAS h8*)(sp + 128);
    R.a = (f32x4){(float)x[0], (float)x[1], (float)x[2], (float)x[3]}; R.b = (f32x4){(float)x[4], (float)x[5], (float)x[6], (float)x[7]};
    R.c = (f32x4){(float)y[0], (float)y[1], (float)y[2], (float)y[3]}; R.d = (f32x4){(float)y[4], (float)y[5], (float)y[6], (float)y[7]};
}
__device__ __forceinline__ void peer_route_core(const RouteIn& R, unsigned* EIDX, float* GATE, int tok, int h, int lane) {
    const int sub = lane & 15;
    unsigned x1[8], x2[8];
    { const f32x4 a = R.a, b = R.b, c = R.c, d = R.d;
#pragma unroll
      for (int i = 0; i < 4; ++i) { x1[i] = (f2key(a[i]) & ~127u) | (unsigned)(127 - (sub * 8 + i)); x1[4 + i] = (f2key(b[i]) & ~127u) | (unsigned)(127 - (sub * 8 + 4 + i));
                                    x2[i] = (f2key(c[i]) & ~127u) | (unsigned)(127 - (sub * 8 + i)); x2[4 + i] = (f2key(d[i]) & ~127u) | (unsigned)(127 - (sub * 8 + 4 + i)); } }
    const unsigned r1 = top16_of_128(x1, sub), r2 = top16_of_128(x2, sub);
    const float v1 = key2f(r1 & ~127u), v2 = key2f(r2 & ~127u); const int i1 = 127 - (int)(r1 & 127u), i2 = 127 - (int)(r2 & 127u);
    unsigned c[8];
    const int La = (sub == 0 || sub == 1) ? 8 : (sub == 2 ? 5 : (sub == 3 ? 4 : (sub == 4 ? 3 : (sub < 8 ? 2 : 1))));
#pragma unroll
    for (int j = 0; j < 8; ++j) { const float vj = __shfl(v2, (lane & 48) | j); c[j] = (j < La) ? ((f2key(v1 + vj) & ~255u) | (unsigned)((15 - sub) << 4) | (unsigned)(15 - j)) : 0u; }
    { const float v10 = __shfl(v1, lane & 48); if (sub >= 8) { const unsigned extra = (f2key(v10 + v2) & ~255u) | (unsigned)(15 << 4) | (unsigned)(15 - sub);
          const unsigned hi_ = max(c[0], extra), lo_ = min(c[0], extra); c[0] = hi_; c[1] = lo_; } }
    unsigned res = 0u;
#pragma unroll
    for (int r = 0; r < 16; ++r) {
        unsigned m = c[0]; ROWMAX16(m);
        res = (sub == r) ? m : res;
        const bool win = (c[0] == m);
#pragma unroll
        for (int j = 0; j < 7; ++j) c[j] = win ? c[j + 1] : c[j];
        c[7] = win ? 0u : c[7];
    }
    const float ts = key2f(res & ~255u); const int a = 15 - (int)((res >> 4) & 15u), b = 15 - (int)(res & 15u);
    const int ia = __shfl(i1, (lane & 48) | a), ib = __shfl(i2, (lane & 48) | b);
    unsigned mk = f2key(ts); ROWMAX16(mk); const float mx = key2f(mk);
    const float e = fast_exp2((ts - mx) * 1.4426950408889634f); float sum = e; ROWSUM16F(sum);
    { const int j = h * 16 + sub, pos = (j & 64) + (j & 7) * 8 + ((j >> 3) & 7);
      if (tok < NT) { EIDX[(size_t)tok * 128 + pos] = (unsigned)(ia * 128 + ib); GATE[(size_t)tok * 128 + pos] = e / sum; } }
}

__device__ __forceinline__ void peer_route_task(const RouteIn& R, unsigned* EIDX, float* GATE, int task, int lane) { const int p = task * 4 + (lane >> 4); peer_route_core(R, EIDX, GATE, p >> 3, p & 7, lane); }
struct OneUnit : pg8::StaticOrder { int k;
    __device__ __forceinline__ bool next(int i, pg8::Unit& u) const { return i == 0 && pg8::StaticOrder::next(k, u); } };
struct EpiRoute { static constexpr bool PERM = true, AFTER_DRAIN = true;
    const unsigned long long* ss; unsigned* EIDX; float* GATE;
    __device__ __forceinline__ void fused(f32x4 (&acc)[2][2][4][2], const pg8::Unit& u, int wr, int wc, int fr, int fq, LAS unsigned char* tile, int wid, int lane) const {
#pragma unroll
        for (int ai = 0; ai < 2; ++ai)
#pragma unroll
            for (int m = 0; m < 4; ++m) { const int row = ai * 128 + wr * 64 + m * 16 + fr; const float rs = rsqrtf(pg8::ss_get(ss + u.pm * 256 + row) * (1.0f / 1024.0f) + EPS);
#pragma unroll
                for (int bj = 0; bj < 2; ++bj) { const f32x4 v0 = acc[ai][bj][m][0] * rs, v1 = acc[ai][bj][m][1] * rs; v4u w;
                    w.x = pg8::EpiScaleF16::pkh(v0[0], v0[1]); w.y = pg8::EpiScaleF16::pkh(v0[2], v0[3]); w.z = pg8::EpiScaleF16::pkh(v1[0], v1[1]); w.w = pg8::EpiScaleF16::pkh(v1[2], v1[3]);
                    const int ci = bj * 16 + wc * 4 + fq; *(LAS v4u*)(tile + row * 512 + ((ci ^ (row & 7)) * 16)) = w; } }
        asm volatile("s_waitcnt lgkmcnt(0)" ::: "memory"); __builtin_amdgcn_s_barrier(); asm volatile("" ::: "memory");
        const int sub = lane & 15, grp = lane >> 4;
#pragma unroll 1
        for (int tk = wid; tk < 64; tk += 8) { const int row = tk * 4 + grp; const LAS unsigned char* rp = tile + row * 512; const int sw = sub ^ (row & 7);
            typedef _Float16 h8 __attribute__((ext_vector_type(8)));
            const h8 x = *(const LAS h8*)(rp + sw * 16), y = *(const LAS h8*)(rp + 256 + sw * 16);
            RouteIn R; R.a = (f32x4){(float)x[0], (float)x[1], (float)x[2], (float)x[3]}; R.b = (f32x4){(float)x[4], (float)x[5], (float)x[6], (float)x[7]};
            R.c = (f32x4){(float)y[0], (float)y[1], (float)y[2], (float)y[3]}; R.d = (f32x4){(float)y[4], (float)y[5], (float)y[6], (float)y[7]};
            peer_route_core(R, EIDX, GATE, u.pm * 256 + row, u.pn, lane); }
        asm volatile("s_waitcnt lgkmcnt(0)" ::: "memory"); __builtin_amdgcn_s_barrier(); asm volatile("" ::: "memory");
    }
};
struct XqIn { f32x4 xv[4]; float ss; };
__device__ __forceinline__ void peer_xq_load(XqIn& R, const bf16* X, const unsigned long long* ss, int tok, int lane) {
    const v4u a = *(const GAS v4u*)(X + (size_t)tok * 1024 + lane * 16), b = *(const GAS v4u*)(X + (size_t)tok * 1024 + lane * 16 + 8);
    R.xv[0] = (f32x4){bflo(a.x), bfhi(a.x), bflo(a.y), bfhi(a.y)}; R.xv[1] = (f32x4){bflo(a.z), bfhi(a.z), bflo(a.w), bfhi(a.w)};
    R.xv[2] = (f32x4){bflo(b.x), bfhi(b.x), bflo(b.y), bfhi(b.y)}; R.xv[3] = (f32x4){bflo(b.z), bfhi(b.z), bflo(b.w), bfhi(b.w)};
    R.ss = pg8::ss_get(ss + tok);
}
__device__ __forceinline__ void peer_xq_token(const XqIn& R, unsigned char* XQ, float* RSX, int tok, int lane) {
    float am = 0.f;
#pragma unroll
    for (int j = 0; j < 4; ++j) am = fmaxf(am, fmaxf(fmaxf(fabsf(R.xv[j].x), fabsf(R.xv[j].y)), fmaxf(fabsf(R.xv[j].z), fabsf(R.xv[j].w))));
    am = wave_max_f(am);
    const float sx = am > 0.f ? am * (1.0f / 127.0f) : 1.0f, isx = 1.0f / sx;
    v4u w;
#pragma unroll
    for (int j = 0; j < 4; ++j) { unsigned pk = 0u;
#pragma unroll
        for (int e = 0; e < 4; ++e) { const int q = (int)rintf(R.xv[j][e] * isx); pk |= ((unsigned)q & 0xffu) << (8 * e); }
        w[j] = pk; }
    *((GAS v4u*)(XQ + (size_t)tok * 1024) + lane) = w;
    if (lane == 0) RSX[tok] = rsqrtf(R.ss * (1.0f / 1024.0f) + EPS) * sx;
}
struct E1Set { v4u uu[8]; v4u xw; float rs, su, sv, gt; int tokj; };
__device__ __forceinline__ void e1_load(E1Set& S, const LAS unsigned* wl, int b, int ts, const unsigned char* XQ, const float* RSX, const float* GATE, const unsigned char* U8, const float* SU, const float* SV, int lane) {
    const unsigned d = (unsigned)__builtin_amdgcn_readfirstlane((int)wl[2048 + b]); const int start = (int)(d & 0xffffu), n = (int)((d >> 16) & 0xffu), tok = ts + (int)(d >> 24), grp = (lane >> 3) & 7;
    const unsigned ev8 = wl[start + ((lane & 7) < n ? (lane & 7) : n - 1)];
#pragma unroll
    for (int i = 0; i < 8; ++i) { const unsigned e = (unsigned)__builtin_amdgcn_readlane((int)ev8, i); S.uu[i] = *((const GAS v4u*)(U8 + (size_t)e * 1024) + lane); }
    S.xw = *((const GAS v4u*)(XQ + (size_t)tok * 1024) + lane); S.rs = RSX[tok];
    { const int gi = grp < n ? grp : n - 1; const unsigned ek = wl[start + gi], jk = wl[1024 + start + gi] & 0xffu; S.tokj = grp < n ? tok * 128 + (int)jk : -1; S.su = SU[ek]; S.sv = SV[ek]; S.gt = GATE[(size_t)tok * 128 + jk]; }
}
__device__ __forceinline__ void e1_compute(const E1Set& S, float* ACT, int lane) {
    const int b5 = (lane >> 5) & 1, b4 = (lane >> 4) & 1, b3 = (lane >> 3) & 1; int p[8];
#pragma unroll
    for (int i = 0; i < 8; ++i) { int d = __builtin_amdgcn_sdot4((int)S.uu[i].x, (int)S.xw.x, 0, false); d = __builtin_amdgcn_sdot4((int)S.uu[i].y, (int)S.xw.y, d, false);
        d = __builtin_amdgcn_sdot4((int)S.uu[i].z, (int)S.xw.z, d, false); d = __builtin_amdgcn_sdot4((int)S.uu[i].w, (int)S.xw.w, d, false); p[i] = d; }
    const int r0 = xadd32i(p[0], p[4]), r1 = xadd32i(p[1], p[5]), r2 = xadd32i(p[2], p[6]), r3 = xadd32i(p[3], p[7]);
    const int q0 = xadd16i(r0, r2), q1 = xadd16i(r1, r3);
    int t = (b3 ? q1 : q0) + ror8i(b3 ? q0 : q1);
    t = sum8i(t); (void)b5; (void)b4;
    if (S.tokj >= 0 && (lane & 7) == 0) ACT[S.tokj] = S.gt * gelu_tanh(S.rs * S.su * (float)t) * S.sv;
}
__device__ __forceinline__ void peer_e1_chunk(const unsigned char* XQ, const float* RSX, const unsigned* EIDX, const float* GATE, const unsigned char* U8, const float* SU, const float* SV,
                                              float* ACT, LAS unsigned* wl, int t0, int t1, int pi, int lane) {
    const unsigned long long lt = lanemask_lt(lane);
#pragma unroll 1
    for (int ts = t0; ts < t1; ts += 8) {
        const int nt = (t1 - ts) < 8 ? (t1 - ts) : 8;
        unsigned ee[8][2];
#pragma unroll
        for (int tl = 0; tl < 8; ++tl) { ee[tl][0] = 0xffffffffu; ee[tl][1] = 0xffffffffu; if (tl < nt) { ee[tl][0] = EIDX[(size_t)(ts + tl) * 128 + lane]; ee[tl][1] = EIDX[(size_t)(ts + tl) * 128 + 64 + lane]; } }
        int nent = 0, nbat = 0;
#pragma unroll
        for (int tl = 0; tl < 8; ++tl) {
            const bool s0 = (int)(ee[tl][0] >> 11) == pi, s1 = (int)(ee[tl][1] >> 11) == pi;
            const unsigned long long m0 = __ballot(s0), m1 = __ballot(s1);
            const int c0 = __builtin_popcountll(m0), c = c0 + __builtin_popcountll(m1);
            if (s0) { const int p = nent + __builtin_popcountll(m0 & lt); wl[p] = ee[tl][0]; wl[1024 + p] = (unsigned)lane; }
            if (s1) { const int p = nent + c0 + __builtin_popcountll(m1 & lt); wl[p] = ee[tl][1]; wl[1024 + p] = (unsigned)(64 + lane); }
            const int nb = (c + 7) >> 3;
            if (lane < nb) { const int rem = c - 8 * lane; wl[2048 + nbat + lane] = (unsigned)(nent + 8 * lane) | ((unsigned)(rem < 8 ? rem : 8) << 16) | ((unsigned)tl << 24); }
            nent += c; nbat += nb;
        }
        LDS_WAIT(); asm volatile("" ::: "memory");
        if (nbat > 0) {
            E1Set A, B;
            e1_load(A, wl, 0, ts, XQ, RSX, GATE, U8, SU, SV, lane);
#pragma unroll 1
            for (int b = 0; b < nbat; b += 2) {
                e1_load(B, wl, b + 1 < nbat ? b + 1 : nbat - 1, ts, XQ, RSX, GATE, U8, SU, SV, lane);
                e1_compute(A, ACT, lane);
                if (b + 1 >= nbat) break;
                e1_load(A, wl, b + 2 < nbat ? b + 2 : nbat - 1, ts, XQ, RSX, GATE, U8, SU, SV, lane);
                e1_compute(B, ACT, lane);
            }
        }
        LDS_WAIT(); asm volatile("" ::: "memory");
    }
}
__device__ __forceinline__ void e2_accum4(const v4u& d0v, const v4u& d1v, const v4u& d2v, const v4u& d3v, int W4, int (&y)[16]) {
#pragma unroll
    for (int k = 0; k < 4; ++k) { const unsigned d0 = d0v[k], d1 = d1v[k], d2 = d2v[k], d3 = d3v[k];
        const unsigned p01l = __builtin_amdgcn_perm(d1, d0, 0x05010400u), p01h = __builtin_amdgcn_perm(d1, d0, 0x07030602u);
        const unsigned p23l = __builtin_amdgcn_perm(d3, d2, 0x05010400u), p23h = __builtin_amdgcn_perm(d3, d2, 0x07030602u);
        y[4 * k + 0] = __builtin_amdgcn_sdot4((int)__builtin_amdgcn_perm(p23l, p01l, 0x05040100u), W4, y[4 * k + 0], false);
        y[4 * k + 1] = __builtin_amdgcn_sdot4((int)__builtin_amdgcn_perm(p23l, p01l, 0x07060302u), W4, y[4 * k + 1], false);
        y[4 * k + 2] = __builtin_amdgcn_sdot4((int)__builtin_amdgcn_perm(p23h, p01h, 0x05040100u), W4, y[4 * k + 2], false);
        y[4 * k + 3] = __builtin_amdgcn_sdot4((int)__builtin_amdgcn_perm(p23h, p01h, 0x07060302u), W4, y[4 * k + 3], false); }
}
struct E2Meta { f32x4 a[4]; unsigned x; };
template <bool HAS_B> __device__ __forceinline__ void e2_finish(const v4u (&V)[16], const E2Meta& M, float* Xo, bf16* Xob, float* sso, int tok, int pi, int col, int lane) {
    const int b3 = (lane >> 3) & 1;
    int y[16];
#pragma unroll
    for (int i = 0; i < 16; ++i) y[i] = 0;
    float am = 0.f;
#pragma unroll
    for (int i = 0; i < 4; ++i) am = fmaxf(am, fmaxf(fmaxf(fabsf(M.a[i].x), fabsf(M.a[i].y)), fmaxf(fabsf(M.a[i].z), fabsf(M.a[i].w))));
    am = wave_max_f(am);
    const float sw = am > 0.f ? am * (1.0f / 127.0f) : 1.0f, isw = 1.0f / sw;
#pragma unroll
    for (int g4 = 0; g4 < 4; ++g4) { const f32x4 a = M.a[g4];
        const int W4 = (int)(((unsigned)(int)rintf(a.x * isw) & 0xffu) | (((unsigned)(int)rintf(a.y * isw) & 0xffu) << 8) | (((unsigned)(int)rintf(a.z * isw) & 0xffu) << 16) | ((unsigned)(int)rintf(a.w * isw) << 24));
        e2_accum4(V[4 * g4], V[4 * g4 + 1], V[4 * g4 + 2], V[4 * g4 + 3], W4, y); }
    int z8[8];
#pragma unroll
    for (int i = 0; i < 8; ++i) z8[i] = (b3 ? y[8 + i] : y[i]) + ror8i(b3 ? y[i] : y[8 + i]);
    int z4[4];
#pragma unroll
    for (int i = 0; i < 4; ++i) z4[i] = xadd16i(z8[i], z8[4 + i]);
    int z2[2];
#pragma unroll
    for (int i = 0; i < 2; ++i) z2[i] = xadd32i(z4[i], z4[2 + i]);
    const float o0 = bflo(M.x) + sw * (float)z2[0], o1 = bfhi(M.x) + sw * (float)z2[1];
    if constexpr (!HAS_B) *(GAS f32x2*)(Xo + (size_t)tok * 1024 + col) = (f32x2){o0, o1};
    if constexpr (HAS_B) { *(GAS unsigned*)(Xob + (size_t)tok * 1024 + col) = pk2(o0, o1);
        float sq = o0 * o0 + o1 * o1; ROWSUM16F(sq);
        const float tot = (__int_as_float(__builtin_amdgcn_readlane(__float_as_int(sq), 0)) + __int_as_float(__builtin_amdgcn_readlane(__float_as_int(sq), 16))) + (__int_as_float(__builtin_amdgcn_readlane(__float_as_int(sq), 32)) + __int_as_float(__builtin_amdgcn_readlane(__float_as_int(sq), 48)));
        if (lane == 0) sso[(size_t)pi * MP + tok] = tot; }
}
template <bool HAS_B> __device__ __forceinline__ void peer_e2_chunk(const bf16* X, const unsigned* EIDX, const float* ACT, const unsigned char* V8, float* Xo, bf16* Xob, float* sso, int t0, int t1, int pi, int lane) {
    const int grp = lane >> 3, l8 = lane & 7, b3 = (lane >> 3) & 1, b4 = (lane >> 4) & 1, b5 = (lane >> 5) & 1;
    const int col = pi * 128 + l8 * 16 + b3 * 8 + b4 * 4 + b5 * 2;
    const unsigned char* vb = V8 + (size_t)pi * (16384 * 128) + l8 * 16;
    v4u vA[16], vB[16]; E2Meta mA, mB; v4u eN[4];
#define E2_LOADE(T) do { const GAS v4u* ep = (const GAS v4u*)(EIDX + (size_t)(T) * 128 + grp * 8); eN[0] = ep[0]; eN[1] = ep[1]; eN[2] = ep[16]; eN[3] = ep[17]; } while (0)
#define E2_META(T, M) do { const GAS f32x4* apn = (const GAS f32x4*)(ACT + (size_t)(T) * 128 + grp * 8); M.a[0] = apn[0]; M.a[1] = apn[1]; M.a[2] = apn[16]; M.a[3] = apn[17]; \
        M.x = *(const GAS unsigned*)(X + (size_t)(T) * 1024 + col); } while (0)
#define E2_GATHER16(V) do { _Pragma("unroll") for (int g4 = 0; g4 < 4; ++g4) { _Pragma("unroll") for (int k = 0; k < 4; ++k) V[4 * g4 + k] = *(const GAS v4u*)(vb + (size_t)eN[g4][k] * 128); } } while (0)
    E2_LOADE(t0); E2_META(t0, mA);
    E2_GATHER16(vA);
    if (t0 + 1 < t1) E2_LOADE(t0 + 1);
#pragma unroll 1
    for (int tok = t0; tok < t1; tok += 2) {
        if (tok + 1 < t1) { E2_GATHER16(vB); E2_META(tok + 1, mB); if (tok + 2 < t1) E2_LOADE(tok + 2); }
        e2_finish<HAS_B>(vA, mA, Xo, Xob, sso, tok, pi, col, lane);
        if (tok + 1 >= t1) break;
        if (tok + 2 < t1) { E2_GATHER16(vA); E2_META(tok + 2, mA); if (tok + 3 < t1) E2_LOADE(tok + 3); }
        e2_finish<HAS_B>(vB, mB, Xo, Xob, sso, tok + 1, pi, col, lane);
    }
#undef E2_GATHER16
#undef E2_META
#undef E2_LOADE
}
#define PEER_QLOOP_CHUNK(QBASE, BODY) do { const int home_ = (int)(xb_xcc_id() & 7u); \
    for (int k_ = 0; k_ < 8; ++k_) { const int pi = (home_ + k_) & 7; unsigned* qh_ = (QBASE) + pi * 64; \
        for (;;) { unsigned c_ = 0u; if (lane == 0) c_ = __hip_atomic_fetch_add(qh_, 16u, __ATOMIC_RELAXED, __HIP_MEMORY_SCOPE_AGENT); c_ = (unsigned)__builtin_amdgcn_readfirstlane((int)c_); \
            if (c_ >= (unsigned)NT) break; const int t0 = (int)c_, t1 = (int)c_ + 16 < NT ? (int)c_ + 16 : NT; BODY; } } } while (0)
__device__ __forceinline__ float wave_sum_dpp(float v) {
    ROWSUM16F(v);
    return (__int_as_float(__builtin_amdgcn_readlane(__float_as_int(v), 0)) + __int_as_float(__builtin_amdgcn_readlane(__float_as_int(v), 16))) + (__int_as_float(__builtin_amdgcn_readlane(__float_as_int(v), 32)) + __int_as_float(__builtin_amdgcn_readlane(__float_as_int(v), 48)));
}
struct PostRow { float x[33]; float wi; };
__device__ __forceinline__ void att_post_load(PostRow& R, const bf16* P, int row, int lane) {
    const bf16* p = P + (size_t)row * APAD;
#pragma unroll
    for (int i = 0; i < 33; ++i) R.x[i] = bflo((unsigned)p[i * 64 + lane]);
    R.wi = (lane < 8) ? bflo((unsigned)p[2112 + lane]) : 0.f;
}
__device__ __forceinline__ void att_post_compute(const PostRow& R, float gq, float gk, float gik, const float* tab,
                                                 bf16* QB, bf16* KB, bf16* V2B, bf16* QIB, bf16* KIB, float* WI, float* out, int row, int lane) {
    const float* tb = tab + (size_t)(row < NP ? (row & 4095) : 4096) * 64;
    const float cs = tb[lane & 31], sn0 = tb[32 + (lane & 31)], sn = (lane < 32) ? -sn0 : sn0;
    float* okp = (row < NP) ? out + O_KP + (size_t)row * 256 : out + O_KS + (size_t)(row - NP) * 256;
    float* ovp = (row < NP) ? out + O_VP + (size_t)row * 256 : out + O_VS + (size_t)(row - NP) * 256;
    float* oip = (row < NP) ? out + O_IP + (size_t)row * 64 : out + O_IS + (size_t)(row - NP) * 64;
#pragma unroll
    for (int i = 0; i < 33; ++i) {
        float x = R.x[i];
        if (i >= 20 && i < 24) { V2B[(size_t)row * 256 + (i - 20) * 64 + lane] = (bf16)f2bf(x); ovp[(i - 20) * 64 + lane] = x; continue; }
        const float g = (i < 16) ? gq : ((i < 20) ? gk : gik);
        if (i < 20 || i == 32) { const float ss = wave_sum_dpp(x * x); x = x * rsqrtf(ss * (1.0f / 64.0f) + EPS) * g; }
        const auto sw_ = __builtin_amdgcn_permlane32_swap(__float_as_uint(x), __float_as_uint(x), false, false);
        const float other = __uint_as_float(lane < 32 ? sw_[1] : sw_[0]);
        const float y = x * cs + other * sn;
        if (i < 16) QB[(size_t)row * 1024 + i * 64 + lane] = (bf16)f2bf(y * QSCALE);
        else if (i < 20) { KB[(size_t)row * 256 + (i - 16) * 64 + lane] = (bf16)f2bf(y); okp[(i - 16) * 64 + lane] = y; }
        else if (i < 32) QIB[(size_t)row * 512 + (i - 24) * 64 + lane] = (bf16)f2bf(y);
        else { KIB[(size_t)row * 64 + lane] = (bf16)f2bf(y); oip[lane] = y; }
    }
    if (lane < 8) WI[(size_t)row * 8 + lane] = R.wi * IDX_SCALE;
}

__device__ __forceinline__ void idx_scores_task(const bf16* QIB, const bf16* KIB, const float* WI, unsigned short* SC, int b, int qb, int kb_lo, int kb_hi, int lane) {
    const int l16 = lane & 15, q4 = lane >> 4; const size_t qrow = (size_t)b * SEQ + qb * 16 + l16;
    bf16x8 qf[8][2]; float wi[8];
#pragma unroll
    for (int h = 0; h < 8; ++h) { wi[h] = WI[qrow * 8 + h];
#pragma unroll
        for (int kk = 0; kk < 2; ++kk) qf[h][kk] = *(const GAS bf16x8*)(QIB + qrow * 512 + h * 64 + kk * 32 + q4 * 8); }
    const bf16* kbase = KIB + ((size_t)b * SEQ + l16) * 64 + q4 * 8;
    bf16x8 kr0[4], kr1[4];
#pragma unroll
    for (int j = 0; j < 4; ++j) { const int kb = (kb_lo + j < kb_hi) ? kb_lo + j : kb_lo; kr0[j] = *(const GAS bf16x8*)(kbase + (size_t)kb * 1024); kr1[j] = *(const GAS bf16x8*)(kbase + (size_t)kb * 1024 + 32); }
#pragma unroll 1
    for (int kb0 = kb_lo; kb0 < kb_hi; kb0 += 4) {
#pragma unroll
        for (int j = 0; j < 4; ++j) { const int kb = kb0 + j;
            const bf16x8 k0 = kr0[j], k1 = kr1[j];
            { const int kn = (kb + 4 < kb_hi) ? kb + 4 : kb_lo; kr0[j] = *(const GAS bf16x8*)(kbase + (size_t)kn * 1024); kr1[j] = *(const GAS bf16x8*)(kbase + (size_t)kn * 1024 + 32); }
            {
                f32x4 sc = {0.f, 0.f, 0.f, 0.f};
#pragma unroll
                for (int h = 0; h < 8; ++h) { f32x4 a = {0.f, 0.f, 0.f, 0.f};
                    a = __builtin_amdgcn_mfma_f32_16x16x32_bf16(k0, qf[h][0], a, 0, 0, 0);
                    a = __builtin_amdgcn_mfma_f32_16x16x32_bf16(k1, qf[h][1], a, 0, 0, 0);
#pragma unroll
                    for (int i = 0; i < 4; ++i) sc[i] += wi[h] * fmaxf(a[i], 0.f); }
                if (kb < kb_hi) { v2u w; w.x = pg8::EpiScaleF16::pkh(sc[0], sc[1]); w.y = pg8::EpiScaleF16::pkh(sc[2], sc[3]); *(GAS v2u*)(SC + qrow * 4096 + kb * 16 + 4 * q4) = w; } }
        }
    }
}

__device__ __forceinline__ void select_load(unsigned (&raw)[64], const unsigned short* SC, int row, int lane) {
    const int t = row & 4095, n = t + 1; if (n <= 256) return;
    const unsigned short* sc = SC + (size_t)row * 4096; const int nj = (n + 63) >> 6;
#pragma unroll
    for (int j = 0; j < 64; ++j) if (j < nj) raw[j] = (unsigned)sc[j * 64 + lane];
}
__device__ __forceinline__ void select_keys(unsigned (&x)[64], const unsigned (&raw)[64], int row, int lane) {
    const int t = row & 4095, n = t + 1; if (n <= 256) return; const int nj = (n + 63) >> 6;
#pragma unroll
    for (int j = 0; j < 64; ++j) { x[j] = 0u; if (j < nj) { const int s = j * 64 + lane; const unsigned h = raw[j];
            if (s < n) x[j] = ((h & 0x8000u) ? (~h & 0xffffu) : (h | 0x8000u)) + ((h & 0x7fffu) == 0u && (h & 0x8000u) ? 1u : 0u); } }
}
__device__ __forceinline__ void select_run(const unsigned (&x)[64], unsigned long long* BM, int row, int lane) {
    const int t = row & 4095, n = t + 1; unsigned long long* bm = BM + (size_t)row * 64;
    if (n <= 256) { const int lo = lane * 64; unsigned long long w = 0ull; if (lo + 63 <= t) w = ~0ull; else if (lo <= t) w = (2ull << (t - lo)) - 1ull; bm[lane] = w; return; }
    const int nj = (n + 63) >> 6;
    unsigned T = 0u; const int ngrp = (nj + 15) >> 4;
#pragma unroll 1
    for (int bit = 15; bit >= 0; --bit) { const unsigned c = T | (1u << bit); unsigned cv = 0u;
#pragma unroll
        for (int g = 0; g < 4; ++g) if (g < ngrp) {
#pragma unroll
            for (int j = g * 16; j < g * 16 + 16; ++j) asm("v_cmp_ge_u32 vcc, %1, %2\n\tv_addc_co_u32 %0, vcc, 0, %0, vcc" : "+v"(cv) : "v"(x[j]), "v"(c) : "vcc"); }
        asm volatile("s_nop 1" : "+v"(cv));
        int ci = (int)cv;
        ci += __builtin_amdgcn_update_dpp(0, ci, 0x121, 0xf, 0xf, false); ci += __builtin_amdgcn_update_dpp(0, ci, 0x122, 0xf, 0xf, false);
        ci += __builtin_amdgcn_update_dpp(0, ci, 0x124, 0xf, 0xf, false); ci += __builtin_amdgcn_update_dpp(0, ci, 0x128, 0xf, 0xf, false);
        const int cnt = __builtin_amdgcn_readlane(ci, 0) + __builtin_amdgcn_readlane(ci, 16) + __builtin_amdgcn_readlane(ci, 32) + __builtin_amdgcn_readlane(ci, 48);
        if (cnt >= 256) T = c; }
    int cgt = 0;
#pragma unroll
    for (int j = 0; j < 64; ++j) if (j < nj) cgt += __builtin_popcountll(__ballot(x[j] > T));
    const int need = 256 - cgt; int eqb = 0; const unsigned long long lt = lanemask_lt(lane); unsigned long long myw = 0ull;
#pragma unroll
    for (int j = 0; j < 64; ++j) if (j < nj) {
        const bool eq = (x[j] == T); const unsigned long long meq = __ballot(eq);
        const bool sl = (x[j] > T) || (eq && (eqb + __builtin_popcountll(meq & lt)) < need);
        const unsigned long long m = __ballot(sl);
        if (lane == j) myw = m;
        eqb += __builtin_popcountll(meq); }
    bm[lane] = myw;
}

constexpr int ATT_KP = 144, ATT_VP = 136, ATT_STAGE = 64 * ATT_KP + 64 * ATT_VP;
__device__ __forceinline__ void attend_unit(const bf16* QB, const bf16* KB, const bf16* VT, const unsigned long long* BM, bf16* OB, LAS unsigned char* lds, int b, int kvh, int qt, float nbound, int tid, unsigned* qnext, int& nxt) {
    const int lane = tid & 63, wave = tid >> 6, r32 = lane & 31, hi = lane >> 5, qh = wave >> 2, head = kvh * 4 + (wave & 3);
    const size_t qrow = (size_t)b * SEQ + qt * 64 + qh * 32 + r32;
    bf16x8 qf[4];
#pragma unroll
    for (int d0 = 0; d0 < 4; ++d0) qf[d0] = *(const GAS bf16x8*)(QB + qrow * 1024 + head * 64 + d0 * 16 + hi * 8);
    const int srow = tid >> 3, sch = tid & 7;
    const bf16* kg = KB + ((size_t)b * SEQ + srow) * 256 + kvh * 64 + sch * 8;
    const bf16* vg = VT + ((size_t)(b * 4 + kvh) * 64 + srow) * SEQ + sch * 8;
    const unsigned long long* bmq = BM + qrow * 64; const LAS unsigned char* mtab = lds + 3 * ATT_STAGE + 64;
    f32x16 o0 = {}, o1 = {}; f32x16 nb16; float ls[4] = {0.f, 0.f, 0.f, 0.f};
#pragma unroll
    for (int i = 0; i < 16; ++i) nb16[i] = nbound;
    const bf16x8 ones8 = {0x3F80, 0x3F80, 0x3F80, 0x3F80, 0x3F80, 0x3F80, 0x3F80, 0x3F80};
    const int nt = qt + 1;
#define ATT_STORE(T, KR, VR) do { LAS unsigned char* st_ = lds + ((T) % 3) * ATT_STAGE; *(LAS v4u*)(st_ + srow * ATT_KP + sch * 16) = KR; \
        LAS v2u* vp_ = (LAS v2u*)(st_ + 64 * ATT_KP + srow * ATT_VP + sch * 16); vp_[0] = (v2u){VR.x, VR.y}; vp_[1] = (v2u){VR.z, VR.w}; } while (0)
#define ATT_QK(T, P0, P1) do { const LAS unsigned char* st_ = lds + ((T) % 3) * ATT_STAGE; _Pragma("unroll") for (int d0 = 0; d0 < 4; ++d0) { \
        const bf16x8 k0 = *(const LAS bf16x8*)(st_ + r32 * ATT_KP + d0 * 32 + hi * 16), k1 = *(const LAS bf16x8*)(st_ + (32 + r32) * ATT_KP + d0 * 32 + hi * 16); \
        P0 = __builtin_amdgcn_mfma_f32_32x32x16_bf16(k0, qf[d0], P0, 0, 0, 0); P1 = __builtin_amdgcn_mfma_f32_32x32x16_bf16(k1, qf[d0], P1, 0, 0, 0); } } while (0)
#define ATT_BAR() do { asm volatile("s_waitcnt lgkmcnt(0)" ::: "memory"); __builtin_amdgcn_s_barrier(); asm volatile("" ::: "memory"); } while (0)
    auto tcl = [&](int t) { return t < nt ? t : nt - 1; };
    v4u kA = *(const GAS v4u*)kg, vA = *(const GAS v4u*)vg; unsigned long long wA = bmq[0];
    v4u kB = *(const GAS v4u*)(kg + (size_t)tcl(1) * 64 * 256), vB = *(const GAS v4u*)(vg + tcl(1) * 64); unsigned long long wB = bmq[tcl(1)];
    ATT_STORE(0, kA, vA);
    kA = *(const GAS v4u*)(kg + (size_t)tcl(2) * 64 * 256); vA = *(const GAS v4u*)(vg + tcl(2) * 64);
    ATT_BAR();
    f32x16 p0 = nb16, p1 = nb16;
    ATT_QK(0, p0, p1);
    auto step = [&](const int t, v4u& kq, v4u& vq, unsigned long long& wp) __attribute__((always_inline)) {
        const unsigned long long wcur = wp;
        if (t + 1 < nt) ATT_STORE(t + 1, kq, vq);
        ATT_BAR();
        { const int t3 = tcl(t + 3); wp = bmq[tcl(t + 2)]; kq = *(const GAS v4u*)(kg + (size_t)t3 * 64 * 256); vq = *(const GAS v4u*)(vg + t3 * 64); }
        if (t == 0 && tid == 0) nxt = (int)__hip_atomic_fetch_add(qnext, 1u, __ATOMIC_RELAXED, __HIP_MEMORY_SCOPE_AGENT);
        f32x16 n0 = nb16, n1 = nb16;
        ATT_QK(t + 1, n0, n1);
#pragma unroll
        for (int r = 0; r < 16; ++r) { p0[r] = fast_exp2(p0[r]); p1[r] = fast_exp2(p1[r]); }
        const unsigned ml = (unsigned)wcur >> (4 * hi), mh = (unsigned)(wcur >> 32) >> (4 * hi);
        unsigned pw[4][4];
#pragma unroll
        for (int g = 0; g < 4; ++g) {
            const v2u ma = *(const LAS v2u*)(mtab + (((ml >> (8 * g)) & 15u) << 3)), mb = *(const LAS v2u*)(mtab + (((mh >> (8 * g)) & 15u) << 3));
            const int r = 4 * g;
            pw[g >> 1][2 * (g & 1)] = cvtpk(p0[r], p0[r + 1]) & ma.x; pw[g >> 1][2 * (g & 1) + 1] = cvtpk(p0[r + 2], p0[r + 3]) & ma.y;
            pw[2 + (g >> 1)][2 * (g & 1)] = cvtpk(p1[r], p1[r + 1]) & mb.x; pw[2 + (g >> 1)][2 * (g & 1) + 1] = cvtpk(p1[r + 2], p1[r + 3]) & mb.y;
        }
        const LAS unsigned char* vb = lds + (t % 3) * ATT_STAGE + 64 * ATT_KP;
#pragma unroll
        for (int kk = 0; kk < 4; ++kk) {
            const bf16x8 pf = __builtin_bit_cast(bf16x8, (v4u){pw[kk][0], pw[kk][1], pw[kk][2], pw[kk][3]});
            const v2u a0 = *(const LAS v2u*)(vb + r32 * ATT_VP + (16 * kk + 4 * hi) * 2), a1 = *(const LAS v2u*)(vb + r32 * ATT_VP + (16 * kk + 4 * hi) * 2 + 16);
            const v2u c0 = *(const LAS v2u*)(vb + (32 + r32) * ATT_VP + (16 * kk + 4 * hi) * 2), c1 = *(const LAS v2u*)(vb + (32 + r32) * ATT_VP + (16 * kk + 4 * hi) * 2 + 16);
            o0 = __builtin_amdgcn_mfma_f32_32x32x16_bf16(__builtin_bit_cast(bf16x8, (v4u){a0.x, a0.y, a1.x, a1.y}), pf, o0, 0, 0, 0);
            o1 = __builtin_amdgcn_mfma_f32_32x32x16_bf16(__builtin_bit_cast(bf16x8, (v4u){c0.x, c0.y, c1.x, c1.y}), pf, o1, 0, 0, 0);
#pragma unroll
            for (int j = 0; j < 4; ++j) ls[j] = __builtin_amdgcn_fdot2_f32_bf16(__builtin_bit_cast(bf16x2_t, pw[kk][j]), __builtin_bit_cast(bf16x2_t, 0x3F803F80u), ls[j], false); }
        p0 = n0; p1 = n1;
    };
#pragma unroll 1
    for (int t = 0; t < nt; t += 2) {
        step(t, kB, vB, wA);
        if (t + 1 >= nt) break;
        step(t + 1, kA, vA, wB);
    }
#undef ATT_BAR
#undef ATT_STORE
#undef ATT_QK
    float lsum = (ls[0] + ls[1]) + (ls[2] + ls[3]); lsum += __shfl_xor(lsum, 32); const float inv = 1.0f / lsum;
    bf16* op = OB + qrow * 1024 + head * 64 + 4 * hi;
#pragma unroll
    for (int r4 = 0; r4 < 4; ++r4) {
        v2u w0, w1; w0.x = pk2(o0[4 * r4] * inv, o0[4 * r4 + 1] * inv); w0.y = pk2(o0[4 * r4 + 2] * inv, o0[4 * r4 + 3] * inv);
        w1.x = pk2(o1[4 * r4] * inv, o1[4 * r4 + 1] * inv); w1.y = pk2(o1[4 * r4 + 2] * inv, o1[4 * r4 + 3] * inv);
        *(GAS v2u*)(op + 8 * r4) = w0; *(GAS v2u*)(op + 32 + 8 * r4) = w1; }
    __syncthreads();
}

__device__ __forceinline__ void samp_scores_task(const bf16* QIB, const float* WI, const bf16* KIB, const float* cik, const int* page_table, unsigned* SKEYS, LAS float* scr, int b, int pg, int lane) {
    const size_t row = (size_t)NP + b;
    for (int i = lane; i < 512; i += 64) scr[i] = bflo((unsigned)QIB[row * 512 + i]);
    LDS_WAIT(); asm volatile("" ::: "memory");
    float wi[8];
#pragma unroll
    for (int h = 0; h < 8; ++h) wi[h] = WI[row * 8 + h];
    if (pg < NPAGE) {
        const int phys = page_table[b * NPAGE + pg];
#pragma unroll 1
        for (int rep = 0; rep < 2; ++rep) { const int kk = lane + rep * 64; const float* kr = cik + ((size_t)phys * 128 + kk) * 64; float d[8];
#pragma unroll
            for (int h = 0; h < 8; ++h) d[h] = 0.f;
#pragma unroll 4
            for (int c = 0; c < 16; ++c) { const f32x4 k4 = *(const GAS f32x4*)(kr + c * 4);
#pragma unroll
                for (int h = 0; h < 8; ++h) { const f32x4 q4 = *(const LAS f32x4*)(scr + h * 64 + c * 4); d[h] += k4[0] * q4[0] + k4[1] * q4[1] + k4[2] * q4[2] + k4[3] * q4[3]; } }
            float sc = 0.f;
#pragma unroll
            for (int h = 0; h < 8; ++h) sc += fmaxf(d[h], 0.f) * wi[h];
            SKEYS[(size_t)b * 16640 + pg * 128 + kk] = f2key(sc); }
    } else {
        const float kv = bflo((unsigned)KIB[row * 64 + lane]); float sc = 0.f;
#pragma unroll
        for (int h = 0; h < 8; ++h) { const float d = wave_sum(kv * scr[h * 64 + lane]); sc += fmaxf(d, 0.f) * wi[h]; }
        if (lane == 0) SKEYS[(size_t)b * 16640 + PAST] = f2key(sc);
    }
    LDS_WAIT(); asm volatile("" ::: "memory");
}
__device__ __forceinline__ void samp_select_attend(const unsigned* SKEYS, const bf16* QB, const bf16* KB, const bf16* V2B, const float* ck, const float* cv, const int* page_table,
                                                   bf16* OB, LAS unsigned char* lds, int b, int tid) {
    LAS int* cnt = (LAS int*)lds;
    LAS int* sl = (LAS int*)(lds + 64);
    LAS float* qs = (LAS float*)(lds + 64 + 1024);
    LAS float* lg = (LAS float*)(lds + 64 + 1024 + 4096);
    const int lane = tid & 63, w = tid >> 6; const size_t row = (size_t)NP + b; const int n = PAST + 1;
    const unsigned* kk = SKEYS + (size_t)b * 16640;
    unsigned x[33];
#pragma unroll
    for (int j = 0; j < 33; ++j) { const int s = j * 512 + tid; x[j] = (s < n) ? kk[s] : 0u; }
    for (int i = tid; i < 1024; i += NTHR) qs[i] = bflo((unsigned)QB[row * 1024 + i]);
    if (tid < 4) cnt[tid] = 0;
    __syncthreads();
    unsigned T = 0u;
#pragma unroll 1
    for (int bit = 31; bit >= 0; --bit) { const unsigned c = T | (1u << bit); int my = 0;
#pragma unroll
        for (int j = 0; j < 33; ++j) my += __builtin_popcountll(__ballot(x[j] >= c));
        if (lane == 0) atomicAdd((int*)&cnt[bit & 1], my);
        __syncthreads();
        const int tot = cnt[bit & 1]; if (tot >= 256) T = c;
        if (tid == 0) cnt[(bit + 1) & 1] = 0;
        __syncthreads(); }
    { const unsigned long long lt = lanemask_lt(lane); int cg = 0, ce = 0;
#pragma unroll
      for (int j = 0; j < 33; ++j) { cg += __builtin_popcountll(__ballot(x[j] > T)); ce += __builtin_popcountll(__ballot(x[j] == T)); }
      LAS int* wc = (LAS int*)(lds + 22656);
      if (lane == 0) { wc[w * 2] = cg; wc[w * 2 + 1] = ce; }
      __syncthreads();
      int bg = 0, be = 0, tg = 0;
      for (int ww = 0; ww < NWAVES; ++ww) { const int a_ = wc[ww * 2], e_ = wc[ww * 2 + 1]; if (ww < w) { bg += a_; be += e_; } tg += a_; }
      const int need = 256 - tg;
#pragma unroll
      for (int j = 0; j < 33; ++j) { const bool sg = x[j] > T, se = x[j] == T; const unsigned long long mg = __ballot(sg), me = __ballot(se);
          if (sg) sl[bg + __builtin_popcountll(mg & lt)] = j * 512 + tid;
          if (se) { const int r = be + __builtin_popcountll(me & lt); if (r < need) sl[tg + r] = j * 512 + tid; }
          bg += __builtin_popcountll(mg); be += __builtin_popcountll(me); } }
    __syncthreads();
    LAS int* prow = (LAS int*)(lds + 64 + 1024 + 4096 + 16384);
    if (tid < 256) { const int s = sl[tid]; prow[tid] = (s >= PAST) ? -1 : page_table[b * NPAGE + (s >> 7)] * 128 + (s & 127); }
    __syncthreads();
    { const int n_ = tid & 255, hh = tid >> 8; const int pr = prow[n_];
      float kv[2][64];
      if (pr >= 0) { const float* krf = ck + (size_t)pr * 256 + hh * 128;
#pragma unroll
          for (int i = 0; i < 32; ++i) { const f32x4 k4 = *(const GAS f32x4*)(krf + i * 4); kv[i >> 4][(i & 15) * 4] = k4[0]; kv[i >> 4][(i & 15) * 4 + 1] = k4[1]; kv[i >> 4][(i & 15) * 4 + 2] = k4[2]; kv[i >> 4][(i & 15) * 4 + 3] = k4[3]; } }
      else { const bf16* krb = KB + row * 256 + hh * 128;
#pragma unroll
          for (int i = 0; i < 128; ++i) kv[i >> 6][i & 63] = bflo((unsigned)krb[i]); }
#pragma unroll
      for (int hq = 0; hq < 8; ++hq) { const int h = hh * 8 + hq; float d = 0.f;
#pragma unroll
          for (int i = 0; i < 64; i += 4) { const f32x4 q4 = *(const LAS f32x4*)(qs + h * 64 + i); d += q4[0] * kv[hq >> 2][i] + q4[1] * kv[hq >> 2][i + 1] + q4[2] * kv[hq >> 2][i + 2] + q4[3] * kv[hq >> 2][i + 3]; }
          lg[h * 256 + n_] = d; } }
    __syncthreads();
    for (int h = w; h < 16; h += NWAVES) { float v[4]; float m = -INFINITY;
#pragma unroll
        for (int i = 0; i < 4; ++i) { v[i] = lg[h * 256 + i * 64 + lane]; m = fmaxf(m, v[i]); }
#pragma unroll
        for (int o = 1; o < 64; o <<= 1) m = fmaxf(m, __shfl_xor(m, o));
        float sum = 0.f;
#pragma unroll
        for (int i = 0; i < 4; ++i) { v[i] = fast_exp2(v[i] - m); sum += v[i]; }
        sum = wave_sum(sum); const float inv = 1.0f / sum;
#pragma unroll
        for (int i = 0; i < 4; ++i) lg[h * 256 + i * 64 + lane] = v[i] * inv; }
    __syncthreads();
    {
        LAS float* red = (LAS float*)(lds + 24576);
        const int kvh = lane >> 4, d0 = (lane & 15) * 4;
        f32x4 vr[32];
#pragma unroll
        for (int jj = 0; jj < 32; ++jj) { const int pr = prow[w * 32 + jj];
            if (pr >= 0) vr[jj] = *(const GAS f32x4*)(cv + (size_t)pr * 256 + kvh * 64 + d0);
            else { const v2u vb = *(const GAS v2u*)(V2B + row * 256 + kvh * 64 + d0); vr[jj] = (f32x4){bflo(vb.x), bfhi(vb.x), bflo(vb.y), bfhi(vb.y)}; } }
        f32x4 acc[4];
#pragma unroll
        for (int g = 0; g < 4; ++g) acc[g] = (f32x4){0.f, 0.f, 0.f, 0.f};
#pragma unroll
        for (int jj = 0; jj < 32; ++jj) {
#pragma unroll
            for (int g = 0; g < 4; ++g) acc[g] += vr[jj] * lg[(kvh * 4 + g) * 256 + w * 32 + jj]; }
#pragma unroll
        for (int g = 0; g < 4; ++g) *(LAS f32x4*)(red + w * 1024 + (kvh * 4 + g) * 64 + d0) = acc[g];
        __syncthreads();
        { const int c = tid * 2; float o0 = 0.f, o1 = 0.f;
#pragma unroll
          for (int ww = 0; ww < 8; ++ww) { const f32x2 r2 = *(const LAS f32x2*)(red + ww * 1024 + c); o0 += r2[0]; o1 += r2[1]; }
          *(GAS unsigned*)(OB + row * 1024 + c) = pk2(o0, o1); }
    }
    __syncthreads();
}

template <int K> __device__ __forceinline__ void thin_gemm_tile(const bf16* A, const bf16* Bt, int col0, LAS float* red, int tid, float& v0, float& v1) {
    const int lane = tid & 63, w = tid >> 6, r32 = lane & 31, hi = lane >> 5;
    constexpr int KS = K / 8, NS = KS / 16;
    const bf16* ap = A + (size_t)r32 * K + w * KS + hi * 8;
    const bf16* bp = Bt + (size_t)(col0 + r32) * K + w * KS + hi * 8;
    f32x16 acc = {};
    bf16x8 af[NS], bf_[NS];
#pragma unroll
    for (int i = 0; i < NS; ++i) { af[i] = *(const GAS bf16x8*)(ap + i * 16); bf_[i] = *(const GAS bf16x8*)(bp + i * 16); }
#pragma unroll
    for (int i = 0; i < NS; ++i) acc = __builtin_amdgcn_mfma_f32_32x32x16_bf16(af[i], bf_[i], acc, 0, 0, 0);
    __syncthreads();
#pragma unroll
    for (int i = 0; i < 16; ++i) red[w * 1024 + ((i & 3) + 8 * (i >> 2) + 4 * hi) * 32 + r32] = acc[i];
    __syncthreads();
    v0 = 0.f; v1 = 0.f;
#pragma unroll
    for (int ww = 0; ww < 8; ++ww) { const f32x2 t = *(const LAS f32x2*)(red + ww * 1024 + tid * 2); v0 += t[0]; v1 += t[1]; }
}
__device__ __forceinline__ float row16_sum(float v) {
    v += __shfl_xor(v, 1); v += __shfl_xor(v, 2); v += __shfl_xor(v, 4); v += __shfl_xor(v, 8); return v;
}

__global__ void __launch_bounds__(NTHR, 2) fused_fwd(Params prm) {
    extern __shared__ __attribute__((aligned(16))) unsigned char lds_raw[];
    LAS unsigned char* lds = (LAS unsigned char*)lds_raw;
    volatile LAS unsigned* MISC = (volatile LAS unsigned*)(lds + MISC_OFF);
    const int tid = threadIdx.x, lane = tid & 63, wave = __builtin_amdgcn_readfirstlane(tid >> 6);
    const int G = gridDim.x, bid = blockIdx.x;
    const int gw = bid * NWAVES + wave, NGW = G * NWAVES;
    unsigned char* ws = prm.ws;
    for (int u = tid; u < (LDS_BYTES - RING_BYTES) / 4; u += NTHR) ((LAS unsigned*)(lds + RING_BYTES))[u] = 0u;
    __syncthreads();
    XcdBarrier bar = xcd_barrier_post((unsigned*)ws + CW_BAR, MISC + 8);
    const int lo = prm.ph_lo, hi = prm.ph_hi;
#ifndef REPMASK
#define REPMASK 0
#endif
#define REP(k) (((REPMASK >> (k)) & 1) ? 2 : 1)
#ifndef DISMASK
#define DISMASK 0
#endif
#define IN(k) (lo <= (k) && (k) < hi && !((DISMASK >> (k)) & 1))
#define SEAM(k) do { if (IN(k) && IN((k) + 1)) xcd_barrier(bar); } while (0)
    const float* x_prompt = prm.in[0]; const float* x_sample = prm.in[1]; const float* cache_k = prm.in[2]; const float* cache_v = prm.in[3]; const float* cache_ik = prm.in[4];
    const int* page_table = (const int*)prm.in[5]; const float* norm_mix_g = prm.in[6]; const float* norm_ffn_g = prm.in[7];
    const float* gmlp_w_in = prm.in[8]; const float* gmlp_v_g = prm.in[9]; const float* gmlp_w_s = prm.in[10]; const float* gmlp_b_s = prm.in[11]; const float* gmlp_w_out = prm.in[12];
    const float* att_w_in = prm.in[13]; const float* att_qg = prm.in[14]; const float* att_kg = prm.in[15]; const float* att_ikg = prm.in[16]; const float* att_w_out = prm.in[17];
    const float* peer_wq = prm.in[18]; const float* peer_k1 = prm.in[19]; const float* peer_k2 = prm.in[20]; const float* peer_u = prm.in[21]; const float* peer_v = prm.in[22];
    float* out = prm.out;
    unsigned long long* SSV = (unsigned long long*)(ws + W_SSV); unsigned long long* SS1 = (unsigned long long*)(ws + W_SS1); unsigned long long* SS3 = (unsigned long long*)(ws + W_SS3); float* SS0 = (float*)(ws + W_SS0); float* SS2 = (float*)(ws + W_SS2); unsigned* QC = (unsigned*)(ws + W_QC);
    unsigned char* XQ = ws + W_XQ; float* RSX = (float*)(ws + W_RSX); float* ACT = (float*)(ws + W_ACT);
    bf16* X0B = (bf16*)(ws + W_X0B); bf16* WIN0T = (bf16*)(ws + W_WIN0T); bf16* WOUT0T = (bf16*)(ws + W_WOUT0T); bf16* WP0T = (bf16*)(ws + W_WP0T); bf16* WP1T = (bf16*)(ws + W_WP1T);
    bf16* WIN1T = (bf16*)(ws + W_WIN1T); bf16* WOUT1T = (bf16*)(ws + W_WOUT1T); float* WSMT = (float*)(ws + W_WSMT); float* ROPE = (float*)(ws + W_ROPE);
    unsigned char* U8 = ws + W_UB; unsigned char* V8 = ws + W_VB; float* SU = (float*)(ws + W_SU); float* SV = (float*)(ws + W_SV); bf16* X1B = (bf16*)(ws + W_X1B); bf16* X2B = (bf16*)(ws + W_X2B); bf16* X3B = (bf16*)(ws + W_X3B);
    bf16* U0 = (bf16*)(ws + W_U0); bf16* V0 = (bf16*)(ws + W_V0); bf16* G0 = (bf16*)(ws + W_G0); unsigned short* SH = (unsigned short*)(ws + W_BIG); bf16* PBF = (bf16*)(ws + W_BIG); unsigned short* SC = (unsigned short*)(ws + W_BIG);
    unsigned* EIDX = (unsigned*)(ws + W_EIDX); float* GATE = (float*)(ws + W_GATE);
    bf16* QB = (bf16*)(ws + W_QB); bf16* KB = (bf16*)(ws + W_KB); bf16* V2B = (bf16*)(ws + W_V2B); bf16* QIB = (bf16*)(ws + W_QIB); bf16* KIB = (bf16*)(ws + W_KIB); float* WI = (float*)(ws + W_WI);
    unsigned long long* BM = (unsigned long long*)(ws + W_SEL); bf16* VT = (bf16*)(ws + W_VT); unsigned* SKEYS = (unsigned*)(ws + W_SKEYS); bf16* OB = (bf16*)(ws + W_OB);

    if (IN(0)) for (int rep = 0; rep < REP(0); ++rep) {
        LAS float* scr = (LAS float*)(lds + wave * 16384);
        constexpr int I_X = MP, I_WIN0 = 16 * 128, I_WOUT0 = 32 * 32, I_WIN1 = 16 * 72, I_WOUT1 = 16 * 32, I_WP = 2 * 16 * 64, I_U = 2 * 16384, I_V = 2 * 16384, I_ROPE = (4097 * 32 + 63) / 64, I_WSM = 8 * 128 * 128 / 64;
        constexpr int TOTAL = I_WIN0 + I_WOUT0 + I_WIN1 + I_WOUT1 + I_WP + I_ROPE + I_WSM;
        for (int it = gw; it < TOTAL; it += NGW) {
            int r = it;
            if (r < I_WP) { const int l = r >> 10, hh = (r >> 6) & 15, jb = r & 63, h = hh >> 1, half = hh & 1;
                p0_wp_item(peer_wq + (size_t)l * 1024 * 2048, (half ? peer_k2 : peer_k1) + (size_t)l * 16384, norm_ffn_g + l * 1024, l ? WP1T : WP0T, h * 256 + half * 128, jb * 16, scr, lane); continue; } r -= I_WP;
            if (r < I_WIN0) { p0_transpose_item(gmlp_w_in, 4096, 1024, 128, 4096, norm_mix_g, WIN0T, scr, r, lane); continue; } r -= I_WIN0;
            if (r < I_WOUT0) { p0_transpose_item(gmlp_w_out, 1024, 2048, 32, 1024, nullptr, WOUT0T, scr, r, lane); continue; } r -= I_WOUT0;
            if (r < I_WIN1) { p0_transpose_item(att_w_in, APROJ, 1024, 72, APROJ, norm_mix_g + 1024, WIN1T, scr, r, lane); continue; } r -= I_WIN1;
            if (r < I_WOUT1) { p0_transpose_item(att_w_out, 1024, 1024, 32, 1024, nullptr, WOUT1T, scr, r, lane); continue; } r -= I_WOUT1;
            if (r < I_ROPE) { const int i = r * 64 + lane; if (i < 4097 * 32) { const int p = i >> 5, d = i & 31; const float pos = (p < 4096) ? (float)p : 16384.0f;
                    const float ang = pos * prm.inv[d]; const double rev = (double)ang * 0.15915494309189535; const float fr = (float)(rev - floor(rev));
                    ROPE[p * 64 + d] = __builtin_amdgcn_cosf(fr); ROPE[p * 64 + 32 + d] = __builtin_amdgcn_sinf(fr); } continue; } r -= I_ROPE;
            { const int e = r * 64 + lane, t = (e >> 7) & 127, s = e & 127; ((unsigned short*)WSMT)[e] = (unsigned short)((s <= t) ? (cvtpk(gmlp_w_s[e], 0.f) & 0xffffu) : 0u); }
        }
        {
            auto xsrc = [&](int r) { return r < NP ? x_prompt + (size_t)r * 1024 : (r < NT ? x_sample + (size_t)(r - NP) * 1024 : (const float*)nullptr); };
            RowIn A, B; int r = gw; if (r < I_X) p0_rowx_load(A, xsrc(r), lane);
            for (; r < I_X; r += 2 * NGW) {
                if (r + NGW < I_X) p0_rowx_load(B, xsrc(r + NGW), lane);
                { const float sq = p0_rowx_store(A, X0B + (size_t)r * 1024, lane); if (lane == 0) SS0[r] = sq; }
                if (r + NGW >= I_X) break;
                if (r + 2 * NGW < I_X) p0_rowx_load(A, xsrc(r + 2 * NGW), lane);
                { const float sq = p0_rowx_store(B, X0B + (size_t)(r + NGW) * 1024, lane); if (lane == 0) SS0[r + NGW] = sq; } } }
        {
            RowIn A, B; int r = gw;
            auto qsrc = [&](int q) { return q < I_U ? peer_u + (size_t)q * 1024 : peer_v + (size_t)(q - I_U) * 1024; };
            auto qst = [&](const RowIn& R, int q) { if (q < I_U) p0_rowq_store(R, norm_ffn_g + (q >> 14) * 1024, U8 + (size_t)q * 1024, SU + q, lane, false, 0);
                                                    else { const int v = q - I_U; p0_rowq_store(R, nullptr, V8 + (size_t)(v >> 14) * 16384 * 1024, SV + v, lane, true, v & 16383); } };
            if (r < I_U + I_V) p0_rowq_load(A, qsrc(r), lane);
            for (; r < I_U + I_V; r += 2 * NGW) {
                if (r + NGW < I_U + I_V) p0_rowq_load(B, qsrc(r + NGW), lane);
                qst(A, r);
                if (r + NGW >= I_U + I_V) break;
                if (r + 2 * NGW < I_U + I_V) p0_rowq_load(A, qsrc(r + 2 * NGW), lane);
                qst(B, r + NGW); } }
    }
    SEAM(0);
    if (IN(1)) for (int rep = 0; rep < REP(1); ++rep) { pg8::Gemm g{X0B, WIN0T, NP, 4096, 1024}; pg8::StaticOrder S; S.init(NP, 4096, G, bid); pg8::EpiUV E{U0, V0, SS0, SSV, rep == 0};
        pg8::gemm_phase<pg8::EpiUV, pg8::StaticOrder, true, true>(lds, g, S, E);
        for (int tk = bid; tk < 4096 / 32; tk += G) { float v0, v1; thin_gemm_tile<1024>(X0B + (size_t)NP * 1024, WIN0T, tk * 32, (LAS float*)lds, tid, v0, v1);
            const int r = tid >> 4, row = NP + r, col = tk * 32 + 2 * (tid & 15); const float rs = rsqrtf(SS0[row] * (1.0f / 1024.0f) + EPS); v0 *= rs; v1 *= rs;
            if (col < 2048) *(GAS unsigned*)(U0 + (size_t)row * 2048 + col) = pk2(v0, v1);
            else { *(GAS unsigned*)(V0 + (size_t)row * 2048 + col - 2048) = pk2(v0, v1); const float sq = row16_sum(v0 * v0 + v1 * v1); if ((tid & 15) == 0 && rep == 0) pg8::ss_add(SSV + row, sq); } } }
    SEAM(1);
    if (IN(2)) for (int rep = 0; rep < REP(2); ++rep) {
        typedef short s16x4_t __attribute__((ext_vector_type(4)));
        LAS float* rvs = (LAS float*)(lds + 98304); LAS unsigned char* slab = lds + wave * 8192; LAS float* vgl = (LAS float*)(lds + 65536 + wave * 1024);
        const int c = tid * 4, g = wave, r32 = lane & 31, hi = lane >> 5;
        for (int unit = bid; unit < 256; unit += G) {
            const int row0 = unit * 128;
            __syncthreads();
            { int tl = tid; asm volatile("" : "+v"(tl));
              if (tl < 128) rvs[tl] = rsqrtf(pg8::ss_get(SSV + row0 + tl) * (1.0f / 2048.0f) + EPS);
              for (int i = tl & 63; i < 256; i += 64) vgl[i] = gmlp_v_g[g * 256 + i]; }
            __syncthreads();
            const __amdgpu_buffer_rsrc_t rV = __builtin_amdgcn_make_buffer_rsrc((void*)V0, 0, 0x7fffffff, 0x00020000), rU = __builtin_amdgcn_make_buffer_rsrc((void*)U0, 0, 0x7fffffff, 0x00020000), rG = __builtin_amdgcn_make_buffer_rsrc((void*)G0, 0, 0x7fffffff, 0x00020000);
            const unsigned voffv = (unsigned)(((lane >> 2) * 2048 + g * 256 + (lane & 3) * 8) * 2), voffu = (unsigned)((r32 * 2048 + g * 256 + 4 * hi) * 2);
            const __amdgpu_buffer_rsrc_t rW = __builtin_amdgcn_make_buffer_rsrc((void*)WSMT, 0, 0x7fffffff, 0x00020000); const unsigned voffw = (unsigned)((r32 * 128 + 8 * hi) * 2); const int gs = __builtin_amdgcn_readfirstlane(g);
            v4u pv[8]; v2u pu[16];
#pragma unroll
            for (int i = 0; i < 8; ++i) pv[i] = __builtin_amdgcn_raw_buffer_load_b128(rV, voffv, (row0 + 16 * i) * 4096, 0);
#pragma unroll
            for (int j = 0; j < 16; ++j) pu[j] = __builtin_amdgcn_raw_buffer_load_b64(rU, voffu, (row0 + 32 * (j >> 2)) * 4096 + 16 * (j & 3), 0);
            bf16x8 wf[20]; float bias[4], rv8[8];
#pragma unroll
            for (int i = 0; i < 8; ++i) rv8[i] = rvs[(lane >> 2) + 16 * i];
#pragma unroll
            for (int tb = 0; tb < 4; ++tb) { bias[tb] = gmlp_b_s[g * 128 + tb * 32 + r32];
#pragma unroll
                for (int kk = 0; kk < 2 * tb + 2; ++kk) wf[tb * (tb + 1) + kk] = __builtin_bit_cast(bf16x8, __builtin_amdgcn_raw_buffer_load_b128(rW, voffw, (gs * 128 + tb * 32) * 256 + kk * 32, 0)); }
            LAS unsigned char* trp = slab + (8 * hi + ((lane & 15) >> 2)) * 64 + (((lane >> 4) & 1) * 16 + (lane & 3) * 4) * 2;
#pragma unroll 1
            for (int cb = 0; cb < 8; ++cb) {
#pragma unroll
                for (int i = 0; i < 8; ++i) { const float rv = rv8[i]; v4u w; w.x = cvtpk(bflo(pv[i].x) * rv, bfhi(pv[i].x) * rv); w.y = cvtpk(bflo(pv[i].y) * rv, bfhi(pv[i].y) * rv); w.z = cvtpk(bflo(pv[i].z) * rv, bfhi(pv[i].z) * rv); w.w = cvtpk(bflo(pv[i].w) * rv, bfhi(pv[i].w) * rv);
                    *(LAS v4u*)(slab + ((lane >> 2) + 16 * i) * 64 + (lane & 3) * 16) = w; }
                if (cb + 1 < 8) {
#pragma unroll
                    for (int i = 0; i < 8; ++i) pv[i] = __builtin_amdgcn_raw_buffer_load_b128(rV, voffv, (row0 + 16 * i) * 4096 + (cb + 1) * 64, 0); }
                LDS_WAIT(); asm volatile("" ::: "memory");
                bf16x8 af[8];
#pragma unroll
                for (int kk = 0; kk < 8; ++kk) { const s16x4_t lo = __builtin_amdgcn_ds_read_tr16_b64_v4i16((LAS s16x4_t*)(trp + kk * 1024)), h4 = __builtin_amdgcn_ds_read_tr16_b64_v4i16((LAS s16x4_t*)(trp + kk * 1024 + 256));
                    af[kk] = (bf16x8){lo[0], lo[1], lo[2], lo[3], h4[0], h4[1], h4[2], h4[3]}; }
#pragma unroll
                for (int tb = 0; tb < 4; ++tb) { f32x16 acc = {};
#pragma unroll
                    for (int kk = 0; kk < 2 * tb + 2; ++kk) acc = __builtin_amdgcn_mfma_f32_32x32x16_bf16(af[kk], wf[tb * (tb + 1) + kk], acc, 0, 0, 0);
#pragma unroll
                    for (int i4 = 0; i4 < 4; ++i4) { const f32x4 vg = *(const LAS f32x4*)(vgl + cb * 32 + 8 * i4 + 4 * hi); const v2u uu = pu[tb * 4 + i4];
                        const float o0 = bflo(uu.x) * (acc[4 * i4] * vg[0] + bias[tb]), o1 = bfhi(uu.x) * (acc[4 * i4 + 1] * vg[1] + bias[tb]), o2 = bflo(uu.y) * (acc[4 * i4 + 2] * vg[2] + bias[tb]), o3 = bfhi(uu.y) * (acc[4 * i4 + 3] * vg[3] + bias[tb]);
                        v2u w; w.x = pk2(o0, o1); w.y = pk2(o2, o3); __builtin_amdgcn_raw_buffer_store_b64(w, rG, voffu, (row0 + 32 * tb) * 4096 + cb * 64 + 16 * i4, 0); }
                    __builtin_amdgcn_sched_barrier(0); }
                if (cb + 1 < 8) {
#pragma unroll
                    for (int j = 0; j < 16; ++j) pu[j] = __builtin_amdgcn_raw_buffer_load_b64(rU, voffu, (row0 + 32 * (j >> 2)) * 4096 + (cb + 1) * 64 + 16 * (j & 3), 0); }
                LDS_WAIT(); asm volatile("" ::: "memory");
            }
        }
        for (int r = bid; r < MP - NP; r += G) {
            const int row = NP + r; const float rv = rsqrtf(pg8::ss_get(SSV + row) * (1.0f / 2048.0f) + EPS); const f32x4 vg = *(const GAS f32x4*)(gmlp_v_g + c);
            const v2u vv = *(const GAS v2u*)(V0 + (size_t)row * 2048 + c); const v2u uu = *(const GAS v2u*)(U0 + (size_t)row * 2048 + c);
            const float w00 = gmlp_w_s[(size_t)g * 16384], bias = gmlp_b_s[g * 128];
            const float n0 = bflo(vv.x) * rv * vg[0], n1 = bfhi(vv.x) * rv * vg[1], n2 = bflo(vv.y) * rv * vg[2], n3 = bfhi(vv.y) * rv * vg[3];
            v2u w; w.x = pk2(bflo(uu.x) * (w00 * n0 + bias), bfhi(uu.x) * (w00 * n1 + bias)); w.y = pk2(bflo(uu.y) * (w00 * n2 + bias), bfhi(uu.y) * (w00 * n3 + bias));
            *(GAS v2u*)(G0 + (size_t)row * 2048 + c) = w;
            if (r < NS) *(GAS f32x4*)(out + O_CV + (size_t)r * 2048 + c) = (f32x4){n0, n1, n2, n3};
        }
    }
    SEAM(2);
    if (IN(3)) for (int rep = 0; rep < REP(3); ++rep) { pg8::Gemm g{G0, WOUT0T, NP, 1024, 2048}; pg8::StaticOrder S; S.init(NP, 1024, G, bid); pg8::EpiResid<false> E{x_prompt, x_sample, X1B, SS1, NP, NT, rep == 0};
        pg8::gemm_phase<pg8::EpiResid<false>, pg8::StaticOrder, true, true>(lds, g, S, E);
        for (int tk = bid; tk < 1024 / 32; tk += G) { float v0, v1; thin_gemm_tile<2048>(G0 + (size_t)NP * 2048, WOUT0T, tk * 32, (LAS float*)lds, tid, v0, v1);
            const int r = tid >> 4, row = NP + r, col = tk * 32 + 2 * (tid & 15); const f32x2 xr = *(const GAS f32x2*)(x_sample + (size_t)r * 1024 + col); v0 += xr[0]; v1 += xr[1];
            *(GAS unsigned*)(X1B + (size_t)row * 1024 + col) = pk2(v0, v1); const float sq = row16_sum(v0 * v0 + v1 * v1); if ((tid & 15) == 0 && rep == 0) pg8::ss_add(SS1 + row, sq); } }
    SEAM(3);
    if (IN(4)) for (int rep = 0; rep < REP(4); ++rep) { pg8::Gemm g{X1B, WP0T, NP, 2048, 1024};
        if (G == 256) {
            const EpiRoute ER{SS1, EIDX, GATE};
            { OneUnit S1; S1.init(NP, 2048, G, bid); S1.k = 0; pg8::gemm_phase<EpiRoute, OneUnit, false, true>(lds, g, S1, ER); }
            { OneUnit S1; S1.init(NP, 2048, G, bid); S1.k = 1; pg8::gemm_phase<EpiRoute, OneUnit, false, true>(lds, g, S1, ER); }
            { OneUnit S1; S1.init(NP, 2048, G, bid); S1.k = 2; pg8::gemm_phase<EpiRoute, OneUnit, false, true>(lds, g, S1, ER); }
            { OneUnit S1; S1.init(NP, 2048, G, bid); S1.k = 3; pg8::gemm_phase<EpiRoute, OneUnit, false, true>(lds, g, S1, ER); }
        } else { pg8::StaticOrder S; S.init(NP, 2048, G, bid); pg8::EpiScaleF16 E{SH, 2048, SS1};
            pg8::gemm_phase<pg8::EpiScaleF16, pg8::StaticOrder, true, true>(lds, g, S, E); }
        for (int tk = bid; tk < 2048 / 32; tk += G) { float v0, v1; thin_gemm_tile<1024>(X1B + (size_t)NP * 1024, WP0T, tk * 32, (LAS float*)lds, tid, v0, v1);
            const int r = tid >> 4, row = NP + r, col = tk * 32 + 2 * (tid & 15); const float rs = rsqrtf(pg8::ss_get(SS1 + row) * (1.0f / 1024.0f) + EPS);
            *(GAS unsigned*)(SH + (size_t)row * 2048 + col) = pg8::EpiScaleF16::pkh(v0 * rs, v1 * rs); } }
    SEAM(4);
    if (IN(5)) for (int rep = 0; rep < REP(5); ++rep) { { RouteIn RA, RB; int task = gw + (G == 256 ? NP * 2 : 0); if (task < NT * 2) peer_route_load(RA, SH, task, lane);
          for (; task < NT * 2; task += 2 * NGW) {
              if (task + NGW < NT * 2) peer_route_load(RB, SH, task + NGW, lane);
              peer_route_task(RA, EIDX, GATE, task, lane);
              if (task + NGW >= NT * 2) break;
              if (task + 2 * NGW < NT * 2) peer_route_load(RA, SH, task + 2 * NGW, lane);
              peer_route_task(RB, EIDX, GATE, task + NGW, lane); } }
        { XqIn QA, QB2; int tok = gw; if (tok < NT) peer_xq_load(QA, X1B, SS1, tok, lane);
          for (; tok < NT; tok += 2 * NGW) {
              if (tok + NGW < NT) peer_xq_load(QB2, X1B, SS1, tok + NGW, lane);
              peer_xq_token(QA, XQ, RSX, tok, lane);
              if (tok + NGW >= NT) break;
              if (tok + 2 * NGW < NT) peer_xq_load(QA, X1B, SS1, tok + 2 * NGW, lane);
              peer_xq_token(QB2, XQ, RSX, tok + NGW, lane); } } }
    SEAM(5);
    if (IN(6)) {
        LAS unsigned* lst = (LAS unsigned*)(lds + wave * 9216);
        PEER_QLOOP_CHUNK(QC + 0 * 512, peer_e1_chunk(XQ, RSX, EIDX, GATE, U8, SU, SV, ACT, lst, t0, t1, pi, lane));
        if (REP(6) == 2) PEER_QLOOP_CHUNK(QC + 4 * 512, peer_e1_chunk(XQ, RSX, EIDX, GATE, U8, SU, SV, ACT, lst, t0, t1, pi, lane));
        xcd_barrier(bar);
        if (REP(16) == 2) PEER_QLOOP_CHUNK(QC + 5 * 512, peer_e2_chunk<true>(X1B, EIDX, ACT, V8, nullptr, X2B, SS2, t0, t1, pi, lane));
        PEER_QLOOP_CHUNK(QC + 1 * 512, peer_e2_chunk<true>(X1B, EIDX, ACT, V8, nullptr, X2B, SS2, t0, t1, pi, lane));
        for (int r = NT + gw; r < MP; r += NGW) { (void)p0_row(nullptr, nullptr, X2B + (size_t)r * 1024, lane); if (lane < 8) SS2[(size_t)lane * MP + r] = 0.f; } }
    SEAM(6);
    if (IN(7)) for (int rep = 0; rep < REP(7); ++rep) { pg8::Gemm g{X2B, WIN1T, NP, APAD, 1024}; pg8::StaticOrder S; S.init(NP, APAD, G, bid); pg8::EpiScaleBf16 E{PBF, APAD, SS2, 8, MP};
        pg8::gemm_phase<pg8::EpiScaleBf16, pg8::StaticOrder, true, true>(lds, g, S, E);
        for (int tk = bid; tk < APAD / 32; tk += G) { float v0, v1; thin_gemm_tile<1024>(X2B + (size_t)NP * 1024, WIN1T, tk * 32, (LAS float*)lds, tid, v0, v1);
            const int r = tid >> 4, row = NP + r, col = tk * 32 + 2 * (tid & 15); float sa = 0.f;
#pragma unroll
            for (int pp = 0; pp < 8; ++pp) sa += SS2[(size_t)pp * MP + row];
            const float rs = rsqrtf(sa * (1.0f / 1024.0f) + EPS); *(GAS unsigned*)(PBF + (size_t)row * APAD + col) = pk2(v0 * rs, v1 * rs); } }
    SEAM(7);
    if (IN(8)) for (int rep = 0; rep < REP(8); ++rep) { { const float gq = att_qg[lane], gk = att_kg[lane], gik = att_ikg[lane]; PostRow RA, RB;
            int row = gw; if (row < NT) att_post_load(RA, PBF, row, lane);
            for (; row < NT; row += 2 * NGW) {
                if (row + NGW < NT) att_post_load(RB, PBF, row + NGW, lane);
                att_post_compute(RA, gq, gk, gik, ROPE, QB, KB, V2B, QIB, KIB, WI, out, row, lane);
                if (row + NGW >= NT) break;
                if (row + 2 * NGW < NT) att_post_load(RA, PBF, row + 2 * NGW, lane);
                att_post_compute(RB, gq, gk, gik, ROPE, QB, KB, V2B, QIB, KIB, WI, out, row + NGW, lane);
            } }
        for (int grp = gw; grp < NP / 8; grp += NGW) {
            const int row0 = grp * 8, b = row0 >> 12, t0 = row0 & 4095;
#pragma unroll
            for (int i = 0; i < 4; ++i) { unsigned v[8];
#pragma unroll
                for (int tt = 0; tt < 8; ++tt) v[tt] = (unsigned)PBF[(size_t)(row0 + tt) * APAD + 1280 + i * 64 + lane];
                v4u w; w.x = v[0] | (v[1] << 16); w.y = v[2] | (v[3] << 16); w.z = v[4] | (v[5] << 16); w.w = v[6] | (v[7] << 16);
                *(GAS v4u*)(VT + ((size_t)b * 256 + i * 64 + lane) * SEQ + t0) = w; } } }
    SEAM(8);
    if (IN(9)) for (int rep = 0; rep < REP(9); ++rep) {
        for (int w = gw; w < 2048; w += NGW) { const int b = w >> 8, half = (w >> 7) & 1, p = w & 127;
#pragma unroll 1
            for (int rep = 0; rep < 2; ++rep) { const int qb = rep ? 255 - p : p, nk = qb + 1; idx_scores_task(QIB, KIB, WI, SC, b, qb, (half * nk) >> 1, ((half + 1) * nk) >> 1, lane); } }
        LAS float* scr = (LAS float*)(lds + wave * 4096);
        for (int w = gw; w < NS * 129; w += NGW) samp_scores_task(QIB, WI, KIB, cache_ik, page_table, SKEYS, scr, w / 129, w % 129, lane);
    }
    SEAM(9);
    if (IN(10)) for (int rep = 0; rep < REP(10); ++rep) { unsigned raw[64], x[64];
        int p = gw; if (p < 8 * 2048) select_load(raw, SC, (p >> 11) * 4096 + (p & 2047), lane);
        for (; p < 8 * 2048; p += NGW) { const int rA = (p >> 11) * 4096 + (p & 2047), rB = (p >> 11) * 4096 + 4095 - (p & 2047);
            select_keys(x, raw, rA, lane); select_load(raw, SC, rB, lane); select_run(x, BM, rA, lane);
            select_keys(x, raw, rB, lane); if (p + NGW < 8 * 2048) select_load(raw, SC, ((p + NGW) >> 11) * 4096 + ((p + NGW) & 2047), lane); select_run(x, BM, rB, lane); } }
    SEAM(10);
    if (IN(11)) for (int rep = 0; rep < REP(11); ++rep) {
        for (int b = bid; b < NS; b += G) samp_select_attend(SKEYS, QB, KB, V2B, cache_k, cache_v, page_table, OB, lds, b, tid);
        __syncthreads();
        { float mq = fabsf(att_qg[lane]), mkk = fabsf(att_kg[lane]);
#pragma unroll
          for (int o = 1; o < 64; o <<= 1) { mq = fmaxf(mq, __shfl_xor(mq, o)); mkk = fmaxf(mkk, __shfl_xor(mkk, o)); }
          const float nbound = -(QSCALE * 64.0f * mq * mkk);
          if (tid < 16) { LAS unsigned* mt = (LAS unsigned*)(lds + 3 * ATT_STAGE + 64); mt[2 * tid] = ((tid & 1) ? 0xFFFFu : 0u) | ((tid & 2) ? 0xFFFF0000u : 0u); mt[2 * tid + 1] = ((tid & 4) ? 0xFFFFu : 0u) | ((tid & 8) ? 0xFFFF0000u : 0u); }
          __syncthreads();
          unsigned* qa = QC + 6 * 512; const int home = (int)(xb_xcc_id() & 7u); LAS int* tkp = (LAS int*)(lds + 3 * ATT_STAGE);
#pragma unroll 1
          for (int k = 0; k < 8; ++k) { const int pi = (home + k) & 7; unsigned* qh = qa + pi * 64;
              int nxt = 0; if (tid == 0) nxt = (int)__hip_atomic_fetch_add(qh, 1u, __ATOMIC_RELAXED, __HIP_MEMORY_SCOPE_AGENT);
#pragma unroll 1
              for (;;) { if (tid == 0) *tkp = nxt; __syncthreads(); const int c = __builtin_amdgcn_readfirstlane(*tkp);
                  if (c >= 256) break;
                  const int bk = pi * 4 + (c & 3), qt = 63 - (c >> 2); attend_unit(QB, KB, VT, BM, OB, lds, bk >> 2, bk & 3, qt, nbound, tid, qh, nxt); }
              __syncthreads(); } }
        for (int r = NT + gw; r < MP; r += NGW) (void)p0_row(nullptr, nullptr, OB + (size_t)r * 1024, lane);
    }
    SEAM(11);
    if (IN(12)) for (int rep = 0; rep < REP(12); ++rep) { pg8::Gemm g{OB, WOUT1T, NP, 1024, 1024}; pg8::StaticOrder S; S.init(NP, 1024, G, bid); pg8::EpiResid<true> E{X2B, nullptr, X3B, SS3, NP, NT, rep == 0};
        pg8::gemm_phase<pg8::EpiResid<true>, pg8::StaticOrder, true, true>(lds, g, S, E);
        for (int tk = bid; tk < 1024 / 32; tk += G) { float v0, v1; thin_gemm_tile<1024>(OB + (size_t)NP * 1024, WOUT1T, tk * 32, (LAS float*)lds, tid, v0, v1);
            const int r = tid >> 4, row = NP + r, col = tk * 32 + 2 * (tid & 15); const unsigned xr = *(const GAS unsigned*)(X2B + (size_t)row * 1024 + col); v0 += bflo(xr); v1 += bfhi(xr);
            *(GAS unsigned*)(X3B + (size_t)row * 1024 + col) = pk2(v0, v1); const float sq = row16_sum(v0 * v0 + v1 * v1); if ((tid & 15) == 0 && rep == 0) pg8::ss_add(SS3 + row, sq); } }
    SEAM(12);
    if (IN(13)) for (int rep = 0; rep < REP(13); ++rep) { pg8::Gemm g{X3B, WP1T, NP, 2048, 1024};
        if (G == 256) {
            const EpiRoute ER{SS3, EIDX, GATE};
            { OneUnit S1; S1.init(NP, 2048, G, bid); S1.k = 0; pg8::gemm_phase<EpiRoute, OneUnit, false, true>(lds, g, S1, ER); }
            { OneUnit S1; S1.init(NP, 2048, G, bid); S1.k = 1; pg8::gemm_phase<EpiRoute, OneUnit, false, true>(lds, g, S1, ER); }
            { OneUnit S1; S1.init(NP, 2048, G, bid); S1.k = 2; pg8::gemm_phase<EpiRoute, OneUnit, false, true>(lds, g, S1, ER); }
            { OneUnit S1; S1.init(NP, 2048, G, bid); S1.k = 3; pg8::gemm_phase<EpiRoute, OneUnit, false, true>(lds, g, S1, ER); }
        } else { pg8::StaticOrder S; S.init(NP, 2048, G, bid); pg8::EpiScaleF16 E{SH, 2048, SS3};
            pg8::gemm_phase<pg8::EpiScaleF16, pg8::StaticOrder, true, true>(lds, g, S, E); }
        for (int tk = bid; tk < 2048 / 32; tk += G) { float v0, v1; thin_gemm_tile<1024>(X3B + (size_t)NP * 1024, WP1T, tk * 32, (LAS float*)lds, tid, v0, v1);
            const int r = tid >> 4, row = NP + r, col = tk * 32 + 2 * (tid & 15); const float rs = rsqrtf(pg8::ss_get(SS3 + row) * (1.0f / 1024.0f) + EPS);
            *(GAS unsigned*)(SH + (size_t)row * 2048 + col) = pg8::EpiScaleF16::pkh(v0 * rs, v1 * rs); } }
    SEAM(13);
    if (IN(14)) for (int rep = 0; rep < REP(14); ++rep) { { RouteIn RA, RB; int task = gw + (G == 256 ? NP * 2 : 0); if (task < NT * 2) peer_route_load(RA, SH, task, lane);
          for (; task < NT * 2; task += 2 * NGW) {
              if (task + NGW < NT * 2) peer_route_load(RB, SH, task + NGW, lane);
              peer_route_task(RA, EIDX, GATE, task, lane);
              if (task + NGW >= NT * 2) break;
              if (task + 2 * NGW < NT * 2) peer_route_load(RA, SH, task + 2 * NGW, lane);
              peer_route_task(RB, EIDX, GATE, task + NGW, lane); } }
        { XqIn QA, QB2; int tok = gw; if (tok < NT) peer_xq_load(QA, X3B, SS3, tok, lane);
          for (; tok < NT; tok += 2 * NGW) {
              if (tok + NGW < NT) peer_xq_load(QB2, X3B, SS3, tok + NGW, lane);
              peer_xq_token(QA, XQ, RSX, tok, lane);
              if (tok + NGW >= NT) break;
              if (tok + 2 * NGW < NT) peer_xq_load(QA, X3B, SS3, tok + 2 * NGW, lane);
              peer_xq_token(QB2, XQ, RSX, tok + NGW, lane); } } }
    SEAM(14);
    if (IN(15)) {
        LAS unsigned* lst = (LAS unsigned*)(lds + wave * 9216);
        PEER_QLOOP_CHUNK(QC + 2 * 512, peer_e1_chunk(XQ, RSX, EIDX, GATE, U8 + (size_t)16384 * 1024, SU + 16384, SV + 16384, ACT, lst, t0, t1, pi, lane));
        xcd_barrier(bar);
        PEER_QLOOP_CHUNK(QC + 3 * 512, peer_e2_chunk<false>(X3B, EIDX, ACT, V8 + (size_t)16384 * 1024, out + O_Y, nullptr, nullptr, t0, t1, pi, lane)); }
#undef IN
#undef SEAM
}
constexpr int N_PHASES = 16;
}


extern "C" void kernel_launch(void* const* d_in, const int* in_sizes, int n_in, void* d_out, int out_size, void* d_ws, size_t ws_size, hipStream_t stream) {
    using namespace mk;
    static int grid = 0;
    if (grid == 0) {
        int dev = 0, cus = 0;
        if (hipGetDevice(&dev) != hipSuccess || hipDeviceGetAttribute(&cus, hipDeviceAttributeMultiprocessorCount, dev) != hipSuccess) { fprintf(stderr, "kernel_launch: device query failed\n"); grid = -1; return; }
        if (hipFuncSetAttribute((const void*)fused_fwd, hipFuncAttributeMaxDynamicSharedMemorySize, LDS_BYTES) != hipSuccess) { fprintf(stderr, "kernel_launch: hipFuncSetAttribute failed\n"); grid = -1; return; }
        int per_cu = 0;
        if (hipOccupancyMaxActiveBlocksPerMultiprocessor(&per_cu, (const void*)fused_fwd, NTHR, LDS_BYTES) != hipSuccess || per_cu < 1) fprintf(stderr, "kernel_launch: occupancy query says %d\n", per_cu);
        (void)hipGetLastError();
        grid = cus;
        if (ws_size < W_END) { fprintf(stderr, "kernel_launch: workspace too small (%zu < %zu)\n", ws_size, (size_t)W_END); grid = -1; return; }
    }
    if (grid < 0) return;
    (void)hipMemsetAsync(d_ws, 0, CTL_BYTES, stream);
    Params p{};
    for (int i = 0; i < 23; ++i) p.in[i] = (const float*)d_in[i];
    p.out = (float*)d_out; p.ws = (unsigned char*)d_ws;
    for (int i = 0; i < 32; ++i) p.inv[i] = (float)exp(-log(10000.0) * (double)i / 32.0);
    p.ph_lo = 0; p.ph_hi = N_PHASES;
    hipLaunchKernelGGL(fused_fwd, dim3(grid), dim3(NTHR), LDS_BYTES, stream, p);
}
```

```cpp
#include <hip/hip_runtime.h>
#include <cstdio>
#include <cstdint>
#include <math.h>
namespace pg8 {
#define PG8_LAS __attribute__((address_space(3)))
typedef unsigned short bf16_t;
typedef short bf16x8 __attribute__((ext_vector_type(8)));
typedef float f32x4 __attribute__((ext_vector_type(4)));
typedef unsigned u32x4 __attribute__((ext_vector_type(4)));
constexpr int BM = 256, BK = 64, HALF = 128, HTB = HALF * BK * 2  , STAGE_BYTES = 8 * HTB, NXCD = 8, WGM = 8;

__host__ __device__ __forceinline__ int lds_byte(int r, int c) { const int st = (r >> 4) * 2 + (c >> 5), rr = r & 15, cc = c & 31, ob = rr * 64 + cc * 2; return st * 1024 + (ob ^ (((ob >> 9) & 1) << 5)); }
__host__ __device__ __forceinline__ void stage_rc(int b, int& R, int& C) { const int st = b / 1024, sb = b % 1024, swz = sb ^ (((sb >> 9) & 1) << 5); R = (st >> 1) * 16 + swz / 64; C = (st & 1) * 32 + (swz % 64) / 2; }
__host__ __device__ __forceinline__ int perm32(int rho) { const int n = rho >> 4, i = rho & 15; return 8 * (i >> 2) + 4 * n + (i & 3); }

struct Unit { int pm, pn; };
struct Gemm { const bf16_t* A; const bf16_t* Bt; int M, N, K; };

struct StaticOrder {
    int nM, nN, nwg, G, c;
    __host__ __device__ void init(int M, int N, int G_, int c_) { nM = M / BM; nN = N / BM; nwg = nM * nN; G = G_; c = c_; }
    __host__ __device__ bool next(int i, Unit& u) const {
        const long L = (long)i * G + c; if (L >= nwg) return false;
        int wgid = (int)L; { const int q = nwg / NXCD, r = nwg % NXCD, xcd = wgid % NXCD, off = wgid / NXCD; wgid = (xcd < r ? xcd * (q + 1) : r * (q + 1) + (xcd - r) * q) + off; }
        const int nig = WGM * nN, gid = wgid / nig, fm = gid * WGM, gsz = (nM - fm) < WGM ? (nM - fm) : WGM;
        u.pm = fm + ((wgid % nig) % gsz); u.pn = (wgid % nig) / gsz; return true;
    }
    __device__ __forceinline__ void a_ready(const Unit&) const {}
    __device__ __forceinline__ void done(const Unit&) const {}
};

__device__ __forceinline__ unsigned cvt_pk_bf16(float lo, float hi) { unsigned r; asm volatile("v_cvt_pk_bf16_f32 %0, %1, %2" : "=v"(r) : "v"(lo), "v"(hi)); return r; }
typedef float f32x2 __attribute__((ext_vector_type(2)));

__device__ __forceinline__ void ss_add(unsigned long long* p, float sq) { (void)__hip_atomic_fetch_add(p, (unsigned long long)(sq * 16777216.0f), __ATOMIC_RELAXED, __HIP_MEMORY_SCOPE_AGENT); }
__device__ __forceinline__ float ss_get(const unsigned long long* p) { return (float)*p * (1.0f / 16777216.0f); }
struct EpiUV { static constexpr bool PERM = true, AFTER_DRAIN = false;
    bf16_t* U; bf16_t* V; const float* ss0; unsigned long long* ssv; int do_at;
    __device__ __forceinline__ void operator()(const f32x4 (&acc)[2][2][4][2], const Unit& u, int wr, int wc, int fr, int fq) const {
        const int row0 = u.pm * BM + wr * 64 + fr; const bool isv = u.pn >= 8; bf16_t* base = isv ? V : U;
        const int col0 = (u.pn & 7) * BM + wc * 32 + 8 * fq;
#pragma unroll
        for (int ai = 0; ai < 2; ++ai)
#pragma unroll
            for (int m = 0; m < 4; ++m) { const int row = row0 + ai * HALF + m * 16; const float rs = rsqrtf(ss0[row] * (1.0f / 1024.0f) + 1e-6f); float sq = 0.f;
                bf16_t* rowp = base + (size_t)row * 2048 + col0;
#pragma unroll
                for (int bj = 0; bj < 2; ++bj) { const f32x4 v0 = acc[ai][bj][m][0] * rs, v1 = acc[ai][bj][m][1] * rs;
                    sq += (v0[0] * v0[0] + v0[1] * v0[1]) + (v0[2] * v0[2] + v0[3] * v0[3]) + (v1[0] * v1[0] + v1[1] * v1[1]) + (v1[2] * v1[2] + v1[3] * v1[3]);
                    u32x4 w; w.x = cvt_pk_bf16(v0[0], v0[1]); w.y = cvt_pk_bf16(v0[2], v0[3]); w.z = cvt_pk_bf16(v1[0], v1[1]); w.w = cvt_pk_bf16(v1[2], v1[3]);
                    *(u32x4*)(rowp + bj * HALF) = w; }
                if (isv) { sq += __shfl_xor(sq, 16); sq += __shfl_xor(sq, 32); if (fq == 0 && do_at) ss_add(ssv + row, sq); } }
    }
};
template <bool RB16> struct EpiResid { static constexpr bool PERM = true, AFTER_DRAIN = false;
    const void* R0; const void* R1; bf16_t* Xb; unsigned long long* ssout; int np, nt, do_at;
    __device__ __forceinline__ void operator()(const f32x4 (&acc)[2][2][4][2], const Unit& u, int wr, int wc, int fr, int fq) const {
        const int row0 = u.pm * BM + wr * 64 + fr, col0 = u.pn * BM + wc * 32 + 8 * fq;
#pragma unroll
        for (int ai = 0; ai < 2; ++ai)
#pragma unroll
            for (int m = 0; m < 4; ++m) { const int row = row0 + ai * HALF + m * 16; float sq = 0.f;
#pragma unroll
                for (int bj = 0; bj < 2; ++bj) { f32x4 r0 = (f32x4){0.f, 0.f, 0.f, 0.f}, r1 = r0;
                    if constexpr (RB16) { if (row < nt) { const u32x4 rw = *(const u32x4*)((const bf16_t*)R0 + (size_t)row * 1024 + col0 + bj * HALF);
                            r0 = (f32x4){__uint_as_float(rw.x << 16), __uint_as_float(rw.x & 0xffff0000u), __uint_as_float(rw.y << 16), __uint_as_float(rw.y & 0xffff0000u)};
                            r1 = (f32x4){__uint_as_float(rw.z << 16), __uint_as_float(rw.z & 0xffff0000u), __uint_as_float(rw.w << 16), __uint_as_float(rw.w & 0xffff0000u)}; } }
                    else { const float* rp = row < np ? (const float*)R0 + (size_t)row * 1024 : (row < nt ? (const float*)R1 + (size_t)(row - np) * 1024 : nullptr);
                        if (rp) { r0 = *(const f32x4*)(rp + col0 + bj * HALF); r1 = *(const f32x4*)(rp + col0 + bj * HALF + 4); } }
                    const f32x4 v0 = acc[ai][bj][m][0] + r0, v1 = acc[ai][bj][m][1] + r1;
                    sq += (v0[0] * v0[0] + v0[1] * v0[1]) + (v0[2] * v0[2] + v0[3] * v0[3]) + (v1[0] * v1[0] + v1[1] * v1[1]) + (v1[2] * v1[2] + v1[3] * v1[3]);
                    u32x4 w; w.x = cvt_pk_bf16(v0[0], v0[1]); w.y = cvt_pk_bf16(v0[2], v0[3]); w.z = cvt_pk_bf16(v1[0], v1[1]); w.w = cvt_pk_bf16(v1[2], v1[3]);
                    *(u32x4*)(Xb + (size_t)row * 1024 + col0 + bj * HALF) = w; }
                sq += __shfl_xor(sq, 16); sq += __shfl_xor(sq, 32); if (fq == 0 && do_at) ss_add(ssout + row, sq); }
    }
};
struct EpiScaleF32 { static constexpr bool PERM = false, AFTER_DRAIN = false;
    float* C; int ldc; const float* ss; int nparts; int pstride;
    __device__ __forceinline__ void operator()(const f32x4 (&acc)[2][2][4][2], const Unit& u, int wr, int wc, int fr, int fq) const {
        const int row0 = u.pm * BM + wr * 64 + fr, col0 = u.pn * BM + wc * 32 + 4 * fq;
#pragma unroll
        for (int ai = 0; ai < 2; ++ai)
#pragma unroll
            for (int m = 0; m < 4; ++m) { const int row = row0 + ai * HALF + m * 16; float sa = ss[row]; for (int pp = 1; pp < nparts; ++pp) sa += ss[(size_t)pp * pstride + row];
                const float rs = rsqrtf(sa * (1.0f / 1024.0f) + 1e-6f);
                float* rowp = C + (size_t)row * ldc + col0;
#pragma unroll
                for (int bj = 0; bj < 2; ++bj)
#pragma unroll
                    for (int n = 0; n < 2; ++n) *(f32x4*)(rowp + bj * HALF + n * 16) = acc[ai][bj][m][n] * rs; }
    }
};
struct EpiScaleBf16 { static constexpr bool PERM = true, AFTER_DRAIN = false;
    bf16_t* O; int ldc; const float* ss; int nparts; int pstride;
    __device__ __forceinline__ void operator()(const f32x4 (&acc)[2][2][4][2], const Unit& u, int wr, int wc, int fr, int fq) const {
        const int row0 = u.pm * BM + wr * 64 + fr, col0 = u.pn * BM + wc * 32 + 8 * fq;
#pragma unroll
        for (int ai = 0; ai < 2; ++ai)
#pragma unroll
            for (int m = 0; m < 4; ++m) { const int row = row0 + ai * HALF + m * 16; float sa = ss[row]; for (int pp = 1; pp < nparts; ++pp) sa += ss[(size_t)pp * pstride + row];
                const float rs = rsqrtf(sa * (1.0f / 1024.0f) + 1e-6f);
                bf16_t* rowp = O + (size_t)row * ldc + col0;
#pragma unroll
                for (int bj = 0; bj < 2; ++bj) { const f32x4 v0 = acc[ai][bj][m][0] * rs, v1 = acc[ai][bj][m][1] * rs;
                    u32x4 w; w.x = cvt_pk_bf16(v0[0], v0[1]); w.y = cvt_pk_bf16(v0[2], v0[3]); w.z = cvt_pk_bf16(v1[0], v1[1]); w.w = cvt_pk_bf16(v1[2], v1[3]);
                    *(u32x4*)(rowp + bj * HALF) = w; } }
    }
};
struct EpiScaleF16 { static constexpr bool PERM = true, AFTER_DRAIN = false;
    unsigned short* O; int ldc; const unsigned long long* ss;
    __device__ __forceinline__ static unsigned pkh(float a, float b) { typedef _Float16 h2 __attribute__((ext_vector_type(2))); h2 h; h[0] = (_Float16)a; h[1] = (_Float16)b; return __builtin_bit_cast(unsigned, h); }
    __device__ __forceinline__ void operator()(const f32x4 (&acc)[2][2][4][2], const Unit& u, int wr, int wc, int fr, int fq) const {
        const int row0 = u.pm * BM + wr * 64 + fr, col0 = u.pn * BM + wc * 32 + 8 * fq;
#pragma unroll
        for (int ai = 0; ai < 2; ++ai)
#pragma unroll
            for (int m = 0; m < 4; ++m) { const int row = row0 + ai * HALF + m * 16; const float rs = rsqrtf(ss_get(ss + row) * (1.0f / 1024.0f) + 1e-6f);
                unsigned short* rowp = O + (size_t)row * ldc + col0;
#pragma unroll
                for (int bj = 0; bj < 2; ++bj) { const f32x4 v0 = acc[ai][bj][m][0] * rs, v1 = acc[ai][bj][m][1] * rs;
                    u32x4 w; w.x = pkh(v0[0], v0[1]); w.y = pkh(v0[2], v0[3]); w.z = pkh(v1[0], v1[1]); w.w = pkh(v1[2], v1[3]);
                    *(u32x4*)(rowp + bj * HALF) = w; } }
    }
};
template <class Epi, class Sched, bool ALIGN_EPI = false, bool SP2 = false>
__device__ __forceinline__ void gemm_phase(PG8_LAS unsigned char* lds, const Gemm g, const Sched& S, const Epi& E) {
    const int tid = threadIdx.x, wid = __builtin_amdgcn_readfirstlane(tid >> 6), lane = tid & 63, wr = wid >> 2, wc = wid & 3, fr = lane & 15, fq = lane >> 4;
    const int K = g.K, nt = K / BK;
    unsigned voffA[2], voffB[2];
#pragma unroll
    for (int i = 0; i < 2; ++i) { int R, C; stage_rc(tid * 16 + i * 8192, R, C); const int Rb = Epi::PERM ? ((R & ~31) + perm32(R & 31)) : R;
        voffA[i] = (unsigned)(R * K + C) * 2u; voffB[i] = (unsigned)(Rb * K + C) * 2u; }
    const size_t kstep = (size_t)(BK * 2);
    const size_t hstep = (size_t)HALF * K * 2;
    const size_t tstep = 2 * hstep;
    const unsigned ldsw = (unsigned)wid * 1024u;
    const int aoff = lds_byte(wr * 64 + fr, fq * 8), boff = lds_byte(wc * 32 + fr, fq * 8);
#define PG8_SA(b, h) (((b) * 2 + (h)) * HTB)
#define PG8_SB(b, h) ((4 + (b) * 2 + (h)) * HTB)
#define PG8_STAGE(bufoff, gbase, voff) do { _Pragma("unroll") for (int _i = 0; _i < 2; ++_i) \
        __builtin_amdgcn_global_load_lds((const unsigned*)((const char*)(gbase) + (voff)[_i]), (PG8_LAS unsigned*)(lds + (bufoff) + ldsw + _i * 8192), 16, 0, 0); } while (0)
#define PG8_LDA(dst, b, h) do { _Pragma("unroll") for (int m = 0; m < 4; ++m) _Pragma("unroll") for (int k = 0; k < 2; ++k) dst[m][k] = *(const PG8_LAS bf16x8*)(lds + PG8_SA(b, h) + aoff + m * 2048 + k * 1024); } while (0)
#define PG8_LDB(dst, b, h) do { _Pragma("unroll") for (int n = 0; n < 2; ++n) _Pragma("unroll") for (int k = 0; k < 2; ++k) dst[n][k] = *(const PG8_LAS bf16x8*)(lds + PG8_SB(b, h) + boff + n * 2048 + k * 1024); } while (0)
#define PG8_MMA(ai, bj, At, Bt) do { __builtin_amdgcn_s_setprio(1); _Pragma("unroll") for (int m = 0; m < 4; ++m) _Pragma("unroll") for (int n = 0; n < 2; ++n) _Pragma("unroll") for (int k = 0; k < 2; ++k) \
        acc[ai][bj][m][n] = __builtin_amdgcn_mfma_f32_16x16x32_bf16(Bt[n][k], At[m][k], acc[ai][bj][m][n], 0, 0, 0); __builtin_amdgcn_s_setprio(0); } while (0)
#define PG8_WAIT_V(n) asm volatile("s_waitcnt vmcnt(" #n ")" ::: "memory")
#define PG8_WAIT_L(n) asm volatile("s_waitcnt lgkmcnt(" #n ")" ::: "memory")
#define PG8_BAR __builtin_amdgcn_s_barrier()
#define PG8_SCHED __builtin_amdgcn_sched_barrier(0)
    Unit cur, nxt; int ui = 0;
    if (!S.next(0, cur)) return;
    f32x4 acc[2][2][4][2];
#pragma unroll
    for (int a = 0; a < 2; ++a)
#pragma unroll
        for (int b = 0; b < 2; ++b)
#pragma unroll
            for (int m = 0; m < 4; ++m)
#pragma unroll
                for (int n = 0; n < 2; ++n) acc[a][b][m][n] = (f32x4){0.f, 0.f, 0.f, 0.f};
    bf16x8 At[4][2], B0[2][2], B1[2][2];
    const char* cA = (const char*)g.A + (size_t)cur.pm * tstep; const char* cB = (const char*)g.Bt + (size_t)cur.pn * tstep;
    S.a_ready(cur);
    if constexpr (SP2) {
        PG8_STAGE(PG8_SB(0, 0), cB, voffB); PG8_STAGE(PG8_SB(0, 1), cB + hstep, voffB); PG8_STAGE(PG8_SA(0, 0), cA, voffA); PG8_STAGE(PG8_SA(0, 1), cA + hstep, voffA);
        if (wr == 1) PG8_BAR;
        PG8_WAIT_V(2); PG8_BAR;
        PG8_STAGE(PG8_SB(1, 0), cB + kstep, voffB); PG8_STAGE(PG8_SA(1, 0), cA + kstep, voffA); PG8_STAGE(PG8_SB(1, 1), cB + hstep + kstep, voffB);
        PG8_WAIT_V(6); PG8_BAR;
    } else {
        PG8_STAGE(PG8_SB(0, 0), cB, voffB); PG8_STAGE(PG8_SA(0, 0), cA, voffA); PG8_STAGE(PG8_SB(0, 1), cB + hstep, voffB); PG8_STAGE(PG8_SA(0, 1), cA + hstep, voffA);
        if (wr == 1) PG8_BAR;
        PG8_WAIT_V(4); PG8_BAR;
        PG8_STAGE(PG8_SB(1, 0), cB + kstep, voffB); PG8_STAGE(PG8_SA(1, 0), cA + kstep, voffA); PG8_STAGE(PG8_SB(1, 1), cB + hstep + kstep, voffB);
        PG8_WAIT_V(6); PG8_BAR;
    }
    for (;;) {
        const bool has_next = S.next(ui + 1, nxt);
        const char* nA = has_next ? (const char*)g.A + (size_t)nxt.pm * tstep : cA; const char* nB = has_next ? (const char*)g.Bt + (size_t)nxt.pn * tstep : cB;
        for (int t = 0; t < nt; t += 2) {
            const bool last = (t == nt - 2);
            const char* a1 = cA + (size_t)(t + 1) * kstep;
            const char* a2 = last ? nA : cA + (size_t)(t + 2) * kstep; const char* b2 = last ? nB : cB + (size_t)(t + 2) * kstep;
            const char* a3 = a2 + kstep; const char* b3 = b2 + kstep;
            if (last && has_next) S.a_ready(nxt);
            if constexpr (SP2) {
            PG8_LDB(B0, 0, 0); PG8_LDB(B1, 0, 1); PG8_SCHED; PG8_LDA(At, 0, 0); PG8_STAGE(PG8_SA(1, 1), a1 + hstep, voffA);
            PG8_WAIT_V(8); PG8_WAIT_L(0); PG8_BAR; PG8_MMA(0, 0, At, B0); PG8_MMA(0, 1, At, B1); PG8_BAR; PG8_SCHED;
            PG8_LDA(At, 0, 1); PG8_STAGE(PG8_SB(0, 0), b2, voffB); PG8_STAGE(PG8_SB(0, 1), b2 + hstep, voffB); PG8_STAGE(PG8_SA(0, 0), a2, voffA);
            PG8_WAIT_V(8); PG8_WAIT_L(0); PG8_BAR; PG8_MMA(1, 0, At, B0); PG8_MMA(1, 1, At, B1); PG8_BAR; PG8_SCHED;
            PG8_LDB(B0, 1, 0); PG8_LDB(B1, 1, 1); PG8_SCHED; PG8_LDA(At, 1, 0); PG8_STAGE(PG8_SA(0, 1), a2 + hstep, voffA);
            PG8_WAIT_V(8); PG8_WAIT_L(0); PG8_BAR; PG8_MMA(0, 0, At, B0); PG8_MMA(0, 1, At, B1); PG8_BAR; PG8_SCHED;
            PG8_LDA(At, 1, 1); PG8_STAGE(PG8_SB(1, 0), b3, voffB); PG8_STAGE(PG8_SB(1, 1), b3 + hstep, voffB); PG8_STAGE(PG8_SA(1, 0), a3, voffA);
            PG8_WAIT_V(8); PG8_WAIT_L(0); PG8_BAR; PG8_MMA(1, 0, At, B0); PG8_MMA(1, 1, At, B1); PG8_BAR; PG8_SCHED;
            } else {
            PG8_LDB(B0, 0, 0); PG8_SCHED; PG8_LDA(At, 0, 0); PG8_STAGE(PG8_SA(1, 1), a1 + hstep, voffA);
            PG8_WAIT_L(8); PG8_BAR; PG8_WAIT_L(0); PG8_MMA(0, 0, At, B0); PG8_BAR; PG8_SCHED;
            PG8_LDB(B1, 0, 1); PG8_STAGE(PG8_SB(0, 0), b2, voffB);
            PG8_BAR; PG8_WAIT_L(0); PG8_MMA(0, 1, At, B1); PG8_BAR;
            PG8_LDA(At, 0, 1); PG8_STAGE(PG8_SA(0, 0), a2, voffA);
            PG8_BAR; PG8_WAIT_L(0); PG8_MMA(1, 0, At, B0); PG8_BAR; PG8_SCHED;
            PG8_STAGE(PG8_SB(0, 1), b2 + hstep, voffB);
            PG8_WAIT_V(6); PG8_BAR; PG8_MMA(1, 1, At, B1); PG8_BAR;
            PG8_LDB(B0, 1, 0); PG8_SCHED; PG8_LDA(At, 1, 0); PG8_STAGE(PG8_SA(0, 1), a2 + hstep, voffA);
            PG8_WAIT_L(8); PG8_BAR; PG8_WAIT_L(0); PG8_MMA(0, 0, At, B0); PG8_BAR; PG8_SCHED;
            PG8_LDB(B1, 1, 1); PG8_STAGE(PG8_SB(1, 0), b3, voffB);
            PG8_BAR; PG8_WAIT_L(0); PG8_MMA(0, 1, At, B1); PG8_BAR;
            PG8_LDA(At, 1, 1); PG8_STAGE(PG8_SA(1, 0), a3, voffA);
            PG8_BAR; PG8_WAIT_L(0); PG8_MMA(1, 0, At, B0); PG8_BAR; PG8_SCHED;
            PG8_STAGE(PG8_SB(1, 1), b3 + hstep, voffB);
            PG8_WAIT_V(6); PG8_BAR; PG8_MMA(1, 1, At, B1); PG8_BAR;
            }
        }
        if constexpr (ALIGN_EPI) { if (wr == 0) PG8_BAR; }
        if constexpr (!Epi::AFTER_DRAIN) { E(acc, cur, wr, wc, fr, fq); S.done(cur); }
        if (!has_next) break;
#pragma unroll
        for (int a = 0; a < 2; ++a)
#pragma unroll
            for (int b = 0; b < 2; ++b)
#pragma unroll
                for (int m = 0; m < 4; ++m)
#pragma unroll
                    for (int n = 0; n < 2; ++n) acc[a][b][m][n] = (f32x4){0.f, 0.f, 0.f, 0.f};
        cur = nxt; cA = nA; cB = nB; ++ui;
        if constexpr (ALIGN_EPI) { if (wr == 1) PG8_BAR; }
    }
    PG8_WAIT_V(0);
    if constexpr (!ALIGN_EPI) { if (wr == 0) PG8_BAR; }
    PG8_BAR;
    if constexpr (Epi::AFTER_DRAIN) { E.fused(acc, cur, wr, wc, fr, fq, lds, wid, lane); S.done(cur); }
#undef PG8_SA
#undef PG8_SB
#undef PG8_STAGE
#undef PG8_LDA
#undef PG8_LDB
#undef PG8_MMA
#undef PG8_WAIT_V
#undef PG8_WAIT_L
#undef PG8_BAR
#undef PG8_SCHED
}

}

#define GAS __attribute__((address_space(1)))
#define LAS __attribute__((address_space(3)))
typedef unsigned short bf16;
typedef unsigned v4u __attribute__((ext_vector_type(4)));
typedef unsigned v2u __attribute__((ext_vector_type(2)));
typedef float f32x4 __attribute__((ext_vector_type(4)));
typedef float f32x2 __attribute__((ext_vector_type(2)));
typedef float f32x16 __attribute__((ext_vector_type(16)));
typedef short bf16x8 __attribute__((ext_vector_type(8)));
typedef __bf16 bf16x2_t __attribute__((ext_vector_type(2)));
typedef GAS unsigned gu32;
typedef GAS unsigned long long gu64;
#define RLX_AGENT __ATOMIC_RELAXED, __HIP_MEMORY_SCOPE_AGENT
#define LDS_WAIT() asm volatile("s_waitcnt lgkmcnt(0)" ::: "memory")
#define VM_WAIT() asm volatile("s_waitcnt vmcnt(0)" ::: "memory")
__device__ __forceinline__ unsigned long long rt() { return __builtin_amdgcn_s_memrealtime(); }
__device__ __forceinline__ unsigned f2bf(float f) { unsigned u = __builtin_bit_cast(unsigned, f); return (u + 0x7fffu + ((u >> 16) & 1u)) >> 16; }
__device__ __forceinline__ unsigned pk2(float lo, float hi) { return f2bf(lo) | (f2bf(hi) << 16); }

#define XB_TMO      128
#define XB_XCNT(j)  (256  + 64 * (j))
#define XB_XSUB(j)  (1280 + 64 * (j))
#define XB_XGEN(j)  (2304 + 64 * (j))
#define XB_TOP      3328
#define XB_TOPGEN   3392
#define XCD_BAR_WORDS 3456
#define XB_SPIN_CAP (1u << 18)

__device__ __forceinline__ unsigned xb_ld(unsigned* p)              { return __hip_atomic_load(p, __ATOMIC_RELAXED, __HIP_MEMORY_SCOPE_AGENT); }
__device__ __forceinline__ unsigned xb_add(unsigned* p, unsigned v) { return __hip_atomic_fetch_add(p, v, __ATOMIC_RELAXED, __HIP_MEMORY_SCOPE_AGENT); }
__device__ __forceinline__ unsigned xb_xcc_id() { return (unsigned)__builtin_amdgcn_s_getreg((3 << 11) | 20) & 0xFu; }
#define XB_SPIN(cond, bar) do { unsigned _sp = 0; while (cond) { __builtin_amdgcn_s_sleep(1); \
    if ((++_sp & 255u) == 0u) { if (xb_ld(&(bar)[XB_TMO])) break; if (_sp > XB_SPIN_CAP) { atomicAdd(&(bar)[XB_TMO], 1u); break; } } } } while (0)

struct XcdBarrier {
    unsigned* bar; unsigned x;
    volatile LAS unsigned* st;
};

__device__ __forceinline__ XcdBarrier xcd_barrier_post(unsigned* bar, volatile LAS unsigned* st) {
    XcdBarrier b; b.bar = bar; b.x = xb_xcc_id(); b.st = st;
    if (threadIdx.x == 0) (void)xb_add(&bar[XB_XCNT(b.x)], 1u);
    return b;
}
__device__ __forceinline__ void xcd_barrier_complete(unsigned* bar, unsigned x, unsigned& nloc, unsigned& nx) {
    const unsigned G = gridDim.x * gridDim.y * gridDim.z;
    unsigned sum, cnt, mine, sp = 0u;
    for (;;) {
        sum = 0u; cnt = 0u; mine = 0u;
#pragma unroll
        for (unsigned j = 0; j < 16; ++j) { const unsigned c = xb_ld(&bar[XB_XCNT(j)]); sum += c; cnt += (c > 0u) ? 1u : 0u; mine = (j == x) ? c : mine; }
        if (sum == G) break;
        __builtin_amdgcn_s_sleep(1);
        if ((++sp & 255u) == 0u) { if (xb_ld(&bar[XB_TMO])) break; if (sp > XB_SPIN_CAP) { atomicAdd(&bar[XB_TMO], 1u); break; } }
    }
    nloc = mine > 0u ? mine : 1u; nx = cnt > 0u ? cnt : 1u;
}

__device__ __forceinline__ void xcd_barrier(const XcdBarrier& b) {
    asm volatile("s_waitcnt vmcnt(0)" ::: "memory");
    __syncthreads();
    if (threadIdx.x == 0) {
        unsigned* bar = b.bar;
        __builtin_amdgcn_s_waitcnt(0);
        unsigned nloc = b.st[0], nx = b.st[1];
        if (nloc == 0u) { xcd_barrier_complete(bar, b.x, nloc, nx); b.st[0] = nloc; b.st[1] = nx; }
        const unsigned old = xb_add(&bar[XB_XSUB(b.x)], 1u);
        const unsigned gen = old / nloc;
        if (old + 1u == (gen + 1u) * nloc) {
            __builtin_amdgcn_fence(__ATOMIC_RELEASE, "agent");
            asm volatile("s_waitcnt vmcnt(0)" ::: "memory");
            const unsigned og = xb_add(&bar[XB_TOP], 1u);
            const unsigned tg = og / nx;
            if (og + 1u == (tg + 1u) * nx) xb_add(&bar[XB_TOPGEN], 1u);
            else XB_SPIN(xb_ld(&bar[XB_TOPGEN]) == tg, bar);
            __builtin_amdgcn_fence(__ATOMIC_ACQUIRE, "agent");
            xb_add(&bar[XB_XGEN(b.x)], 1u);
            asm volatile("s_waitcnt vmcnt(0)" ::: "memory");
        } else {
            XB_SPIN(xb_ld(&bar[XB_XGEN(b.x)]) == gen, bar);
            __builtin_amdgcn_fence(__ATOMIC_ACQUIRE, "agent");
            asm volatile("s_waitcnt vmcnt(0)" ::: "memory");
        }
    }

    __syncthreads();
}

namespace mk {
constexpr int D = 1024, NP = 32768, NS = 32, NT = NP + NS, MP = 33024, SEQ = 4096;
constexpr int PAST = 16384, NPAGE = 128, APROJ = 2120, APAD = 2304;
constexpr int NWAVES = 8, NTHR = 512;
constexpr float EPS = 1e-6f;
constexpr float IDX_SCALE = 0.04419417382415922f;
constexpr float QSCALE = 0.125f * 1.4426950408889634f;
constexpr size_t O_Y = 0, O_KP = 33587200, O_VP = 41975808, O_IP = 50364416, O_KS = 52461568, O_VS = 52469760, O_IS = 52477952, O_CV = 52480000;
constexpr size_t A256(size_t x) { return (x + 255) & ~(size_t)255; }
constexpr size_t CTL_BYTES = 2u << 20;
constexpr int CW_BAR = 4096;
constexpr size_t W_SSV = 256u << 10, W_SS1 = 576u << 10, W_SS3 = 896u << 10, W_QC = 64u << 10;
constexpr size_t W_SS0 = CTL_BYTES;
constexpr size_t W_SS2 = W_SS0 + A256((size_t)MP * 4);
constexpr size_t W_X0B = W_SS2 + A256((size_t)8 * MP * 4);
constexpr size_t W_WIN0T = W_X0B + A256((size_t)MP * 1024 * 2);
constexpr size_t W_WOUT0T = W_WIN0T + A256((size_t)4096 * 1024 * 2);
constexpr size_t W_WP0T = W_WOUT0T + A256((size_t)1024 * 2048 * 2);
constexpr size_t W_WP1T = W_WP0T + A256((size_t)2048 * 1024 * 2);
constexpr size_t W_WIN1T = W_WP1T + A256((size_t)2048 * 1024 * 2);
constexpr size_t W_WOUT1T = W_WIN1T + A256((size_t)APAD * 1024 * 2);
constexpr size_t W_WSMT = W_WOUT1T + A256((size_t)1024 * 1024 * 2);
constexpr size_t W_ROPE = W_WSMT + A256((size_t)8 * 128 * 128 * 4);
constexpr size_t W_UB = W_ROPE + A256((size_t)4097 * 64 * 4);
constexpr size_t W_VB = W_UB + A256((size_t)2 * 16384 * 1024 * 2);
constexpr size_t W_SU = W_VB + A256((size_t)2 * 16384 * 1024 * 2);
constexpr size_t W_SV = W_SU + A256((size_t)2 * 16384 * 4);
constexpr size_t W_X1B = W_SV + A256((size_t)2 * 16384 * 4);
constexpr size_t W_X2B = W_X1B + A256((size_t)MP * 1024 * 2);
constexpr size_t W_X3B = W_X2B + A256((size_t)MP * 1024 * 2);
constexpr size_t W_X1 = W_X3B + A256((size_t)MP * 1024 * 2);
constexpr size_t W_X2 = W_X1 + A256((size_t)MP * 1024 * 4);
constexpr size_t W_X3 = W_X2 + A256((size_t)MP * 1024 * 4);
constexpr size_t W_BIG = W_X3 + A256((size_t)MP * 1024 * 4);
constexpr size_t BIG_BYTES = (size_t)NP * 4096 * 4;
constexpr size_t W_U0 = W_BIG, W_V0 = W_U0 + A256((size_t)MP * 2048 * 2), W_G0 = W_V0 + A256((size_t)MP * 2048 * 2);
static_assert(W_G0 + (size_t)MP * 2048 * 2 <= W_BIG + BIG_BYTES, "union");
static_assert((size_t)MP * APAD * 4 <= BIG_BYTES, "union");
constexpr size_t W_EIDX = W_BIG + A256(BIG_BYTES);
constexpr size_t W_GATE = W_EIDX + A256((size_t)MP * 128 * 4);
constexpr size_t W_QB = W_GATE + A256((size_t)MP * 128 * 4);
constexpr size_t W_KB = W_QB + A256((size_t)MP * 1024 * 2);
constexpr size_t W_V2B = W_KB + A256((size_t)MP * 256 * 2);
constexpr size_t W_QIB = W_V2B + A256((size_t)MP * 256 * 2);
constexpr size_t W_KIB = W_QIB + A256((size_t)MP * 512 * 2);
constexpr size_t W_WI = W_KIB + A256((size_t)MP * 64 * 2);
constexpr size_t W_SEL = W_WI + A256((size_t)MP * 8 * 4);
constexpr size_t W_SKEYS = W_SEL + A256((size_t)NP * 64 * 8);
constexpr size_t W_OB = W_SKEYS + A256((size_t)32 * 16640 * 4);
constexpr size_t W_VT = W_OB + A256((size_t)MP * 1024 * 2);
constexpr size_t W_XQ = W_VT + A256((size_t)NP * 256 * 2);
constexpr size_t W_RSX = W_XQ + A256((size_t)MP * 1024);
constexpr size_t W_ACT = W_RSX + A256((size_t)MP * 4);
constexpr size_t W_END = W_ACT + A256((size_t)MP * 128 * 4);
constexpr int RING_BYTES = 131072, MISC_OFF = RING_BYTES + 320, LDS_BYTES = 147456;

struct Params { const float* in[23]; float* out; unsigned char* ws; float inv[32]; int ph_lo, ph_hi; };

__device__ __forceinline__ float wave_sum(float v) {
#pragma unroll
    for (int o = 1; o < 64; o <<= 1) v += __shfl_xor(v, o);
    return v;
}
__device__ __forceinline__ float bflo(unsigned w) { return __uint_as_float(w << 16); }
__device__ __forceinline__ float bfhi(unsigned w) { return __uint_as_float(w & 0xffff0000u); }
__device__ __forceinline__ unsigned f2key(float f) { f = f + 0.0f; const unsigned u = __float_as_uint(f); return (u & 0x80000000u) ? ~u : (u | 0x80000000u); }
__device__ __forceinline__ float key2f(unsigned k) { const unsigned u = (k & 0x80000000u) ? (k & 0x7fffffffu) : ~k; return __uint_as_float(u); }
__device__ __forceinline__ float fast_exp2(float x) { return __builtin_amdgcn_exp2f(x); }
__device__ __forceinline__ float gelu_tanh(float x) {
    const float a = 0.7978845608028654f * (x + 0.044715f * x * x * x);
    const float e = fast_exp2(a * 2.8853900817779268f);
    const float t = 1.0f - 2.0f * __builtin_amdgcn_rcpf(1.0f + e);
    return 0.5f * x * (1.0f + t);
}
__device__ __forceinline__ unsigned long long lanemask_lt(int lane) { return (1ull << lane) - 1ull; }
__device__ __forceinline__ float dot2bf(unsigned a, unsigned b, float c) { return __builtin_amdgcn_fdot2_f32_bf16(__builtin_bit_cast(bf16x2_t, a), __builtin_bit_cast(bf16x2_t, b), c, false); }

__device__ __forceinline__ int xadd32i(int a, int b) { const auto r = __builtin_amdgcn_permlane32_swap((unsigned)a, (unsigned)b, false, false); return (int)r[0] + (int)r[1]; }
__device__ __forceinline__ int xadd16i(int a, int b) { const auto r = __builtin_amdgcn_permlane16_swap((unsigned)a, (unsigned)b, false, false); return (int)r[0] + (int)r[1]; }
__device__ __forceinline__ int ror8i(int v) { return __builtin_amdgcn_update_dpp(0, v, 0x128, 0xf, 0xf, false); }
__device__ __forceinline__ int sum8i(int t) { t += __builtin_amdgcn_update_dpp(0, t, 0xB1, 0xf, 0xf, false); t += __builtin_amdgcn_update_dpp(0, t, 0x4E, 0xf, 0xf, false); t += __builtin_amdgcn_update_dpp(0, t, 0x141, 0xf, 0xf, false); return t; }
__device__ __forceinline__ float wave_max_f(float m) {
    m = fmaxf(m, __int_as_float(__builtin_amdgcn_update_dpp(0, __float_as_int(m), 0x121, 0xf, 0xf, false))); m = fmaxf(m, __int_as_float(__builtin_amdgcn_update_dpp(0, __float_as_int(m), 0x122, 0xf, 0xf, false)));
    m = fmaxf(m, __int_as_float(__builtin_amdgcn_update_dpp(0, __float_as_int(m), 0x124, 0xf, 0xf, false))); m = fmaxf(m, __int_as_float(__builtin_amdgcn_update_dpp(0, __float_as_int(m), 0x128, 0xf, 0xf, false)));
    { const auto r = __builtin_amdgcn_permlane16_swap(__float_as_uint(m), __float_as_uint(m), false, false); m = fmaxf(__uint_as_float(r[0]), __uint_as_float(r[1])); }
    { const auto r = __builtin_amdgcn_permlane32_swap(__float_as_uint(m), __float_as_uint(m), false, false); m = fmaxf(__uint_as_float(r[0]), __uint_as_float(r[1])); }
    return m;
}
__device__ __forceinline__ unsigned cvtpk(float lo, float hi) { const f32x2 v = {lo, hi}; const bf16x2_t b = __builtin_convertvector(v, bf16x2_t); return __builtin_bit_cast(unsigned, b); }
__device__ __forceinline__ void p0_transpose_item(const float* W, int ldw, int K, int nblk, int Nvalid, const float* gain, bf16* WT, LAS float* scr, int item, int lane) {
    const int kb = item / nblk, nb = item % nblk, k0 = 64 * kb, n0 = 32 * nb;
    const int nn = n0 + (lane & 31); const bool ok = nn < Nvalid;
#pragma unroll 8
    for (int i = 0; i < 32; ++i) { const int kk = 2 * i + (lane >> 5); float v = ok ? W[(size_t)(k0 + kk) * ldw + nn] : 0.f; if (gain) v *= gain[k0 + kk]; scr[kk * 33 + (lane & 31)] = v; }
    LDS_WAIT(); asm volatile("" ::: "memory");
    const int c = lane & 7;
#pragma unroll
    for (int j = 0; j < 4; ++j) { const int n = (lane >> 3) + 8 * j; const LAS float* s = scr + (8 * c) * 33 + n;
        v4u o; o.x = pk2(s[0 * 33], s[1 * 33]); o.y = pk2(s[2 * 33], s[3 * 33]); o.z = pk2(s[4 * 33], s[5 * 33]); o.w = pk2(s[6 * 33], s[7 * 33]);
        *(GAS v4u*)(WT + (size_t)(n0 + n) * K + k0 + 8 * c) = o; }
    LDS_WAIT(); asm volatile("" ::: "memory");
}
__device__ __forceinline__ float p0_row(const float* src, const float* gain, bf16* dst, int lane) {
    f32x4 v[4]; float s = 0.f;
#pragma unroll
    for (int j = 0; j < 4; ++j) { v[j] = src ? *((const GAS f32x4*)src + lane + 64 * j) : (f32x4){0.f, 0.f, 0.f, 0.f}; s += (v[j].x * v[j].x + v[j].y * v[j].y) + (v[j].z * v[j].z + v[j].w * v[j].w); }
    if (gain) {
#pragma unroll
        for (int j = 0; j < 4; ++j) v[j] = v[j] * *((const GAS f32x4*)gain + lane + 64 * j); }
    GAS unsigned long long* o8 = (GAS unsigned long long*)dst + lane;
#pragma unroll
    for (int j = 0; j < 4; ++j) o8[64 * j] = (unsigned long long)pk2(v[j].x, v[j].y) | ((unsigned long long)pk2(v[j].z, v[j].w) << 32);
    return wave_sum(s);
}
__device__ __forceinline__ void p0_quant_row(const float* src, const float* gain, unsigned char* dst, float* scale_out, int bias, int lane, bool part = false, int erow = 0) {
    f32x4 v[4]; float am = 0.f;
#pragma unroll
    for (int j = 0; j < 4; ++j) { v[j] = *((const GAS f32x4*)src + lane * 4 + j); if (gain) v[j] = v[j] * *((const GAS f32x4*)gain + lane * 4 + j);
        am = fmaxf(am, fmaxf(fmaxf(fabsf(v[j].x), fabsf(v[j].y)), fmaxf(fabsf(v[j].z), fabsf(v[j].w)))); }
    am = wave_max_f(am);
    const float sc = am > 0.f ? am * (1.0f / 127.0f) : 1.0f, inv = 1.0f / sc;
    v4u w;
#pragma unroll
    for (int j = 0; j < 4; ++j) { unsigned pk = 0u;
#pragma unroll
        for (int e = 0; e < 4; ++e) { int q = (int)rintf(v[j][e] * inv); q = q > 127 ? 127 : (q < -127 ? -127 : q); pk |= ((unsigned)(q + bias) & 0xffu) << (8 * e); }
        w[j] = pk; }
    if (part) *(GAS v4u*)(dst + (size_t)(lane >> 3) * (16384 * 128) + (size_t)erow * 128 + (lane & 7) * 16) = w;
    else *((GAS v4u*)dst + lane) = w;
    if (lane == 0) *scale_out = sc;
}
struct RowIn { f32x4 v[4]; };
__device__ __forceinline__ void p0_rowq_load(RowIn& R, const float* src, int lane) {
#pragma unroll
    for (int j = 0; j < 4; ++j) R.v[j] = *((const GAS f32x4*)src + lane * 4 + j);
}
__device__ __forceinline__ void p0_rowq_store(const RowIn& R, const float* gain, unsigned char* dst, float* scale_out, int lane, bool part, int erow) {
    f32x4 v[4]; float am = 0.f;
#pragma unroll
    for (int j = 0; j < 4; ++j) { v[j] = R.v[j]; if (gain) v[j] = v[j] * *((const GAS f32x4*)gain + lane * 4 + j);
        am = fmaxf(am, fmaxf(fmaxf(fabsf(v[j].x), fabsf(v[j].y)), fmaxf(fabsf(v[j].z), fabsf(v[j].w)))); }
    am = wave_max_f(am);
    const float sc = am > 0.f ? am * (1.0f / 127.0f) : 1.0f, inv = 1.0f / sc;
    v4u w;
#pragma unroll
    for (int j = 0; j < 4; ++j) { unsigned pk = 0u;
#pragma unroll
        for (int e = 0; e < 4; ++e) { int q = (int)rintf(v[j][e] * inv); q = q > 127 ? 127 : (q < -127 ? -127 : q); pk |= ((unsigned)q & 0xffu) << (8 * e); }
        w[j] = pk; }
    if (part) *(GAS v4u*)(dst + (size_t)(lane >> 3) * (16384 * 128) + (size_t)erow * 128 + (lane & 7) * 16) = w;
    else *((GAS v4u*)dst + lane) = w;
    if (lane == 0) *scale_out = sc;
}
__device__ __forceinline__ void p0_rowx_load(RowIn& R, const float* src, int lane) {
#pragma unroll
    for (int j = 0; j < 4; ++j) R.v[j] = src ? *((const GAS f32x4*)src + lane + 64 * j) : (f32x4){0.f, 0.f, 0.f, 0.f};
}
__device__ __forceinline__ float p0_rowx_store(const RowIn& R, bf16* dst, int lane) {
    float s = 0.f;
#pragma unroll
    for (int j = 0; j < 4; ++j) s += (R.v[j].x * R.v[j].x + R.v[j].y * R.v[j].y) + (R.v[j].z * R.v[j].z + R.v[j].w * R.v[j].w);
    GAS unsigned long long* o8 = (GAS unsigned long long*)dst + lane;
#pragma unroll
    for (int j = 0; j < 4; ++j) o8[64 * j] = (unsigned long long)pk2(R.v[j].x, R.v[j].y) | ((unsigned long long)pk2(R.v[j].z, R.v[j].w) << 32);
    return wave_sum(s);
}
__device__ __forceinline__ void p0_wp_item(const float* wq, const float* subk, const float* gain, bf16* WT, int col0, int j0, LAS float* scr, int lane) {
#pragma unroll 4
    for (int i = 0; i < 32; ++i) { const int idx = i * 64 + lane, jj = idx >> 7, d = idx & 127; scr[d * 16 + jj] = wq[(size_t)(j0 + jj) * 2048 + col0 + d] * gain[j0 + jj]; }
    LDS_WAIT(); asm volatile("" ::: "memory");
    float a0[16], a1[16];
#pragma unroll
    for (int i = 0; i < 16; ++i) { a0[i] = 0.f; a1[i] = 0.f; }
    const float* r0 = subk + (size_t)lane * 128; const float* r1 = subk + (size_t)(lane + 64) * 128;
#pragma unroll 1
    for (int d8 = 0; d8 < 4; ++d8) {
      f32x4 xs[8], ys[8];
#pragma unroll
      for (int u = 0; u < 8; ++u) { xs[u] = *(const GAS f32x4*)(r0 + (d8 * 8 + u) * 4); ys[u] = *(const GAS f32x4*)(r1 + (d8 * 8 + u) * 4); }
#pragma unroll
      for (int u = 0; u < 8; ++u) { const int d4 = d8 * 8 + u;
        const f32x4 x = xs[u], y = ys[u];
#pragma unroll
        for (int dd = 0; dd < 4; ++dd) { const LAS f32x4* wv = (const LAS f32x4*)(scr + (d4 * 4 + dd) * 16);
#pragma unroll
            for (int q = 0; q < 4; ++q) { const f32x4 w = wv[q];
#pragma unroll
                for (int e = 0; e < 4; ++e) { a0[q * 4 + e] += x[dd] * w[e]; a1[q * 4 + e] += y[dd] * w[e]; } } }
      }
    }
    { v4u o0, o1; o0.x = pk2(a0[0], a0[1]); o0.y = pk2(a0[2], a0[3]); o0.z = pk2(a0[4], a0[5]); o0.w = pk2(a0[6], a0[7]); o1.x = pk2(a0[8], a0[9]); o1.y = pk2(a0[10], a0[11]); o1.z = pk2(a0[12], a0[13]); o1.w = pk2(a0[14], a0[15]);
      GAS v4u* p = (GAS v4u*)(WT + (size_t)(col0 + lane) * 1024 + j0); p[0] = o0; p[1] = o1; }
    { v4u o0, o1; o0.x = pk2(a1[0], a1[1]); o0.y = pk2(a1[2], a1[3]); o0.z = pk2(a1[4], a1[5]); o0.w = pk2(a1[6], a1[7]); o1.x = pk2(a1[8], a1[9]); o1.y = pk2(a1[10], a1[11]); o1.z = pk2(a1[12], a1[13]); o1.w = pk2(a1[14], a1[15]);
      GAS v4u* p = (GAS v4u*)(WT + (size_t)(col0 + lane + 64) * 1024 + j0); p[0] = o0; p[1] = o1; }
    LDS_WAIT(); asm volatile("" ::: "memory");
}

#define ROWMAX16(m) do { m = max(m, (unsigned)__builtin_amdgcn_update_dpp(0, (int)m, 0x121, 0xf, 0xf, false)); m = max(m, (unsigned)__builtin_amdgcn_update_dpp(0, (int)m, 0x122, 0xf, 0xf, false)); \
    m = max(m, (unsigned)__builtin_amdgcn_update_dpp(0, (int)m, 0x124, 0xf, 0xf, false)); m = max(m, (unsigned)__builtin_amdgcn_update_dpp(0, (int)m, 0x128, 0xf, 0xf, false)); } while (0)
#define ROWSUM16F(s) do { s += __int_as_float(__builtin_amdgcn_update_dpp(0, __float_as_int(s), 0x121, 0xf, 0xf, false)); s += __int_as_float(__builtin_amdgcn_update_dpp(0, __float_as_int(s), 0x122, 0xf, 0xf, false)); \
    s += __int_as_float(__builtin_amdgcn_update_dpp(0, __float_as_int(s), 0x124, 0xf, 0xf, false)); s += __int_as_float(__builtin_amdgcn_update_dpp(0, __float_as_int(s), 0x128, 0xf, 0xf, false)); } while (0)
__device__ __forceinline__ unsigned top16_of_128(unsigned (&x)[8], int sub) {
#define CE(i, j) do { const unsigned hi_ = max(x[i], x[j]), lo_ = min(x[i], x[j]); x[i] = hi_; x[j] = lo_; } while (0)
    CE(0, 1); CE(2, 3); CE(4, 5); CE(6, 7);
    CE(0, 2); CE(1, 3); CE(4, 6); CE(5, 7);
    CE(1, 2); CE(5, 6); CE(0, 4); CE(3, 7);
    CE(1, 5); CE(2, 6);
    CE(1, 4); CE(3, 6);
    CE(2, 4); CE(3, 5);
    CE(3, 4);
#undef CE
    unsigned res = 0u;
#pragma unroll
    for (int r = 0; r < 16; ++r) {
        unsigned m = x[0];
        ROWMAX16(m);
        res = (sub == r) ? m : res;
        const bool win = (x[0] == m);
#pragma unroll
        for (int i = 0; i < 7; ++i) x[i] = win ? x[i + 1] : x[i];
        x[7] = win ? 0u : x[7];
    }
    return res;
}
struct RouteIn { f32x4 a, b, c, d; };
__device__ __forceinline__ void peer_route_load(RouteIn& R, const unsigned short* S, int task, int lane) {
    const int sub = lane & 15, grp = lane >> 4, p = task * 4 + grp, tok = p >> 3, h = p & 7;
    const unsigned short* sp = S + (size_t)tok * 2048 + h * 256 + sub * 8;
    typedef _Float16 h8 __attribute__((ext_vector_type(8)));
    const h8 x = *(const GAS h8*)sp, y = *(const GAS h8*)(sp + 128);
    R.a = (f32x4){(float)x[0], (float)x[1], (float)x[2], (float)x[3]}; R.b = (f32x4){(float)x[4], (float)x[5], (float)x[6], (float)x[7]};
    R.c = (f32x4){(float)y[0], (float)y[1], (float)y[2], (float)y[3]}; R.d = (f32x4){(float)y[4], (float)y[5], (float)y[6], (float)y[7]};
}
__device__ __forceinline__ void peer_route_core(const RouteIn& R, unsigned* EIDX, float* GATE, int tok, int h, int lane) {
    const int sub = lane & 15;
    unsigned x1[8], x2[8];
    { const f32x4 a = R.a, b = R.b, c = R.c, d = R.d;
#pragma unroll
      for (int i = 0; i < 4; ++i) { x1[i] = (f2key(a[i]) & ~127u) | (unsigned)(127 - (sub * 8 + i)); x1[4 + i] = (f2key(b[i]) & ~127u) | (unsigned)(127 - (sub * 8 + 4 + i));
                                    x2[i] = (f2key(c[i]) & ~127u) | (unsigned)(127 - (sub * 8 + i)); x2[4 + i] = (f2key(d[i]) & ~127u) | (unsigned)(127 - (sub * 8 + 4 + i)); } }
    const unsigned r1 = top16_of_128(x1, sub), r2 = top16_of_128(x2, sub);
    const float v1 = key2f(r1 & ~127u), v2 = key2f(r2 & ~127u); const int i1 = 127 - (int)(r1 & 127u), i2 = 127 - (int)(r2 & 127u);
    unsigned c[8];
    const int La = (sub == 0 || sub == 1) ? 8 : (sub == 2 ? 5 : (sub == 3 ? 4 : (sub == 4 ? 3 : (sub < 8 ? 2 : 1))));
#pragma unroll
    for (int j = 0; j < 8; ++j) { const float vj = __shfl(v2, (lane & 48) | j); c[j] = (j < La) ? ((f2key(v1 + vj) & ~255u) | (unsigned)((15 - sub) << 4) | (unsigned)(15 - j)) : 0u; }
    { const float v10 = __shfl(v1, lane & 48); if (sub >= 8) { const unsigned extra = (f2key(v10 + v2) & ~255u) | (unsigned)(15 << 4) | (unsigned)(15 - sub);
          const unsigned hi_ = max(c[0], extra), lo_ = min(c[0], extra); c[0] = hi_; c[1] = lo_; } }
    unsigned res = 0u;
#pragma unroll
    for (int r = 0; r < 16; ++r) {
        unsigned m = c[0]; ROWMAX16(m);
        res = (sub == r) ? m : res;
        const bool win = (c[0] == m);
#pragma unroll
        for (int j = 0; j < 7; ++j) c[j] = win ? c[j + 1] : c[j];
        c[7] = win ? 0u : c[7];
    }
    const float ts = key2f(res & ~255u); const int a = 15 - (int)((res >> 4) & 15u), b = 15 - (int)(res & 15u);
    const int ia = __shfl(i1, (lane & 48) | a), ib = __shfl(i2, (lane & 48) | b);
    unsigned mk = f2key(ts); ROWMAX16(mk); const float mx = key2f(mk);
    const float e = fast_exp2((ts - mx) * 1.4426950408889634f); float sum = e; ROWSUM16F(sum);
    { const int j = h * 16 + sub, pos = (j & 64) + (j & 7) * 8 + ((j >> 3) & 7);
      if (tok < NT) { EIDX[(size_t)tok * 128 + pos] = (unsigned)(ia * 128 + ib); GATE[(size_t)tok * 128 + pos] = e / sum; } }
}

__device__ __forceinline__ void peer_route_task(const RouteIn& R, unsigned* EIDX, float* GATE, int task, int lane) { const int p = task * 4 + (lane >> 4); peer_route_core(R, EIDX, GATE, p >> 3, p & 7, lane); }
struct OneUnit : pg8::StaticOrder { int k;
    __device__ __forceinline__ bool next(int i, pg8::Unit& u) const { return i == 0 && pg8::StaticOrder::next(k, u); } };
struct EpiRoute { static constexpr bool PERM = true, AFTER_DRAIN = true;
    const unsigned long long* ss; unsigned* EIDX; float* GATE;
    __device__ __forceinline__ void fused(f32x4 (&acc)[2][2][4][2], const pg8::Unit& u, int wr, int wc, int fr, int fq, LAS unsigned char* tile, int wid, int lane) const {
#pragma unroll
        for (int ai = 0; ai < 2; ++ai)
#pragma unroll
            for (int m = 0; m < 4; ++m) { const int row = ai * 128 + wr * 64 + m * 16 + fr; const float rs = rsqrtf(pg8::ss_get(ss + u.pm * 256 + row) * (1.0f / 1024.0f) + EPS);
#pragma unroll
                for (int bj = 0; bj < 2; ++bj) { const f32x4 v0 = acc[ai][bj][m][0] * rs, v1 = acc[ai][bj][m][1] * rs; v4u w;
                    w.x = pg8::EpiScaleF16::pkh(v0[0], v0[1]); w.y = pg8::EpiScaleF16::pkh(v0[2], v0[3]); w.z = pg8::EpiScaleF16::pkh(v1[0], v1[1]); w.w = pg8::EpiScaleF16::pkh(v1[2], v1[3]);
                    const int ci = bj * 16 + wc * 4 + fq; *(LAS v4u*)(tile + row * 512 + ((ci ^ (row & 7)) * 16)) = w; } }
        asm volatile("s_waitcnt lgkmcnt(0)" ::: "memory"); __builtin_amdgcn_s_barrier(); asm volatile("" ::: "memory");
        const int sub = lane & 15, grp = lane >> 4;
#pragma unroll 1
        for (int tk = wid; tk < 64; tk += 8) { const int row = tk * 4 + grp; const LAS unsigned char* rp = tile + row * 512; const int sw = sub ^ (row & 7);
            typedef _Float16 h8 __attribute__((ext_vector_type(8)));
            const h8 x = *(const LAS h8*)(rp + sw * 16), y = *(const LAS h8*)(rp + 256 + sw * 16);
            RouteIn R; R.a = (f32x4){(float)x[0], (float)x[1], (float)x[2], (float)x[3]}; R.b = (f32x4){(float)x[4], (float)x[5], (float)x[6], (float)x[7]};
            R.c = (f32x4){(float)y[0], (float)y[1], (float)y[2], (float)y[3]}; R.d = (f32x4){(float)y[4], (float)y[5], (float)y[6], (float)y[7]};
            peer_route_core(R, EIDX, GATE, u.pm * 256 + row, u.pn, lane); }
        asm volatile("s_waitcnt lgkmcnt(0)" ::: "memory"); __builtin_amdgcn_s_barrier(); asm volatile("" ::: "memory");
    }
};
struct XqIn { f32x4 xv[4]; float ss; };
__device__ __forceinline__ void peer_xq_load(XqIn& R, const bf16* X, const unsigned long long* ss, int tok, int lane) {
    const v4u a = *(const GAS v4u*)(X + (size_t)tok * 1024 + lane * 16), b = *(const GAS v4u*)(X + (size_t)tok * 1024 + lane * 16 + 8);
    R.xv[0] = (f32x4){bflo(a.x), bfhi(a.x), bflo(a.y), bfhi(a.y)}; R.xv[1] = (f32x4){bflo(a.z), bfhi(a.z), bflo(a.w), bfhi(a.w)};
    R.xv[2] = (f32x4){bflo(b.x), bfhi(b.x), bflo(b.y), bfhi(b.y)}; R.xv[3] = (f32x4){bflo(b.z), bfhi(b.z), bflo(b.w), bfhi(b.w)};
    R.ss = pg8::ss_get(ss + tok);
}
__device__ __forceinline__ void peer_xq_token(const XqIn& R, unsigned char* XQ, float* RSX, int tok, int lane) {
    float am = 0.f;
#pragma unroll
    for (int j = 0; j < 4; ++j) am = fmaxf(am, fmaxf(fmaxf(fabsf(R.xv[j].x), fabsf(R.xv[j].y)), fmaxf(fabsf(R.xv[j].z), fabsf(R.xv[j].w))));
    am = wave_max_f(am);
    const float sx = am > 0.f ? am * (1.0f / 127.0f) : 1.0f, isx = 1.0f / sx;
    v4u w;
#pragma unroll
    for (int j = 0; j < 4; ++j) { unsigned pk = 0u;
#pragma unroll
        for (int e = 0; e < 4; ++e) { const int q = (int)rintf(R.xv[j][e] * isx); pk |= ((unsigned)q & 0xffu) << (8 * e); }
        w[j] = pk; }
    *((GAS v4u*)(XQ + (size_t)tok * 1024) + lane) = w;
    if (lane == 0) RSX[tok] = rsqrtf(R.ss * (1.0f / 1024.0f) + EPS) * sx;
}
struct E1Set { v4u uu[8]; v4u xw; float rs, su, sv, gt; int tokj; };
__device__ __forceinline__ void e1_load(E1Set& S, const LAS unsigned* wl, int b, int ts, const unsigned char* XQ, const float* RSX, const float* GATE, const unsigned char* U8, const float* SU, const float* SV, int lane) {
    const unsigned d = (unsigned)__builtin_amdgcn_readfirstlane((int)wl[2048 + b]); const int start = (int)(d & 0xffffu), n = (int)((d >> 16) & 0xffu), tok = ts + (int)(d >> 24), grp = (lane >> 3) & 7;
    const unsigned ev8 = wl[start + ((lane & 7) < n ? (lane & 7) : n - 1)];
#pragma unroll
    for (int i = 0; i < 8; ++i) { const unsigned e = (unsigned)__builtin_amdgcn_readlane((int)ev8, i); S.uu[i] = *((const GAS v4u*)(U8 + (size_t)e * 1024) + lane); }
    S.xw = *((const GAS v4u*)(XQ + (size_t)tok * 1024) + lane); S.rs = RSX[tok];
    { const int gi = grp < n ? grp : n - 1; const unsigned ek = wl[start + gi], jk = wl[1024 + start + gi] & 0xffu; S.tokj = grp < n ? tok * 128 + (int)jk : -1; S.su = SU[ek]; S.sv = SV[ek]; S.gt = GATE[(size_t)tok * 128 + jk]; }
}
__device__ __forceinline__ void e1_compute(const E1Set& S, float* ACT, int lane) {
    const int b5 = (lane >> 5) & 1, b4 = (lane >> 4) & 1, b3 = (lane >> 3) & 1; int p[8];
#pragma unroll
    for (int i = 0; i < 8; ++i) { int d = __builtin_amdgcn_sdot4((int)S.uu[i].x, (int)S.xw.x, 0, false); d = __builtin_amdgcn_sdot4((int)S.uu[i].y, (int)S.xw.y, d, false);
        d = __builtin_amdgcn_sdot4((int)S.uu[i].z, (int)S.xw.z, d, false); d = __builtin_amdgcn_sdot4((int)S.uu[i].w, (int)S.xw.w, d, false); p[i] = d; }
    const int r0 = xadd32i(p[0], p[4]), r1 = xadd32i(p[1], p[5]), r2 = xadd32i(p[2], p[6]), r3 = xadd32i(p[3], p[7]);
    const int q0 = xadd16i(r0, r2), q1 = xadd16i(r1, r3);
    int t = (b3 ? q1 : q0) + ror8i(b3 ? q0 : q1);
    t = sum8i(t); (void)b5; (void)b4;
    if (S.tokj >= 0 && (lane & 7) == 0) ACT[S.tokj] = S.gt * gelu_tanh(S.rs * S.su * (float)t) * S.sv;
}
__device__ __forceinline__ void peer_e1_chunk(const unsigned char* XQ, const float* RSX, const unsigned* EIDX, const float* GATE, const unsigned char* U8, const float* SU, const float* SV,
                                              float* ACT, LAS unsigned* wl, int t0, int t1, int pi, int lane) {
    const unsigned long long lt = lanemask_lt(lane);
#pragma unroll 1
    for (int ts = t0; ts < t1; ts += 8) {
        const int nt = (t1 - ts) < 8 ? (t1 - ts) : 8;
        unsigned ee[8][2];
#pragma unroll
        for (int tl = 0; tl < 8; ++tl) { ee[tl][0] = 0xffffffffu; ee[tl][1] = 0xffffffffu; if (tl < nt) { ee[tl][0] = EIDX[(size_t)(ts + tl) * 128 + lane]; ee[tl][1] = EIDX[(size_t)(ts + tl) * 128 + 64 + lane]; } }
        int nent = 0, nbat = 0;
#pragma unroll
        for (int tl = 0; tl < 8; ++tl) {
            const bool s0 = (int)(ee[tl][0] >> 11) == pi, s1 = (int)(ee[tl][1] >> 11) == pi;
            const unsigned long long m0 = __ballot(s0), m1 = __ballot(s1);
            const int c0 = __builtin_popcountll(m0), c = c0 + __builtin_popcountll(m1);
            if (s0) { const int p = nent + __builtin_popcountll(m0 & lt); wl[p] = ee[tl][0]; wl[1024 + p] = (unsigned)lane; }
            if (s1) { const int p = nent + c0 + __builtin_popcountll(m1 & lt); wl[p] = ee[tl][1]; wl[1024 + p] = (unsigned)(64 + lane); }
            const int nb = (c + 7) >> 3;
            if (lane < nb) { const int rem = c - 8 * lane; wl[2048 + nbat + lane] = (unsigned)(nent + 8 * lane) | ((unsigned)(rem < 8 ? rem : 8) << 16) | ((unsigned)tl << 24); }
            nent += c; nbat += nb;
        }
        LDS_WAIT(); asm volatile("" ::: "memory");
        if (nbat > 0) {
            E1Set A, B;
            e1_load(A, wl, 0, ts, XQ, RSX, GATE, U8, SU, SV, lane);
#pragma unroll 1
            for (int b = 0; b < nbat; b += 2) {
                e1_load(B, wl, b + 1 < nbat ? b + 1 : nbat - 1, ts, XQ, RSX, GATE, U8, SU, SV, lane);
                e1_compute(A, ACT, lane);
                if (b + 1 >= nbat) break;
                e1_load(A, wl, b + 2 < nbat ? b + 2 : nbat - 1, ts, XQ, RSX, GATE, U8, SU, SV, lane);
                e1_compute(B, ACT, lane);
            }
        }
        LDS_WAIT(); asm volatile("" ::: "memory");
    }
}
__device__ __forceinline__ void e2_accum4(const v4u& d0v, const v4u& d1v, const v4u& d2v, const v4u& d3v, int W4, int (&y)[16]) {
#pragma unroll
    for (int k = 0; k < 4; ++k) { const unsigned d0 = d0v[k], d1 = d1v[k], d2 = d2v[k], d3 = d3v[k];
        const unsigned p01l = __builtin_amdgcn_perm(d1, d0, 0x05010400u), p01h = __builtin_amdgcn_perm(d1, d0, 0x07030602u);
        const unsigned p23l = __builtin_amdgcn_perm(d3, d2, 0x05010400u), p23h = __builtin_amdgcn_perm(d3, d2, 0x07030602u);
        y[4 * k + 0] = __builtin_amdgcn_sdot4((int)__builtin_amdgcn_perm(p23l, p01l, 0x05040100u), W4, y[4 * k + 0], false);
        y[4 * k + 1] = __builtin_amdgcn_sdot4((int)__builtin_amdgcn_perm(p23l, p01l, 0x07060302u), W4, y[4 * k + 1], false);
        y[4 * k + 2] = __builtin_amdgcn_sdot4((int)__builtin_amdgcn_perm(p23h, p01h, 0x05040100u), W4, y[4 * k + 2], false);
        y[4 * k + 3] = __builtin_amdgcn_sdot4((int)__builtin_amdgcn_perm(p23h, p01h, 0x07060302u), W4, y[4 * k + 3], false); }
}
struct E2Meta { f32x4 a[4]; unsigned x; };
template <bool HAS_B> __device__ __forceinline__ void e2_finish(const v4u (&V)[16], const E2Meta& M, float* Xo, bf16* Xob, float* sso, int tok, int pi, int col, int lane) {
    const int b3 = (lane >> 3) & 1;
    int y[16];
#pragma unroll
    for (int i = 0; i < 16; ++i) y[i] = 0;
    float am = 0.f;
#pragma unroll
    for (int i = 0; i < 4; ++i) am = fmaxf(am, fmaxf(fmaxf(fabsf(M.a[i].x), fabsf(M.a[i].y)), fmaxf(fabsf(M.a[i].z), fabsf(M.a[i].w))));
    am = wave_max_f(am);
    const float sw = am > 0.f ? am * (1.0f / 127.0f) : 1.0f, isw = 1.0f / sw;
#pragma unroll
    for (int g4 = 0; g4 < 4; ++g4) { const f32x4 a = M.a[g4];
        const int W4 = (int)(((unsigned)(int)rintf(a.x * isw) & 0xffu) | (((unsigned)(int)rintf(a.y * isw) & 0xffu) << 8) | (((unsigned)(int)rintf(a.z * isw) & 0xffu) << 16) | ((unsigned)(int)rintf(a.w * isw) << 24));
        e2_accum4(V[4 * g4], V[4 * g4 + 1], V[4 * g4 + 2], V[4 * g4 + 3], W4, y); }
    int z8[8];
#pragma unroll
    for (int i = 0; i < 8; ++i) z8[i] = (b3 ? y[8 + i] : y[i]) + ror8i(b3 ? y[i] : y[8 + i]);
    int z4[4];
#pragma unroll
    for (int i = 0; i < 4; ++i) z4[i] = xadd16i(z8[i], z8[4 + i]);
    int z2[2];
#pragma unroll
    for (int i = 0; i < 2; ++i) z2[i] = xadd32i(z4[i], z4[2 + i]);
    const float o0 = bflo(M.x) + sw * (float)z2[0], o1 = bfhi(M.x) + sw * (float)z2[1];
    if constexpr (!HAS_B) *(GAS f32x2*)(Xo + (size_t)tok * 1024 + col) = (f32x2){o0, o1};
    if constexpr (HAS_B) { *(GAS unsigned*)(Xob + (size_t)tok * 1024 + col) = pk2(o0, o1);
        float sq = o0 * o0 + o1 * o1; ROWSUM16F(sq);
        const float tot = (__int_as_float(__builtin_amdgcn_readlane(__float_as_int(sq), 0)) + __int_as_float(__builtin_amdgcn_readlane(__float_as_int(sq), 16))) + (__int_as_float(__builtin_amdgcn_readlane(__float_as_int(sq), 32)) + __int_as_float(__builtin_amdgcn_readlane(__float_as_int(sq), 48)));
        if (lane == 0) sso[(size_t)pi * MP + tok] = tot; }
}
template <bool HAS_B> __device__ __forceinline__ void peer_e2_chunk(const bf16* X, const unsigned* EIDX, const float* ACT, const unsigned char* V8, float* Xo, bf16* Xob, float* sso, int t0, int t1, int pi, int lane) {
    const int grp = lane >> 3, l8 = lane & 7, b3 = (lane >> 3) & 1, b4 = (lane >> 4) & 1, b5 = (lane >> 5) & 1;
    const int col = pi * 128 + l8 * 16 + b3 * 8 + b4 * 4 + b5 * 2;
    const unsigned char* vb = V8 + (size_t)pi * (16384 * 128) + l8 * 16;
    v4u vA[16], vB[16]; E2Meta mA, mB; v4u eN[4];
#define E2_LOADE(T) do { const GAS v4u* ep = (const GAS v4u*)(EIDX + (size_t)(T) * 128 + grp * 8); eN[0] = ep[0]; eN[1] = ep[1]; eN[2] = ep[16]; eN[3] = ep[17]; } while (0)
#define E2_META(T, M) do { const GAS f32x4* apn = (const GAS f32x4*)(ACT + (size_t)(T) * 128 + grp * 8); M.a[0] = apn[0]; M.a[1] = apn[1]; M.a[2] = apn[16]; M.a[3] = apn[17]; \
        M.x = *(const GAS unsigned*)(X + (size_t)(T) * 1024 + col); } while (0)
#define E2_GATHER16(V) do { _Pragma("unroll") for (int g4 = 0; g4 < 4; ++g4) { _Pragma("unroll") for (int k = 0; k < 4; ++k) V[4 * g4 + k] = *(const GAS v4u*)(vb + (size_t)eN[g4][k] * 128); } } while (0)
    E2_LOADE(t0); E2_META(t0, mA);
    E2_GATHER16(vA);
    const int tl = t1 - 1;
    E2_LOADE(t0 + 1 < t1 ? t0 + 1 : tl);
#pragma unroll 1
    for (int tok = t0; tok < t1; tok += 2) {
        { E2_GATHER16(vB); E2_META(tok + 1 < t1 ? tok + 1 : tl, mB); E2_LOADE(tok + 2 < t1 ? tok + 2 : tl); }
        e2_finish<HAS_B>(vA, mA, Xo, Xob, sso, tok, pi, col, lane);
        if (tok + 1 >= t1) break;
        { E2_GATHER16(vA); E2_META(tok + 2 < t1 ? tok + 2 : tl, mA); E2_LOADE(tok + 3 < t1 ? tok + 3 : tl); }
        e2_finish<HAS_B>(vB, mB, Xo, Xob, sso, tok + 1, pi, col, lane);
    }
#undef E2_GATHER16
#undef E2_META
#undef E2_LOADE
}
#define PEER_QLOOP_CHUNK(QBASE, BODY) do { const int home_ = (int)(xb_xcc_id() & 7u); \
    for (int k_ = 0; k_ < 8; ++k_) { const int pi = (home_ + k_) & 7; unsigned* qh_ = (QBASE) + pi * 64; \
        for (;;) { unsigned c_ = 0u; if (lane == 0) c_ = __hip_atomic_fetch_add(qh_, 16u, __ATOMIC_RELAXED, __HIP_MEMORY_SCOPE_AGENT); c_ = (unsigned)__builtin_amdgcn_readfirstlane((int)c_); \
            if (c_ >= (unsigned)NT) break; const int t0 = (int)c_, t1 = (int)c_ + 16 < NT ? (int)c_ + 16 : NT; BODY; } } } while (0)
__device__ __forceinline__ float wave_sum_dpp(float v) {
    ROWSUM16F(v);
    return (__int_as_float(__builtin_amdgcn_readlane(__float_as_int(v), 0)) + __int_as_float(__builtin_amdgcn_readlane(__float_as_int(v), 16))) + (__int_as_float(__builtin_amdgcn_readlane(__float_as_int(v), 32)) + __int_as_float(__builtin_amdgcn_readlane(__float_as_int(v), 48)));
}
struct PostRow { float x[33]; float wi; };
__device__ __forceinline__ void att_post_load(PostRow& R, const bf16* P, int row, int lane) {
    const bf16* p = P + (size_t)row * APAD;
#pragma unroll
    for (int i = 0; i < 33; ++i) R.x[i] = bflo((unsigned)p[i * 64 + lane]);
    R.wi = (lane < 8) ? bflo((unsigned)p[2112 + lane]) : 0.f;
}
__device__ __forceinline__ void att_post_compute(const PostRow& R, float gq, float gk, float gik, const float* tab,
                                                 bf16* QB, bf16* KB, bf16* V2B, bf16* QIB, bf16* KIB, float* WI, float* out, int row, int lane) {
    const float* tb = tab + (size_t)(row < NP ? (row & 4095) : 4096) * 64;
    const float cs = tb[lane & 31], sn0 = tb[32 + (lane & 31)], sn = (lane < 32) ? -sn0 : sn0;
    float* okp = (row < NP) ? out + O_KP + (size_t)row * 256 : out + O_KS + (size_t)(row - NP) * 256;
    float* ovp = (row < NP) ? out + O_VP + (size_t)row * 256 : out + O_VS + (size_t)(row - NP) * 256;
    float* oip = (row < NP) ? out + O_IP + (size_t)row * 64 : out + O_IS + (size_t)(row - NP) * 64;
#pragma unroll
    for (int i = 0; i < 33; ++i) {
        float x = R.x[i];
        if (i >= 20 && i < 24) { V2B[(size_t)row * 256 + (i - 20) * 64 + lane] = (bf16)f2bf(x); ovp[(i - 20) * 64 + lane] = x; continue; }
        const float g = (i < 16) ? gq : ((i < 20) ? gk : gik);
        if (i < 20 || i == 32) { const float ss = wave_sum_dpp(x * x); x = x * rsqrtf(ss * (1.0f / 64.0f) + EPS) * g; }
        const auto sw_ = __builtin_amdgcn_permlane32_swap(__float_as_uint(x), __float_as_uint(x), false, false);
        const float other = __uint_as_float(lane < 32 ? sw_[1] : sw_[0]);
        const float y = x * cs + other * sn;
        if (i < 16) QB[(size_t)row * 1024 + i * 64 + lane] = (bf16)f2bf(y * QSCALE);
        else if (i < 20) { KB[(size_t)row * 256 + (i - 16) * 64 + lane] = (bf16)f2bf(y); okp[(i - 16) * 64 + lane] = y; }
        else if (i < 32) QIB[(size_t)row * 512 + (i - 24) * 64 + lane] = (bf16)f2bf(y);
        else { KIB[(size_t)row * 64 + lane] = (bf16)f2bf(y); oip[lane] = y; }
    }
    if (lane < 8) WI[(size_t)row * 8 + lane] = R.wi * IDX_SCALE;
}

__device__ __forceinline__ void idx_scores_task(const bf16* QIB, const bf16* KIB, const float* WI, unsigned short* SC, int b, int qb, int kb_lo, int kb_hi, int lane) {
    const int l16 = lane & 15, q4 = lane >> 4; const size_t qrow = (size_t)b * SEQ + qb * 16 + l16;
    bf16x8 qf[8][2]; float wi[8];
#pragma unroll
    for (int h = 0; h < 8; ++h) { wi[h] = WI[qrow * 8 + h];
#pragma unroll
        for (int kk = 0; kk < 2; ++kk) qf[h][kk] = *(const GAS bf16x8*)(QIB + qrow * 512 + h * 64 + kk * 32 + q4 * 8); }
    const bf16* kbase = KIB + ((size_t)b * SEQ + l16) * 64 + q4 * 8;
    bf16x8 kr0[4], kr1[4];
#pragma unroll
    for (int j = 0; j < 4; ++j) { const int kb = (kb_lo + j < kb_hi) ? kb_lo + j : kb_lo; kr0[j] = *(const GAS bf16x8*)(kbase + (size_t)kb * 1024); kr1[j] = *(const GAS bf16x8*)(kbase + (size_t)kb * 1024 + 32); }
#pragma unroll 1
    for (int kb0 = kb_lo; kb0 < kb_hi; kb0 += 4) {
#pragma unroll
        for (int j = 0; j < 4; ++j) { const int kb = kb0 + j;
            const bf16x8 k0 = kr0[j], k1 = kr1[j];
            { const int kn = (kb + 4 < kb_hi) ? kb + 4 : kb_lo; kr0[j] = *(const GAS bf16x8*)(kbase + (size_t)kn * 1024); kr1[j] = *(const GAS bf16x8*)(kbase + (size_t)kn * 1024 + 32); }
            {
                f32x4 sc = {0.f, 0.f, 0.f, 0.f};
#pragma unroll
                for (int h = 0; h < 8; ++h) { f32x4 a = {0.f, 0.f, 0.f, 0.f};
                    a = __builtin_amdgcn_mfma_f32_16x16x32_bf16(k0, qf[h][0], a, 0, 0, 0);
                    a = __builtin_amdgcn_mfma_f32_16x16x32_bf16(k1, qf[h][1], a, 0, 0, 0);
#pragma unroll
                    for (int i = 0; i < 4; ++i) sc[i] += wi[h] * fmaxf(a[i], 0.f); }
                if (kb < kb_hi) { v2u w; w.x = pg8::EpiScaleF16::pkh(sc[0], sc[1]); w.y = pg8::EpiScaleF16::pkh(sc[2], sc[3]); *(GAS v2u*)(SC + qrow * 4096 + kb * 16 + 4 * q4) = w; } }
        }
    }
}

__device__ __forceinline__ void select_load(unsigned (&raw)[64], const unsigned short* SC, int row, int lane) {
    const int t = row & 4095, n = t + 1; if (n <= 256) return;
    const unsigned short* sc = SC + (size_t)row * 4096; const int nj = (n + 63) >> 6;
#pragma unroll
    for (int j = 0; j < 64; ++j) if (j < nj) raw[j] = (unsigned)sc[j * 64 + lane];
}
__device__ __forceinline__ void select_keys(unsigned (&x)[64], const unsigned (&raw)[64], int row, int lane) {
    const int t = row & 4095, n = t + 1; if (n <= 256) return; const int nj = (n + 63) >> 6;
#pragma unroll
    for (int j = 0; j < 64; ++j) { x[j] = 0u; if (j < nj) { const int s = j * 64 + lane; const unsigned h = raw[j];
            if (s < n) x[j] = ((h & 0x8000u) ? (~h & 0xffffu) : (h | 0x8000u)) + ((h & 0x7fffu) == 0u && (h & 0x8000u) ? 1u : 0u); } }
}
__device__ __forceinline__ void select_run(const unsigned (&x)[64], unsigned long long* BM, int row, int lane) {
    const int t = row & 4095, n = t + 1; unsigned long long* bm = BM + (size_t)row * 64;
    if (n <= 256) { const int lo = lane * 64; unsigned long long w = 0ull; if (lo + 63 <= t) w = ~0ull; else if (lo <= t) w = (2ull << (t - lo)) - 1ull; bm[lane] = w; return; }
    const int nj = (n + 63) >> 6;
    unsigned T = 0u; const int ngrp = (nj + 15) >> 4;
#pragma unroll 1
    for (int bit = 15; bit >= 0; --bit) { const unsigned c = T | (1u << bit); unsigned cv = 0u;
#pragma unroll
        for (int g = 0; g < 4; ++g) if (g < ngrp) {
#pragma unroll
            for (int j = g * 16; j < g * 16 + 16; ++j) asm("v_cmp_ge_u32 vcc, %1, %2\n\tv_addc_co_u32 %0, vcc, 0, %0, vcc" : "+v"(cv) : "v"(x[j]), "v"(c) : "vcc"); }
        asm volatile("s_nop 1" : "+v"(cv));
        int ci = (int)cv;
        ci += __builtin_amdgcn_update_dpp(0, ci, 0x121, 0xf, 0xf, false); ci += __builtin_amdgcn_update_dpp(0, ci, 0x122, 0xf, 0xf, false);
        ci += __builtin_amdgcn_update_dpp(0, ci, 0x124, 0xf, 0xf, false); ci += __builtin_amdgcn_update_dpp(0, ci, 0x128, 0xf, 0xf, false);
        const int cnt = __builtin_amdgcn_readlane(ci, 0) + __builtin_amdgcn_readlane(ci, 16) + __builtin_amdgcn_readlane(ci, 32) + __builtin_amdgcn_readlane(ci, 48);
        if (cnt >= 256) T = c; }
    int cgt = 0;
#pragma unroll
    for (int j = 0; j < 64; ++j) if (j < nj) cgt += __builtin_popcountll(__ballot(x[j] > T));
    const int need = 256 - cgt; int eqb = 0; const unsigned long long lt = lanemask_lt(lane); unsigned long long myw = 0ull;
#pragma unroll
    for (int j = 0; j < 64; ++j) if (j < nj) {
        const bool eq = (x[j] == T); const unsigned long long meq = __ballot(eq);
        const bool sl = (x[j] > T) || (eq && (eqb + __builtin_popcountll(meq & lt)) < need);
        const unsigned long long m = __ballot(sl);
        if (lane == j) myw = m;
        eqb += __builtin_popcountll(meq); }
    bm[lane] = myw;
}

constexpr int ATT_KP = 144, ATT_VP = 136, ATT_STAGE = 64 * ATT_KP + 64 * ATT_VP;
__device__ __forceinline__ void attend_unit(const bf16* QB, const bf16* KB, const bf16* VT, const unsigned long long* BM, bf16* OB, LAS unsigned char* lds, int b, int kvh, int qt, float nbound, int tid, unsigned* qnext, int& nxt) {
    const int lane = tid & 63, wave = tid >> 6, r32 = lane & 31, hi = lane >> 5, qh = wave >> 2, head = kvh * 4 + (wave & 3);
    const size_t qrow = (size_t)b * SEQ + qt * 64 + qh * 32 + r32;
    bf16x8 qf[4];
#pragma unroll
    for (int d0 = 0; d0 < 4; ++d0) qf[d0] = *(const GAS bf16x8*)(QB + qrow * 1024 + head * 64 + d0 * 16 + hi * 8);
    const int srow = tid >> 3, sch = tid & 7;
    const bf16* kg = KB + ((size_t)b * SEQ + srow) * 256 + kvh * 64 + sch * 8;
    const bf16* vg = VT + ((size_t)(b * 4 + kvh) * 64 + srow) * SEQ + sch * 8;
    const unsigned long long* bmq = BM + qrow * 64; const LAS unsigned char* mtab = lds + 3 * ATT_STAGE + 64;
    f32x16 o0 = {}, o1 = {}; f32x16 nb16; float ls[4] = {0.f, 0.f, 0.f, 0.f};
#pragma unroll
    for (int i = 0; i < 16; ++i) nb16[i] = nbound;
    const bf16x8 ones8 = {0x3F80, 0x3F80, 0x3F80, 0x3F80, 0x3F80, 0x3F80, 0x3F80, 0x3F80};
    const int nt = qt + 1;
#define ATT_STORE(T, KR, VR) do { LAS unsigned char* st_ = lds + ((T) % 3) * ATT_STAGE; *(LAS v4u*)(st_ + srow * ATT_KP + sch * 16) = KR; \
        LAS v2u* vp_ = (LAS v2u*)(st_ + 64 * ATT_KP + srow * ATT_VP + sch * 16); vp_[0] = (v2u){VR.x, VR.y}; vp_[1] = (v2u){VR.z, VR.w}; } while (0)
#define ATT_QK(T, P0, P1) do { const LAS unsigned char* st_ = lds + ((T) % 3) * ATT_STAGE; _Pragma("unroll") for (int d0 = 0; d0 < 4; ++d0) { \
        const bf16x8 k0 = *(const LAS bf16x8*)(st_ + r32 * ATT_KP + d0 * 32 + hi * 16), k1 = *(const LAS bf16x8*)(st_ + (32 + r32) * ATT_KP + d0 * 32 + hi * 16); \
        P0 = __builtin_amdgcn_mfma_f32_32x32x16_bf16(k0, qf[d0], P0, 0, 0, 0); P1 = __builtin_amdgcn_mfma_f32_32x32x16_bf16(k1, qf[d0], P1, 0, 0, 0); } } while (0)
#define ATT_BAR() do { asm volatile("s_waitcnt lgkmcnt(0)" ::: "memory"); __builtin_amdgcn_s_barrier(); asm volatile("" ::: "memory"); } while (0)
    auto tcl = [&](int t) { return t < nt ? t : nt - 1; };
    v4u kA = *(const GAS v4u*)kg, vA = *(const GAS v4u*)vg; unsigned long long wA = bmq[0];
    v4u kB = *(const GAS v4u*)(kg + (size_t)tcl(1) * 64 * 256), vB = *(const GAS v4u*)(vg + tcl(1) * 64); unsigned long long wB = bmq[tcl(1)];
    ATT_STORE(0, kA, vA);
    kA = *(const GAS v4u*)(kg + (size_t)tcl(2) * 64 * 256); vA = *(const GAS v4u*)(vg + tcl(2) * 64);
    ATT_BAR();
    f32x16 p0 = nb16, p1 = nb16;
    ATT_QK(0, p0, p1);
    auto step = [&](const int t, v4u& kq, v4u& vq, unsigned long long& wp) __attribute__((always_inline)) {
        const unsigned long long wcur = wp;
        if (t + 1 < nt) ATT_STORE(t + 1, kq, vq);
        ATT_BAR();
        { const int t3 = tcl(t + 3); wp = bmq[tcl(t + 2)]; kq = *(const GAS v4u*)(kg + (size_t)t3 * 64 * 256); vq = *(const GAS v4u*)(vg + t3 * 64); }
        if (t == 0 && tid == 0) nxt = (int)__hip_atomic_fetch_add(qnext, 1u, __ATOMIC_RELAXED, __HIP_MEMORY_SCOPE_AGENT);
        f32x16 n0 = nb16, n1 = nb16;
        ATT_QK(t + 1, n0, n1);
#pragma unroll
        for (int r = 0; r < 16; ++r) { p0[r] = fast_exp2(p0[r]); p1[r] = fast_exp2(p1[r]); }
        const unsigned ml = (unsigned)wcur >> (4 * hi), mh = (unsigned)(wcur >> 32) >> (4 * hi);
        unsigned pw[4][4];
#pragma unroll
        for (int g = 0; g < 4; ++g) {
            const v2u ma = *(const LAS v2u*)(mtab + (((ml >> (8 * g)) & 15u) << 3)), mb = *(const LAS v2u*)(mtab + (((mh >> (8 * g)) & 15u) << 3));
            const int r = 4 * g;
            pw[g >> 1][2 * (g & 1)] = cvtpk(p0[r], p0[r + 1]) & ma.x; pw[g >> 1][2 * (g & 1) + 1] = cvtpk(p0[r + 2], p0[r + 3]) & ma.y;
            pw[2 + (g >> 1)][2 * (g & 1)] = cvtpk(p1[r], p1[r + 1]) & mb.x; pw[2 + (g >> 1)][2 * (g & 1) + 1] = cvtpk(p1[r + 2], p1[r + 3]) & mb.y;
        }
        const LAS unsigned char* vb = lds + (t % 3) * ATT_STAGE + 64 * ATT_KP;
#pragma unroll
        for (int kk = 0; kk < 4; ++kk) {
            const bf16x8 pf = __builtin_bit_cast(bf16x8, (v4u){pw[kk][0], pw[kk][1], pw[kk][2], pw[kk][3]});
            const v2u a0 = *(const LAS v2u*)(vb + r32 * ATT_VP + (16 * kk + 4 * hi) * 2), a1 = *(const LAS v2u*)(vb + r32 * ATT_VP + (16 * kk + 4 * hi) * 2 + 16);
            const v2u c0 = *(const LAS v2u*)(vb + (32 + r32) * ATT_VP + (16 * kk + 4 * hi) * 2), c1 = *(const LAS v2u*)(vb + (32 + r32) * ATT_VP + (16 * kk + 4 * hi) * 2 + 16);
            o0 = __builtin_amdgcn_mfma_f32_32x32x16_bf16(__builtin_bit_cast(bf16x8, (v4u){a0.x, a0.y, a1.x, a1.y}), pf, o0, 0, 0, 0);
            o1 = __builtin_amdgcn_mfma_f32_32x32x16_bf16(__builtin_bit_cast(bf16x8, (v4u){c0.x, c0.y, c1.x, c1.y}), pf, o1, 0, 0, 0);
#pragma unroll
            for (int j = 0; j < 4; ++j) ls[j] = __builtin_amdgcn_fdot2_f32_bf16(__builtin_bit_cast(bf16x2_t, pw[kk][j]), __builtin_bit_cast(bf16x2_t, 0x3F803F80u), ls[j], false); }
        p0 = n0; p1 = n1;
    };
#pragma unroll 1
    for (int t = 0; t < nt; t += 2) {
        step(t, kB, vB, wA);
        if (t + 1 >= nt) break;
        step(t + 1, kA, vA, wB);
    }
#undef ATT_BAR
#undef ATT_STORE
#undef ATT_QK
    float lsum = (ls[0] + ls[1]) + (ls[2] + ls[3]); lsum += __shfl_xor(lsum, 32); const float inv = 1.0f / lsum;
    bf16* op = OB + qrow * 1024 + head * 64 + 4 * hi;
#pragma unroll
    for (int r4 = 0; r4 < 4; ++r4) {
        v2u w0, w1; w0.x = pk2(o0[4 * r4] * inv, o0[4 * r4 + 1] * inv); w0.y = pk2(o0[4 * r4 + 2] * inv, o0[4 * r4 + 3] * inv);
        w1.x = pk2(o1[4 * r4] * inv, o1[4 * r4 + 1] * inv); w1.y = pk2(o1[4 * r4 + 2] * inv, o1[4 * r4 + 3] * inv);
        *(GAS v2u*)(op + 8 * r4) = w0; *(GAS v2u*)(op + 32 + 8 * r4) = w1; }
    __syncthreads();
}

__device__ __forceinline__ void samp_scores_task(const bf16* QIB, const float* WI, const bf16* KIB, const float* cik, const int* page_table, unsigned* SKEYS, LAS float* scr, int b, int pg, int lane) {
    const size_t row = (size_t)NP + b;
    for (int i = lane; i < 512; i += 64) scr[i] = bflo((unsigned)QIB[row * 512 + i]);
    LDS_WAIT(); asm volatile("" ::: "memory");
    float wi[8];
#pragma unroll
    for (int h = 0; h < 8; ++h) wi[h] = WI[row * 8 + h];
    if (pg < NPAGE) {
        const int phys = page_table[b * NPAGE + pg];
#pragma unroll 1
        for (int rep = 0; rep < 2; ++rep) { const int kk = lane + rep * 64; const float* kr = cik + ((size_t)phys * 128 + kk) * 64; float d[8];
#pragma unroll
            for (int h = 0; h < 8; ++h) d[h] = 0.f;
#pragma unroll 4
            for (int c = 0; c < 16; ++c) { const f32x4 k4 = *(const GAS f32x4*)(kr + c * 4);
#pragma unroll
                for (int h = 0; h < 8; ++h) { const f32x4 q4 = *(const LAS f32x4*)(scr + h * 64 + c * 4); d[h] += k4[0] * q4[0] + k4[1] * q4[1] + k4[2] * q4[2] + k4[3] * q4[3]; } }
            float sc = 0.f;
#pragma unroll
            for (int h = 0; h < 8; ++h) sc += fmaxf(d[h], 0.f) * wi[h];
            SKEYS[(size_t)b * 16640 + pg * 128 + kk] = f2key(sc); }
    } else {
        const float kv = bflo((unsigned)KIB[row * 64 + lane]); float sc = 0.f;
#pragma unroll
        for (int h = 0; h < 8; ++h) { const float d = wave_sum(kv * scr[h * 64 + lane]); sc += fmaxf(d, 0.f) * wi[h]; }
        if (lane == 0) SKEYS[(size_t)b * 16640 + PAST] = f2key(sc);
    }
    LDS_WAIT(); asm volatile("" ::: "memory");
}
__device__ __forceinline__ void samp_select_attend(const unsigned* SKEYS, const bf16* QB, const bf16* KB, const bf16* V2B, const float* ck, const float* cv, const int* page_table,
                                                   bf16* OB, LAS unsigned char* lds, int b, int tid) {
    LAS int* cnt = (LAS int*)lds;
    LAS int* sl = (LAS int*)(lds + 64);
    LAS float* qs = (LAS float*)(lds + 64 + 1024);
    LAS float* lg = (LAS float*)(lds + 64 + 1024 + 4096);
    const int lane = tid & 63, w = tid >> 6; const size_t row = (size_t)NP + b; const int n = PAST + 1;
    const unsigned* kk = SKEYS + (size_t)b * 16640;
    unsigned x[33];
#pragma unroll
    for (int j = 0; j < 33; ++j) { const int s = j * 512 + tid; x[j] = (s < n) ? kk[s] : 0u; }
    for (int i = tid; i < 1024; i += NTHR) qs[i] = bflo((unsigned)QB[row * 1024 + i]);
    if (tid < 4) cnt[tid] = 0;
    __syncthreads();
    unsigned T = 0u;
#pragma unroll 1
    for (int bit = 31; bit >= 0; --bit) { const unsigned c = T | (1u << bit); int my = 0;
#pragma unroll
        for (int j = 0; j < 33; ++j) my += __builtin_popcountll(__ballot(x[j] >= c));
        if (lane == 0) atomicAdd((int*)&cnt[bit & 1], my);
        __syncthreads();
        const int tot = cnt[bit & 1]; if (tot >= 256) T = c;
        if (tid == 0) cnt[(bit + 1) & 1] = 0;
        __syncthreads(); }
    { const unsigned long long lt = lanemask_lt(lane); int cg = 0, ce = 0;
#pragma unroll
      for (int j = 0; j < 33; ++j) { cg += __builtin_popcountll(__ballot(x[j] > T)); ce += __builtin_popcountll(__ballot(x[j] == T)); }
      LAS int* wc = (LAS int*)(lds + 22656);
      if (lane == 0) { wc[w * 2] = cg; wc[w * 2 + 1] = ce; }
      __syncthreads();
      int bg = 0, be = 0, tg = 0;
      for (int ww = 0; ww < NWAVES; ++ww) { const int a_ = wc[ww * 2], e_ = wc[ww * 2 + 1]; if (ww < w) { bg += a_; be += e_; } tg += a_; }
      const int need = 256 - tg;
#pragma unroll
      for (int j = 0; j < 33; ++j) { const bool sg = x[j] > T, se = x[j] == T; const unsigned long long mg = __ballot(sg), me = __ballot(se);
          if (sg) sl[bg + __builtin_popcountll(mg & lt)] = j * 512 + tid;
          if (se) { const int r = be + __builtin_popcountll(me & lt); if (r < need) sl[tg + r] = j * 512 + tid; }
          bg += __builtin_popcountll(mg); be += __builtin_popcountll(me); } }
    __syncthreads();
    LAS int* prow = (LAS int*)(lds + 64 + 1024 + 4096 + 16384);
    if (tid < 256) { const int s = sl[tid]; prow[tid] = (s >= PAST) ? -1 : page_table[b * NPAGE + (s >> 7)] * 128 + (s & 127); }
    __syncthreads();
    { const int n_ = tid & 255, hh = tid >> 8; const int pr = prow[n_];
      float kv[2][64];
      if (pr >= 0) { const float* krf = ck + (size_t)pr * 256 + hh * 128;
#pragma unroll
          for (int i = 0; i < 32; ++i) { const f32x4 k4 = *(const GAS f32x4*)(krf + i * 4); kv[i >> 4][(i & 15) * 4] = k4[0]; kv[i >> 4][(i & 15) * 4 + 1] = k4[1]; kv[i >> 4][(i & 15) * 4 + 2] = k4[2]; kv[i >> 4][(i & 15) * 4 + 3] = k4[3]; } }
      else { const bf16* krb = KB + row * 256 + hh * 128;
#pragma unroll
          for (int i = 0; i < 128; ++i) kv[i >> 6][i & 63] = bflo((unsigned)krb[i]); }
#pragma unroll
      for (int hq = 0; hq < 8; ++hq) { const int h = hh * 8 + hq; float d = 0.f;
#pragma unroll
          for (int i = 0; i < 64; i += 4) { const f32x4 q4 = *(const LAS f32x4*)(qs + h * 64 + i); d += q4[0] * kv[hq >> 2][i] + q4[1] * kv[hq >> 2][i + 1] + q4[2] * kv[hq >> 2][i + 2] + q4[3] * kv[hq >> 2][i + 3]; }
          lg[h * 256 + n_] = d; } }
    __syncthreads();
    for (int h = w; h < 16; h += NWAVES) { float v[4]; float m = -INFINITY;
#pragma unroll
        for (int i = 0; i < 4; ++i) { v[i] = lg[h * 256 + i * 64 + lane]; m = fmaxf(m, v[i]); }
#pragma unroll
        for (int o = 1; o < 64; o <<= 1) m = fmaxf(m, __shfl_xor(m, o));
        float sum = 0.f;
#pragma unroll
        for (int i = 0; i < 4; ++i) { v[i] = fast_exp2(v[i] - m); sum += v[i]; }
        sum = wave_sum(sum); const float inv = 1.0f / sum;
#pragma unroll
        for (int i = 0; i < 4; ++i) lg[h * 256 + i * 64 + lane] = v[i] * inv; }
    __syncthreads();
    {
        LAS float* red = (LAS float*)(lds + 24576);
        const int kvh = lane >> 4, d0 = (lane & 15) * 4;
        f32x4 vr[32];
#pragma unroll
        for (int jj = 0; jj < 32; ++jj) { const int pr = prow[w * 32 + jj];
            if (pr >= 0) vr[jj] = *(const GAS f32x4*)(cv + (size_t)pr * 256 + kvh * 64 + d0);
            else { const v2u vb = *(const GAS v2u*)(V2B + row * 256 + kvh * 64 + d0); vr[jj] = (f32x4){bflo(vb.x), bfhi(vb.x), bflo(vb.y), bfhi(vb.y)}; } }
        f32x4 acc[4];
#pragma unroll
        for (int g = 0; g < 4; ++g) acc[g] = (f32x4){0.f, 0.f, 0.f, 0.f};
#pragma unroll
        for (int jj = 0; jj < 32; ++jj) {
#pragma unroll
            for (int g = 0; g < 4; ++g) acc[g] += vr[jj] * lg[(kvh * 4 + g) * 256 + w * 32 + jj]; }
#pragma unroll
        for (int g = 0; g < 4; ++g) *(LAS f32x4*)(red + w * 1024 + (kvh * 4 + g) * 64 + d0) = acc[g];
        __syncthreads();
        { const int c = tid * 2; float o0 = 0.f, o1 = 0.f;
#pragma unroll
          for (int ww = 0; ww < 8; ++ww) { const f32x2 r2 = *(const LAS f32x2*)(red + ww * 1024 + c); o0 += r2[0]; o1 += r2[1]; }
          *(GAS unsigned*)(OB + row * 1024 + c) = pk2(o0, o1); }
    }
    __syncthreads();
}

template <int K> __device__ __forceinline__ void thin_gemm_tile(const bf16* A, const bf16* Bt, int col0, LAS float* red, int tid, float& v0, float& v1) {
    const int lane = tid & 63, w = tid >> 6, r32 = lane & 31, hi = lane >> 5;
    constexpr int KS = K / 8, NS = KS / 16;
    const bf16* ap = A + (size_t)r32 * K + w * KS + hi * 8;
    const bf16* bp = Bt + (size_t)(col0 + r32) * K + w * KS + hi * 8;
    f32x16 acc = {};
    bf16x8 af[NS], bf_[NS];
#pragma unroll
    for (int i = 0; i < NS; ++i) { af[i] = *(const GAS bf16x8*)(ap + i * 16); bf_[i] = *(const GAS bf16x8*)(bp + i * 16); }
#pragma unroll
    for (int i = 0; i < NS; ++i) acc = __builtin_amdgcn_mfma_f32_32x32x16_bf16(af[i], bf_[i], acc, 0, 0, 0);
    __syncthreads();
#pragma unroll
    for (int i = 0; i < 16; ++i) red[w * 1024 + ((i & 3) + 8 * (i >> 2) + 4 * hi) * 32 + r32] = acc[i];
    __syncthreads();
    v0 = 0.f; v1 = 0.f;
#pragma unroll
    for (int ww = 0; ww < 8; ++ww) { const f32x2 t = *(const LAS f32x2*)(red + ww * 1024 + tid * 2); v0 += t[0]; v1 += t[1]; }
}
__device__ __forceinline__ float row16_sum(float v) {
    v += __shfl_xor(v, 1); v += __shfl_xor(v, 2); v += __shfl_xor(v, 4); v += __shfl_xor(v, 8); return v;
}

__global__ void __launch_bounds__(NTHR, 2) fused_fwd(Params prm) {
    extern __shared__ __attribute__((aligned(16))) unsigned char lds_raw[];
    LAS unsigned char* lds = (LAS unsigned char*)lds_raw;
    volatile LAS unsigned* MISC = (volatile LAS unsigned*)(lds + MISC_OFF);
    const int tid = threadIdx.x, lane = tid & 63, wave = __builtin_amdgcn_readfirstlane(tid >> 6);
    const int G = gridDim.x, bid = blockIdx.x;
    const int gw = bid * NWAVES + wave, NGW = G * NWAVES;
    unsigned char* ws = prm.ws;
    for (int u = tid; u < (LDS_BYTES - RING_BYTES) / 4; u += NTHR) ((LAS unsigned*)(lds + RING_BYTES))[u] = 0u;
    __syncthreads();
    XcdBarrier bar = xcd_barrier_post((unsigned*)ws + CW_BAR, MISC + 8);
    const int lo = prm.ph_lo, hi = prm.ph_hi;
#ifndef REPMASK
#define REPMASK 0
#endif
#define REP(k) (((REPMASK >> (k)) & 1) ? 2 : 1)
#ifndef DISMASK
#define DISMASK 0
#endif
#define IN(k) (lo <= (k) && (k) < hi && !((DISMASK >> (k)) & 1))
#define SEAM(k) do { if (IN(k) && IN((k) + 1)) xcd_barrier(bar); } while (0)
    const float* x_prompt = prm.in[0]; const float* x_sample = prm.in[1]; const float* cache_k = prm.in[2]; const float* cache_v = prm.in[3]; const float* cache_ik = prm.in[4];
    const int* page_table = (const int*)prm.in[5]; const float* norm_mix_g = prm.in[6]; const float* norm_ffn_g = prm.in[7];
    const float* gmlp_w_in = prm.in[8]; const float* gmlp_v_g = prm.in[9]; const float* gmlp_w_s = prm.in[10]; const float* gmlp_b_s = prm.in[11]; const float* gmlp_w_out = prm.in[12];
    const float* att_w_in = prm.in[13]; const float* att_qg = prm.in[14]; const float* att_kg = prm.in[15]; const float* att_ikg = prm.in[16]; const float* att_w_out = prm.in[17];
    const float* peer_wq = prm.in[18]; const float* peer_k1 = prm.in[19]; const float* peer_k2 = prm.in[20]; const float* peer_u = prm.in[21]; const float* peer_v = prm.in[22];
    float* out = prm.out;
    unsigned long long* SSV = (unsigned long long*)(ws + W_SSV); unsigned long long* SS1 = (unsigned long long*)(ws + W_SS1); unsigned long long* SS3 = (unsigned long long*)(ws + W_SS3); float* SS0 = (float*)(ws + W_SS0); float* SS2 = (float*)(ws + W_SS2); unsigned* QC = (unsigned*)(ws + W_QC);
    unsigned char* XQ = ws + W_XQ; float* RSX = (float*)(ws + W_RSX); float* ACT = (float*)(ws + W_ACT);
    bf16* X0B = (bf16*)(ws + W_X0B); bf16* WIN0T = (bf16*)(ws + W_WIN0T); bf16* WOUT0T = (bf16*)(ws + W_WOUT0T); bf16* WP0T = (bf16*)(ws + W_WP0T); bf16* WP1T = (bf16*)(ws + W_WP1T);
    bf16* WIN1T = (bf16*)(ws + W_WIN1T); bf16* WOUT1T = (bf16*)(ws + W_WOUT1T); float* WSMT = (float*)(ws + W_WSMT); float* ROPE = (float*)(ws + W_ROPE);
    unsigned char* U8 = ws + W_UB; unsigned char* V8 = ws + W_VB; float* SU = (float*)(ws + W_SU); float* SV = (float*)(ws + W_SV); bf16* X1B = (bf16*)(ws + W_X1B); bf16* X2B = (bf16*)(ws + W_X2B); bf16* X3B = (bf16*)(ws + W_X3B);
    bf16* U0 = (bf16*)(ws + W_U0); bf16* V0 = (bf16*)(ws + W_V0); bf16* G0 = (bf16*)(ws + W_G0); unsigned short* SH = (unsigned short*)(ws + W_BIG); bf16* PBF = (bf16*)(ws + W_BIG); unsigned short* SC = (unsigned short*)(ws + W_BIG);
    unsigned* EIDX = (unsigned*)(ws + W_EIDX); float* GATE = (float*)(ws + W_GATE);
    bf16* QB = (bf16*)(ws + W_QB); bf16* KB = (bf16*)(ws + W_KB); bf16* V2B = (bf16*)(ws + W_V2B); bf16* QIB = (bf16*)(ws + W_QIB); bf16* KIB = (bf16*)(ws + W_KIB); float* WI = (float*)(ws + W_WI);
    unsigned long long* BM = (unsigned long long*)(ws + W_SEL); bf16* VT = (bf16*)(ws + W_VT); unsigned* SKEYS = (unsigned*)(ws + W_SKEYS); bf16* OB = (bf16*)(ws + W_OB);

    if (IN(0)) for (int rep = 0; rep < REP(0); ++rep) {
        LAS float* scr = (LAS float*)(lds + wave * 16384);
        constexpr int I_X = MP, I_WIN0 = 16 * 128, I_WOUT0 = 32 * 32, I_WIN1 = 16 * 72, I_WOUT1 = 16 * 32, I_WP = 2 * 16 * 64, I_U = 2 * 16384, I_V = 2 * 16384, I_ROPE = (4097 * 32 + 63) / 64, I_WSM = 8 * 128 * 128 / 64;
        constexpr int TOTAL = I_WIN0 + I_WOUT0 + I_WIN1 + I_WOUT1 + I_WP + I_ROPE + I_WSM;
        for (int it = gw; it < TOTAL; it += NGW) {
            int r = it;
            if (r < I_WP) { const int l = r >> 10, hh = (r >> 6) & 15, jb = r & 63, h = hh >> 1, half = hh & 1;
                p0_wp_item(peer_wq + (size_t)l * 1024 * 2048, (half ? peer_k2 : peer_k1) + (size_t)l * 16384, norm_ffn_g + l * 1024, l ? WP1T : WP0T, h * 256 + half * 128, jb * 16, scr, lane); continue; } r -= I_WP;
            if (r < I_WIN0) { p0_transpose_item(gmlp_w_in, 4096, 1024, 128, 4096, norm_mix_g, WIN0T, scr, r, lane); continue; } r -= I_WIN0;
            if (r < I_WOUT0) { p0_transpose_item(gmlp_w_out, 1024, 2048, 32, 1024, nullptr, WOUT0T, scr, r, lane); continue; } r -= I_WOUT0;
            if (r < I_WIN1) { p0_transpose_item(att_w_in, APROJ, 1024, 72, APROJ, norm_mix_g + 1024, WIN1T, scr, r, lane); continue; } r -= I_WIN1;
            if (r < I_WOUT1) { p0_transpose_item(att_w_out, 1024, 1024, 32, 1024, nullptr, WOUT1T, scr, r, lane); continue; } r -= I_WOUT1;
            if (r < I_ROPE) { const int i = r * 64 + lane; if (i < 4097 * 32) { const int p = i >> 5, d = i & 31; const float pos = (p < 4096) ? (float)p : 16384.0f;
                    const float ang = pos * prm.inv[d]; const double rev = (double)ang * 0.15915494309189535; const float fr = (float)(rev - floor(rev));
                    ROPE[p * 64 + d] = __builtin_amdgcn_cosf(fr); ROPE[p * 64 + 32 + d] = __builtin_amdgcn_sinf(fr); } continue; } r -= I_ROPE;
            { const int e = r * 64 + lane, t = (e >> 7) & 127, s = e & 127; ((unsigned short*)WSMT)[e] = (unsigned short)((s <= t) ? (cvtpk(gmlp_w_s[e], 0.f) & 0xffffu) : 0u); }
        }
        {
            auto xsrc = [&](int r) { return r < NP ? x_prompt + (size_t)r * 1024 : (r < NT ? x_sample + (size_t)(r - NP) * 1024 : (const float*)nullptr); };
            RowIn A, B; int r = gw; if (r < I_X) p0_rowx_load(A, xsrc(r), lane);
            for (; r < I_X; r += 2 * NGW) {
                if (r + NGW < I_X) p0_rowx_load(B, xsrc(r + NGW), lane);
                { const float sq = p0_rowx_store(A, X0B + (size_t)r * 1024, lane); if (lane == 0) SS0[r] = sq; }
                if (r + NGW >= I_X) break;
                if (r + 2 * NGW < I_X) p0_rowx_load(A, xsrc(r + 2 * NGW), lane);
                { const float sq = p0_rowx_store(B, X0B + (size_t)(r + NGW) * 1024, lane); if (lane == 0) SS0[r + NGW] = sq; } } }
        {
            RowIn A, B; int r = gw;
            auto qsrc = [&](int q) { return q < I_U ? peer_u + (size_t)q * 1024 : peer_v + (size_t)(q - I_U) * 1024; };
            auto qst = [&](const RowIn& R, int q) { if (q < I_U) p0_rowq_store(R, norm_ffn_g + (q >> 14) * 1024, U8 + (size_t)q * 1024, SU + q, lane, false, 0);
                                                    else { const int v = q - I_U; p0_rowq_store(R, nullptr, V8 + (size_t)(v >> 14) * 16384 * 1024, SV + v, lane, true, v & 16383); } };
            if (r < I_U + I_V) p0_rowq_load(A, qsrc(r), lane);
            for (; r < I_U + I_V; r += 2 * NGW) {
                if (r + NGW < I_U + I_V) p0_rowq_load(B, qsrc(r + NGW), lane);
                qst(A, r);
                if (r + NGW >= I_U + I_V) break;
                if (r + 2 * NGW < I_U + I_V) p0_rowq_load(A, qsrc(r + 2 * NGW), lane);
                qst(B, r + NGW); } }
    }
    SEAM(0);
    if (IN(1)) for (int rep = 0; rep < REP(1); ++rep) { pg8::Gemm g{X0B, WIN0T, NP, 4096, 1024}; pg8::StaticOrder S; S.init(NP, 4096, G, bid); pg8::EpiUV E{U0, V0, SS0, SSV, rep == 0};
        pg8::gemm_phase<pg8::EpiUV, pg8::StaticOrder, true, true>(lds, g, S, E);
        for (int tk = bid; tk < 4096 / 32; tk += G) { float v0, v1; thin_gemm_tile<1024>(X0B + (size_t)NP * 1024, WIN0T, tk * 32, (LAS float*)lds, tid, v0, v1);
            const int r = tid >> 4, row = NP + r, col = tk * 32 + 2 * (tid & 15); const float rs = rsqrtf(SS0[row] * (1.0f / 1024.0f) + EPS); v0 *= rs; v1 *= rs;
            if (col < 2048) *(GAS unsigned*)(U0 + (size_t)row * 2048 + col) = pk2(v0, v1);
            else { *(GAS unsigned*)(V0 + (size_t)row * 2048 + col - 2048) = pk2(v0, v1); const float sq = row16_sum(v0 * v0 + v1 * v1); if ((tid & 15) == 0 && rep == 0) pg8::ss_add(SSV + row, sq); } } }
    SEAM(1);
    if (IN(2)) for (int rep = 0; rep < REP(2); ++rep) {
        typedef short s16x4_t __attribute__((ext_vector_type(4)));
        LAS float* rvs = (LAS float*)(lds + 98304); LAS unsigned char* slab = lds + wave * 8192; LAS float* vgl = (LAS float*)(lds + 65536 + wave * 1024);
        const int c = tid * 4, g = wave, r32 = lane & 31, hi = lane >> 5;
        for (int unit = bid; unit < 256; unit += G) {
            const int row0 = unit * 128;
            __syncthreads();
            { int tl = tid; asm volatile("" : "+v"(tl));
              if (tl < 128) rvs[tl] = rsqrtf(pg8::ss_get(SSV + row0 + tl) * (1.0f / 2048.0f) + EPS);
              for (int i = tl & 63; i < 256; i += 64) vgl[i] = gmlp_v_g[g * 256 + i]; }
            __syncthreads();
            const __amdgpu_buffer_rsrc_t rV = __builtin_amdgcn_make_buffer_rsrc((void*)V0, 0, 0x7fffffff, 0x00020000), rU = __builtin_amdgcn_make_buffer_rsrc((void*)U0, 0, 0x7fffffff, 0x00020000), rG = __builtin_amdgcn_make_buffer_rsrc((void*)G0, 0, 0x7fffffff, 0x00020000);
            const unsigned voffv = (unsigned)(((lane >> 2) * 2048 + g * 256 + (lane & 3) * 8) * 2), voffu = (unsigned)((r32 * 2048 + g * 256 + 4 * hi) * 2);
            const __amdgpu_buffer_rsrc_t rW = __builtin_amdgcn_make_buffer_rsrc((void*)WSMT, 0, 0x7fffffff, 0x00020000); const unsigned voffw = (unsigned)((r32 * 128 + 8 * hi) * 2); const int gs = __builtin_amdgcn_readfirstlane(g);
            v4u pv[8]; v2u pu[16];
#pragma unroll
            for (int i = 0; i < 8; ++i) pv[i] = __builtin_amdgcn_raw_buffer_load_b128(rV, voffv, (row0 + 16 * i) * 4096, 0);
#pragma unroll
            for (int j = 0; j < 16; ++j) pu[j] = __builtin_amdgcn_raw_buffer_load_b64(rU, voffu, (row0 + 32 * (j >> 2)) * 4096 + 16 * (j & 3), 0);
            bf16x8 wf[20]; float bias[4], rv8[8];
#pragma unroll
            for (int i = 0; i < 8; ++i) rv8[i] = rvs[(lane >> 2) + 16 * i];
#pragma unroll
            for (int tb = 0; tb < 4; ++tb) { bias[tb] = gmlp_b_s[g * 128 + tb * 32 + r32];
#pragma unroll
                for (int kk = 0; kk < 2 * tb + 2; ++kk) wf[tb * (tb + 1) + kk] = __builtin_bit_cast(bf16x8, __builtin_amdgcn_raw_buffer_load_b128(rW, voffw, (gs * 128 + tb * 32) * 256 + kk * 32, 0)); }
            LAS unsigned char* trp = slab + (8 * hi + ((lane & 15) >> 2)) * 64 + (((lane >> 4) & 1) * 16 + (lane & 3) * 4) * 2;
#pragma unroll 1
            for (int cb = 0; cb < 8; ++cb) {
#pragma unroll
                for (int i = 0; i < 8; ++i) { const float rv = rv8[i]; v4u w; w.x = cvtpk(bflo(pv[i].x) * rv, bfhi(pv[i].x) * rv); w.y = cvtpk(bflo(pv[i].y) * rv, bfhi(pv[i].y) * rv); w.z = cvtpk(bflo(pv[i].z) * rv, bfhi(pv[i].z) * rv); w.w = cvtpk(bflo(pv[i].w) * rv, bfhi(pv[i].w) * rv);
                    *(LAS v4u*)(slab + ((lane >> 2) + 16 * i) * 64 + (lane & 3) * 16) = w; }
                if (cb + 1 < 8) {
#pragma unroll
                    for (int i = 0; i < 8; ++i) pv[i] = __builtin_amdgcn_raw_buffer_load_b128(rV, voffv, (row0 + 16 * i) * 4096 + (cb + 1) * 64, 0); }
                LDS_WAIT(); asm volatile("" ::: "memory");
                bf16x8 af[8];
#pragma unroll
                for (int kk = 0; kk < 8; ++kk) { const s16x4_t lo = __builtin_amdgcn_ds_read_tr16_b64_v4i16((LAS s16x4_t*)(trp + kk * 1024)), h4 = __builtin_amdgcn_ds_read_tr16_b64_v4i16((LAS s16x4_t*)(trp + kk * 1024 + 256));
                    af[kk] = (bf16x8){lo[0], lo[1], lo[2], lo[3], h4[0], h4[1], h4[2], h4[3]}; }
#pragma unroll
                for (int tb = 0; tb < 4; ++tb) { f32x16 acc = {};
#pragma unroll
                    for (int kk = 0; kk < 2 * tb + 2; ++kk) acc = __builtin_amdgcn_mfma_f32_32x32x16_bf16(af[kk], wf[tb * (tb + 1) + kk], acc, 0, 0, 0);
#pragma unroll
                    for (int i4 = 0; i4 < 4; ++i4) { const f32x4 vg = *(const LAS f32x4*)(vgl + cb * 32 + 8 * i4 + 4 * hi); const v2u uu = pu[tb * 4 + i4];
                        const float o0 = bflo(uu.x) * (acc[4 * i4] * vg[0] + bias[tb]), o1 = bfhi(uu.x) * (acc[4 * i4 + 1] * vg[1] + bias[tb]), o2 = bflo(uu.y) * (acc[4 * i4 + 2] * vg[2] + bias[tb]), o3 = bfhi(uu.y) * (acc[4 * i4 + 3] * vg[3] + bias[tb]);
                        v2u w; w.x = pk2(o0, o1); w.y = pk2(o2, o3); __builtin_amdgcn_raw_buffer_store_b64(w, rG, voffu, (row0 + 32 * tb) * 4096 + cb * 64 + 16 * i4, 0); }
                    __builtin_amdgcn_sched_barrier(0); }
                if (cb + 1 < 8) {
#pragma unroll
                    for (int j = 0; j < 16; ++j) pu[j] = __builtin_amdgcn_raw_buffer_load_b64(rU, voffu, (row0 + 32 * (j >> 2)) * 4096 + (cb + 1) * 64 + 16 * (j & 3), 0); }
                LDS_WAIT(); asm volatile("" ::: "memory");
            }
        }
        for (int r = bid; r < MP - NP; r += G) {
            const int row = NP + r; const float rv = rsqrtf(pg8::ss_get(SSV + row) * (1.0f / 2048.0f) + EPS); const f32x4 vg = *(const GAS f32x4*)(gmlp_v_g + c);
            const v2u vv = *(const GAS v2u*)(V0 + (size_t)row * 2048 + c); const v2u uu = *(const GAS v2u*)(U0 + (size_t)row * 2048 + c);
            const float w00 = gmlp_w_s[(size_t)g * 16384], bias = gmlp_b_s[g * 128];
            const float n0 = bflo(vv.x) * rv * vg[0], n1 = bfhi(vv.x) * rv * vg[1], n2 = bflo(vv.y) * rv * vg[2], n3 = bfhi(vv.y) * rv * vg[3];
            v2u w; w.x = pk2(bflo(uu.x) * (w00 * n0 + bias), bfhi(uu.x) * (w00 * n1 + bias)); w.y = pk2(bflo(uu.y) * (w00 * n2 + bias), bfhi(uu.y) * (w00 * n3 + bias));
            *(GAS v2u*)(G0 + (size_t)row * 2048 + c) = w;
            if (r < NS) *(GAS f32x4*)(out + O_CV + (size_t)r * 2048 + c) = (f32x4){n0, n1, n2, n3};
        }
    }
    SEAM(2);
    if (IN(3)) for (int rep = 0; rep < REP(3); ++rep) { pg8::Gemm g{G0, WOUT0T, NP, 1024, 2048}; pg8::StaticOrder S; S.init(NP, 1024, G, bid); pg8::EpiResid<false> E{x_prompt, x_sample, X1B, SS1, NP, NT, rep == 0};
        pg8::gemm_phase<pg8::EpiResid<false>, pg8::StaticOrder, true, true>(lds, g, S, E);
        for (int tk = bid; tk < 1024 / 32; tk += G) { float v0, v1; thin_gemm_tile<2048>(G0 + (size_t)NP * 2048, WOUT0T, tk * 32, (LAS float*)lds, tid, v0, v1);
            const int r = tid >> 4, row = NP + r, col = tk * 32 + 2 * (tid & 15); const f32x2 xr = *(const GAS f32x2*)(x_sample + (size_t)r * 1024 + col); v0 += xr[0]; v1 += xr[1];
            *(GAS unsigned*)(X1B + (size_t)row * 1024 + col) = pk2(v0, v1); const float sq = row16_sum(v0 * v0 + v1 * v1); if ((tid & 15) == 0 && rep == 0) pg8::ss_add(SS1 + row, sq); } }
    SEAM(3);
    if (IN(4)) for (int rep = 0; rep < REP(4); ++rep) { pg8::Gemm g{X1B, WP0T, NP, 2048, 1024};
        if (G == 256) {
            const EpiRoute ER{SS1, EIDX, GATE};
            { OneUnit S1; S1.init(NP, 2048, G, bid); S1.k = 0; pg8::gemm_phase<EpiRoute, OneUnit, false, true>(lds, g, S1, ER); }
            { OneUnit S1; S1.init(NP, 2048, G, bid); S1.k = 1; pg8::gemm_phase<EpiRoute, OneUnit, false, true>(lds, g, S1, ER); }
            { OneUnit S1; S1.init(NP, 2048, G, bid); S1.k = 2; pg8::gemm_phase<EpiRoute, OneUnit, false, true>(lds, g, S1, ER); }
            { OneUnit S1; S1.init(NP, 2048, G, bid); S1.k = 3; pg8::gemm_phase<EpiRoute, OneUnit, false, true>(lds, g, S1, ER); }
        } else { pg8::StaticOrder S; S.init(NP, 2048, G, bid); pg8::EpiScaleF16 E{SH, 2048, SS1};
            pg8::gemm_phase<pg8::EpiScaleF16, pg8::StaticOrder, true, true>(lds, g, S, E); }
        for (int tk = bid; tk < 2048 / 32; tk += G) { float v0, v1; thin_gemm_tile<1024>(X1B + (size_t)NP * 1024, WP0T, tk * 32, (LAS float*)lds, tid, v0, v1);
            const int r = tid >> 4, row = NP + r, col = tk * 32 + 2 * (tid & 15); const float rs = rsqrtf(pg8::ss_get(SS1 + row) * (1.0f / 1024.0f) + EPS);
            *(GAS unsigned*)(SH + (size_t)row * 2048 + col) = pg8::EpiScaleF16::pkh(v0 * rs, v1 * rs); } }
    SEAM(4);
    if (IN(5)) for (int rep = 0; rep < REP(5); ++rep) { { RouteIn RA, RB; int task = gw + (G == 256 ? NP * 2 : 0); if (task < NT * 2) peer_route_load(RA, SH, task, lane);
          for (; task < NT * 2; task += 2 * NGW) {
              if (task + NGW < NT * 2) peer_route_load(RB, SH, task + NGW, lane);
              peer_route_task(RA, EIDX, GATE, task, lane);
              if (task + NGW >= NT * 2) break;
              if (task + 2 * NGW < NT * 2) peer_route_load(RA, SH, task + 2 * NGW, lane);
              peer_route_task(RB, EIDX, GATE, task + NGW, lane); } }
        { XqIn QA, QB2; int tok = gw; if (tok < NT) peer_xq_load(QA, X1B, SS1, tok, lane);
          for (; tok < NT; tok += 2 * NGW) {
              if (tok + NGW < NT) peer_xq_load(QB2, X1B, SS1, tok + NGW, lane);
              peer_xq_token(QA, XQ, RSX, tok, lane);
              if (tok + NGW >= NT) break;
              if (tok + 2 * NGW < NT) peer_xq_load(QA, X1B, SS1, tok + 2 * NGW, lane);
              peer_xq_token(QB2, XQ, RSX, tok + NGW, lane); } } }
    SEAM(5);
    if (IN(6)) {
        LAS unsigned* lst = (LAS unsigned*)(lds + wave * 9216);
        PEER_QLOOP_CHUNK(QC + 0 * 512, peer_e1_chunk(XQ, RSX, EIDX, GATE, U8, SU, SV, ACT, lst, t0, t1, pi, lane));
        if (REP(6) == 2) PEER_QLOOP_CHUNK(QC + 4 * 512, peer_e1_chunk(XQ, RSX, EIDX, GATE, U8, SU, SV, ACT, lst, t0, t1, pi, lane));
        xcd_barrier(bar);
        if (REP(16) == 2) PEER_QLOOP_CHUNK(QC + 5 * 512, peer_e2_chunk<true>(X1B, EIDX, ACT, V8, nullptr, X2B, SS2, t0, t1, pi, lane));
        PEER_QLOOP_CHUNK(QC + 1 * 512, peer_e2_chunk<true>(X1B, EIDX, ACT, V8, nullptr, X2B, SS2, t0, t1, pi, lane));
        for (int r = NT + gw; r < MP; r += NGW) { (void)p0_row(nullptr, nullptr, X2B + (size_t)r * 1024, lane); if (lane < 8) SS2[(size_t)lane * MP + r] = 0.f; } }
    SEAM(6);
    if (IN(7)) for (int rep = 0; rep < REP(7); ++rep) { pg8::Gemm g{X2B, WIN1T, NP, APAD, 1024}; pg8::StaticOrder S; S.init(NP, APAD, G, bid); pg8::EpiScaleBf16 E{PBF, APAD, SS2, 8, MP};
        pg8::gemm_phase<pg8::EpiScaleBf16, pg8::StaticOrder, true, true>(lds, g, S, E);
        for (int tk = bid; tk < APAD / 32; tk += G) { float v0, v1; thin_gemm_tile<1024>(X2B + (size_t)NP * 1024, WIN1T, tk * 32, (LAS float*)lds, tid, v0, v1);
            const int r = tid >> 4, row = NP + r, col = tk * 32 + 2 * (tid & 15); float sa = 0.f;
#pragma unroll
            for (int pp = 0; pp < 8; ++pp) sa += SS2[(size_t)pp * MP + row];
            const float rs = rsqrtf(sa * (1.0f / 1024.0f) + EPS); *(GAS unsigned*)(PBF + (size_t)row * APAD + col) = pk2(v0 * rs, v1 * rs); } }
    SEAM(7);
    if (IN(8)) for (int rep = 0; rep < REP(8); ++rep) { { const float gq = att_qg[lane], gk = att_kg[lane], gik = att_ikg[lane]; PostRow RA, RB;
            int row = gw; if (row < NT) att_post_load(RA, PBF, row, lane);
            for (; row < NT; row += 2 * NGW) {
                if (row + NGW < NT) att_post_load(RB, PBF, row + NGW, lane);
                att_post_compute(RA, gq, gk, gik, ROPE, QB, KB, V2B, QIB, KIB, WI, out, row, lane);
                if (row + NGW >= NT) break;
                if (row + 2 * NGW < NT) att_post_load(RA, PBF, row + 2 * NGW, lane);
                att_post_compute(RB, gq, gk, gik, ROPE, QB, KB, V2B, QIB, KIB, WI, out, row + NGW, lane);
            } }
        for (int grp = gw; grp < NP / 8; grp += NGW) {
            const int row0 = grp * 8, b = row0 >> 12, t0 = row0 & 4095;
#pragma unroll
            for (int i = 0; i < 4; ++i) { unsigned v[8];
#pragma unroll
                for (int tt = 0; tt < 8; ++tt) v[tt] = (unsigned)PBF[(size_t)(row0 + tt) * APAD + 1280 + i * 64 + lane];
                v4u w; w.x = v[0] | (v[1] << 16); w.y = v[2] | (v[3] << 16); w.z = v[4] | (v[5] << 16); w.w = v[6] | (v[7] << 16);
                *(GAS v4u*)(VT + ((size_t)b * 256 + i * 64 + lane) * SEQ + t0) = w; } } }
    SEAM(8);
    if (IN(9)) for (int rep = 0; rep < REP(9); ++rep) {
        for (int w = gw; w < 2048; w += NGW) { const int b = w >> 8, half = (w >> 7) & 1, p = w & 127;
#pragma unroll 1
            for (int rep = 0; rep < 2; ++rep) { const int qb = rep ? 255 - p : p, nk = qb + 1; idx_scores_task(QIB, KIB, WI, SC, b, qb, (half * nk) >> 1, ((half + 1) * nk) >> 1, lane); } }
        LAS float* scr = (LAS float*)(lds + wave * 4096);
        for (int w = gw; w < NS * 129; w += NGW) samp_scores_task(QIB, WI, KIB, cache_ik, page_table, SKEYS, scr, w / 129, w % 129, lane);
    }
    SEAM(9);
    if (IN(10)) for (int rep = 0; rep < REP(10); ++rep) { unsigned raw[64], x[64];
        int p = gw; if (p < 8 * 2048) select_load(raw, SC, (p >> 11) * 4096 + (p & 2047), lane);
        for (; p < 8 * 2048; p += NGW) { const int rA = (p >> 11) * 4096 + (p & 2047), rB = (p >> 11) * 4096 + 4095 - (p & 2047);
            select_keys(x, raw, rA, lane); select_load(raw, SC, rB, lane); select_run(x, BM, rA, lane);
            select_keys(x, raw, rB, lane); if (p + NGW < 8 * 2048) select_load(raw, SC, ((p + NGW) >> 11) * 4096 + ((p + NGW) & 2047), lane); select_run(x, BM, rB, lane); } }
    SEAM(10);
    if (IN(11)) for (int rep = 0; rep < REP(11); ++rep) {
        for (int b = bid; b < NS; b += G) samp_select_attend(SKEYS, QB, KB, V2B, cache_k, cache_v, page_table, OB, lds, b, tid);
        __syncthreads();
        { float mq = fabsf(att_qg[lane]), mkk = fabsf(att_kg[lane]);
#pragma unroll
          for (int o = 1; o < 64; o <<= 1) { mq = fmaxf(mq, __shfl_xor(mq, o)); mkk = fmaxf(mkk, __shfl_xor(mkk, o)); }
          const float nbound = -(QSCALE * 64.0f * mq * mkk);
          if (tid < 16) { LAS unsigned* mt = (LAS unsigned*)(lds + 3 * ATT_STAGE + 64); mt[2 * tid] = ((tid & 1) ? 0xFFFFu : 0u) | ((tid & 2) ? 0xFFFF0000u : 0u); mt[2 * tid + 1] = ((tid & 4) ? 0xFFFFu : 0u) | ((tid & 8) ? 0xFFFF0000u : 0u); }
          __syncthreads();
          unsigned* qa = QC + 6 * 512; const int home = (int)(xb_xcc_id() & 7u); LAS int* tkp = (LAS int*)(lds + 3 * ATT_STAGE);
#pragma unroll 1
          for (int k = 0; k < 8; ++k) { const int pi = (home + k) & 7; unsigned* qh = qa + pi * 64;
              int nxt = 0; if (tid == 0) nxt = (int)__hip_atomic_fetch_add(qh, 1u, __ATOMIC_RELAXED, __HIP_MEMORY_SCOPE_AGENT);
#pragma unroll 1
              for (;;) { if (tid == 0) *tkp = nxt; __syncthreads(); const int c = __builtin_amdgcn_readfirstlane(*tkp);
                  if (c >= 256) break;
                  const int bk = pi * 4 + (c & 3), qt = 63 - (c >> 2); attend_unit(QB, KB, VT, BM, OB, lds, bk >> 2, bk & 3, qt, nbound, tid, qh, nxt); }
              __syncthreads(); } }
        for (int r = NT + gw; r < MP; r += NGW) (void)p0_row(nullptr, nullptr, OB + (size_t)r * 1024, lane);
    }
    SEAM(11);
    if (IN(12)) for (int rep = 0; rep < REP(12); ++rep) { pg8::Gemm g{OB, WOUT1T, NP, 1024, 1024}; pg8::StaticOrder S; S.init(NP, 1024, G, bid); pg8::EpiResid<true> E{X2B, nullptr, X3B, SS3, NP, NT, rep == 0};
        pg8::gemm_phase<pg8::EpiResid<true>, pg8::StaticOrder, true, true>(lds, g, S, E);
        for (int tk = bid; tk < 1024 / 32; tk += G) { float v0, v1; thin_gemm_tile<1024>(OB + (size_t)NP * 1024, WOUT1T, tk * 32, (LAS float*)lds, tid, v0, v1);
            const int r = tid >> 4, row = NP + r, col = tk * 32 + 2 * (tid & 15); const unsigned xr = *(const GAS unsigned*)(X2B + (size_t)row * 1024 + col); v0 += bflo(xr); v1 += bfhi(xr);
            *(GAS unsigned*)(X3B + (size_t)row * 1024 + col) = pk2(v0, v1); const float sq = row16_sum(v0 * v0 + v1 * v1); if ((tid & 15) == 0 && rep == 0) pg8::ss_add(SS3 + row, sq); } }
    SEAM(12);
    if (IN(13)) for (int rep = 0; rep < REP(13); ++rep) { pg8::Gemm g{X3B, WP1T, NP, 2048, 1024};
        if (G == 256) {
            const EpiRoute ER{SS3, EIDX, GATE};
            { OneUnit S1; S1.init(NP, 2048, G, bid); S1.k = 0; pg8::gemm_phase<EpiRoute, OneUnit, false, true>(lds, g, S1, ER); }
            { OneUnit S1; S1.init(NP, 2048, G, bid); S1.k = 1; pg8::gemm_phase<EpiRoute, OneUnit, false, true>(lds, g, S1, ER); }
            { OneUnit S1; S1.init(NP, 2048, G, bid); S1.k = 2; pg8::gemm_phase<EpiRoute, OneUnit, false, true>(lds, g, S1, ER); }
            { OneUnit S1; S1.init(NP, 2048, G, bid); S1.k = 3; pg8::gemm_phase<EpiRoute, OneUnit, false, true>(lds, g, S1, ER); }
        } else { pg8::StaticOrder S; S.init(NP, 2048, G, bid); pg8::EpiScaleF16 E{SH, 2048, SS3};
            pg8::gemm_phase<pg8::EpiScaleF16, pg8::StaticOrder, true, true>(lds, g, S, E); }
        for (int tk = bid; tk < 2048 / 32; tk += G) { float v0, v1; thin_gemm_tile<1024>(X3B + (size_t)NP * 1024, WP1T, tk * 32, (LAS float*)lds, tid, v0, v1);
            const int r = tid >> 4, row = NP + r, col = tk * 32 + 2 * (tid & 15); const float rs = rsqrtf(pg8::ss_get(SS3 + row) * (1.0f / 1024.0f) + EPS);
            *(GAS unsigned*)(SH + (size_t)row * 2048 + col) = pg8::EpiScaleF16::pkh(v0 * rs, v1 * rs); } }
    SEAM(13);
    if (IN(14)) for (int rep = 0; rep < REP(14); ++rep) { { RouteIn RA, RB; int task = gw + (G == 256 ? NP * 2 : 0); if (task < NT * 2) peer_route_load(RA, SH, task, lane);
          for (; task < NT * 2; task += 2 * NGW) {
              if (task + NGW < NT * 2) peer_route_load(RB, SH, task + NGW, lane);
              peer_route_task(RA, EIDX, GATE, task, lane);
              if (task + NGW >= NT * 2) break;
              if (task + 2 * NGW < NT * 2) peer_route_load(RA, SH, task + 2 * NGW, lane);
              peer_route_task(RB, EIDX, GATE, task + NGW, lane); } }
        { XqIn QA, QB2; int tok = gw; if (tok < NT) peer_xq_load(QA, X3B, SS3, tok, lane);
          for (; tok < NT; tok += 2 * NGW) {
              if (tok + NGW < NT) peer_xq_load(QB2, X3B, SS3, tok + NGW, lane);
              peer_xq_token(QA, XQ, RSX, tok, lane);
              if (tok + NGW >= NT) break;
              if (tok + 2 * NGW < NT) peer_xq_load(QA, X3B, SS3, tok + 2 * NGW, lane);
              peer_xq_token(QB2, XQ, RSX, tok + NGW, lane); } } }
    SEAM(14);
    if (IN(15)) {
        LAS unsigned* lst = (LAS unsigned*)(lds + wave * 9216);
        PEER_QLOOP_CHUNK(QC + 2 * 512, peer_e1_chunk(XQ, RSX, EIDX, GATE, U8 + (size_t)16384 * 1024, SU + 16384, SV + 16384, ACT, lst, t0, t1, pi, lane));
        xcd_barrier(bar);
        PEER_QLOOP_CHUNK(QC + 3 * 512, peer_e2_chunk<false>(X3B, EIDX, ACT, V8 + (size_t)16384 * 1024, out + O_Y, nullptr, nullptr, t0, t1, pi, lane)); }
#undef IN
#undef SEAM
}
constexpr int N_PHASES = 16;
}


extern "C" void kernel_launch(void* const* d_in, const int* in_sizes, int n_in, void* d_out, int out_size, void* d_ws, size_t ws_size, hipStream_t stream) {
    using namespace mk;
    static int grid = 0;
    if (grid == 0) {
        int dev = 0, cus = 0;
        if (hipGetDevice(&dev) != hipSuccess || hipDeviceGetAttribute(&cus, hipDeviceAttributeMultiprocessorCount, dev) != hipSuccess) { fprintf(stderr, "kernel_launch: device query failed\n"); grid = -1; return; }
        if (hipFuncSetAttribute((const void*)fused_fwd, hipFuncAttributeMaxDynamicSharedMemorySize, LDS_BYTES) != hipSuccess) { fprintf(stderr, "kernel_launch: hipFuncSetAttribute failed\n"); grid = -1; return; }
        int per_cu = 0;
        if (hipOccupancyMaxActiveBlocksPerMultiprocessor(&per_cu, (const void*)fused_fwd, NTHR, LDS_BYTES) != hipSuccess || per_cu < 1) fprintf(stderr, "kernel_launch: occupancy query says %d\n", per_cu);
        (void)hipGetLastError();
        grid = cus;
        if (ws_size < W_END) { fprintf(stderr, "kernel_launch: workspace too small (%zu < %zu)\n", ws_size, (size_t)W_END); grid = -1; return; }
    }
    if (grid < 0) return;
    (void)hipMemsetAsync(d_ws, 0, CTL_BYTES, stream);
    Params p{};
    for (int i = 0; i < 23; ++i) p.in[i] = (const float*)d_in[i];
    p.out = (float*)d_out; p.ws = (unsigned char*)d_ws;
    for (int i = 0; i < 32; ++i) p.inv[i] = (float)exp(-log(10000.0) * (double)i / 32.0);
    p.ph_lo = 0; p.ph_hi = N_PHASES;
    hipLaunchKernelGGL(fused_fwd, dim3(grid), dim3(NTHR), LDS_BYTES, stream, p);
}
```
